# Optimizing an MI355X kernel written in HIP

```python
import jax, jax.numpy as jnp
from jax import lax
import numpy as np

D_MODEL = 1024
BATCH = 8
SEQ = 2048
DEPTH = 2
DEC_BATCH = 8
DEC_SEQ = 64
PAST_LEN = 4096

CHUNK = 64
Q_BLOCK = 128
N_HEADS = 8
QK_NOPE = 64
QK_ROPE = 32
QK_HEAD = QK_NOPE + QK_ROPE
V_HEAD = 64
Q_LORA = 256
KV_LORA = 128
ROPE_THETA = 10000.0
ATTN_WIDTH = N_HEADS * V_HEAD
GMLP_GROUPS = 8
GMLP_GROUP_DIM = 64
GMLP_WIDTH = GMLP_GROUPS * GMLP_GROUP_DIM
GMLP_CHUNK = 128
MIX_WIDTH = ATTN_WIDTH + GMLP_WIDTH
IN_COLS = Q_LORA + KV_LORA + QK_ROPE + 2 * GMLP_WIDTH
SPLITS = (Q_LORA, Q_LORA + KV_LORA, Q_LORA + KV_LORA + QK_ROPE,
          Q_LORA + KV_LORA + QK_ROPE + GMLP_WIDTH)
D_FF = ((-(-8 * D_MODEL // 3) + 255) // 256) * 256
EPS = 1e-6
NEG_INF = -1e30

kernel_name = 'hybrid_mla_gmlp_stream_step'


def rms_norm(x, g):
    xf = x.astype(jnp.float32)
    y = xf * lax.rsqrt(jnp.mean(jnp.square(xf), axis=-1, keepdims=True) + EPS)
    return (y * g.astype(jnp.float32)).astype(x.dtype)


def layer_norm(x, g, b):
    xf = x.astype(jnp.float32)
    mu = jnp.mean(xf, axis=-1, keepdims=True)
    xc = xf - mu
    y = xc * lax.rsqrt(jnp.mean(jnp.square(xc), axis=-1, keepdims=True) + EPS)
    return (y * g.astype(jnp.float32) + b.astype(jnp.float32)).astype(x.dtype)


def rope_angles(pos):
    half = QK_ROPE // 2
    inv = ROPE_THETA ** (-jnp.arange(half, dtype=jnp.float32) / half)
    ang = pos.astype(jnp.float32)[:, None] * inv[None, :]
    return jnp.cos(ang), jnp.sin(ang)


def apply_rope(x, cos, sin):
    half = QK_ROPE // 2
    xf = x.astype(jnp.float32)
    x1, x2 = xf[..., :half], xf[..., half:]
    return jnp.concatenate([x1 * cos - x2 * sin, x1 * sin + x2 * cos], axis=-1).astype(x.dtype)


def attend_block(qb, qpos_b, k, v, kpos):
    s = jnp.einsum('bqhe,bkhe->bhqk', qb, k, preferred_element_type=jnp.float32) * (QK_HEAD ** -0.5)
    vis = (kpos[None, :] // CHUNK) <= (qpos_b[:, None] // CHUNK)
    s = jnp.where(vis[None, None], s, NEG_INF)
    p = jax.nn.softmax(s, axis=-1)
    return jnp.einsum('bhqk,bkhd->bqhd', p.astype(v.dtype), v)


def block_causal_attention(q, k, v, qpos, kpos):
    B, S, H, E = q.shape
    if S <= Q_BLOCK:
        return attend_block(q, qpos, k, v, kpos)
    nb = S // Q_BLOCK
    qb = q.reshape(B, nb, Q_BLOCK, H, E).transpose(1, 0, 2, 3, 4)
    ob = lax.map(lambda a: attend_block(a[0], a[1], k, v, kpos), (qb, qpos.reshape(nb, Q_BLOCK)))
    return ob.transpose(1, 0, 2, 3, 4).reshape(B, S, H, V_HEAD)


def spatial_gating(u, v, ln_g, ln_b, w_s, b_s):
    B, S, _ = u.shape
    L = min(S, GMLP_CHUNK)
    nc = S // L
    ug = jax.nn.gelu(u).reshape(B, S, GMLP_GROUPS, GMLP_GROUP_DIM)
    vn = layer_norm(jax.nn.gelu(v).reshape(B, S, GMLP_GROUPS, GMLP_GROUP_DIM), ln_g, ln_b)
    idx = jnp.arange(L)
    causal = (idx[:, None] // CHUNK) >= (idx[None, :] // CHUNK)
    ws = jnp.where(causal[None], w_s[:, :L, :L], 0.0)
    mixed = jnp.einsum('gij,bcjgd->bcigd', ws, vn.reshape(B, nc, L, GMLP_GROUPS, GMLP_GROUP_DIM))
    mixed = mixed + b_s[:, :L].T[None, None, :, :, None]
    out = ug * mixed.reshape(B, S, GMLP_GROUPS, GMLP_GROUP_DIM)
    return out, vn.reshape(B, S, GMLP_WIDTH)


def hybrid_layer(x, pos, ckv_past, kr_past, p):
    B, S, _ = x.shape
    h = rms_norm(x, p['g_mix'])
    z = h @ p['w_in']
    q_lat, c_kv, k_r, u, v = jnp.split(z, SPLITS, axis=-1)
    cos, sin = rope_angles(pos)
    q = (rms_norm(q_lat, p['g_q_lora']) @ p['w_q_up']).reshape(B, S, N_HEADS, QK_HEAD)
    q_nope = rms_norm(q[..., :QK_NOPE], p['g_qn'])
    q_rope = apply_rope(rms_norm(q[..., QK_NOPE:], p['g_qr']), cos[:, None, :], sin[:, None, :])
    q = jnp.concatenate([q_nope, q_rope], axis=-1)
    c_kv = rms_norm(c_kv, p['g_kv_lora'])
    k_r = apply_rope(rms_norm(k_r, p['g_kr']), cos, sin)
    if ckv_past is None:
        ckv_all, kr_all, kpos = c_kv, k_r, pos
    else:
        ckv_all = jnp.concatenate([ckv_past, c_kv], axis=1)
        kr_all = jnp.concatenate([kr_past, k_r], axis=1)
        kpos = jnp.arange(ckv_all.shape[1])
    T = ckv_all.shape[1]
    kv = (ckv_all @ p['w_kv_up']).reshape(B, T, N_HEADS, QK_NOPE + V_HEAD)
    k_nope = rms_norm(kv[..., :QK_NOPE], p['g_kn'])
    v_att = kv[..., QK_NOPE:]
    k = jnp.concatenate([k_nope, jnp.broadcast_to(kr_all[:, :, None, :], (B, T, N_HEADS, QK_ROPE))], axis=-1)
    o_att = block_causal_attention(q, k, v_att, pos, kpos)
    o_gm, v_rows = spatial_gating(u, v, p['gm_ln_g'], p['gm_ln_b'], p['gm_w_s'], p['gm_b_s'])
    merged = jnp.concatenate([rms_norm(o_att, p['g_out_att']).reshape(B, S, ATTN_WIDTH),
                              rms_norm(o_gm, p['g_out_gm']).reshape(B, S, GMLP_WIDTH)], axis=-1)
    x = x + merged @ p['w_o']
    h2 = rms_norm(x, p['g_ffn'])
    x = x + (jax.nn.silu(h2 @ p['w_gate']) * (h2 @ p['w_up'])) @ p['w_down']
    return x, c_kv, k_r, v_rows


def setup_inputs(seed: int = 0) -> dict:
    key = jax.random.key(seed)
    ks = jax.random.split(key, 26)

    def nrm(k, shape, scale):
        return scale * jax.random.normal(k, shape, jnp.float32)

    def gain(k, shape):
        return 1.0 + 0.02 * jax.random.normal(k, shape, jnp.float32)

    return {
        'x_prompt': nrm(ks[0], (BATCH, SEQ, D_MODEL), 1.0),
        'x_sample': nrm(ks[1], (DEC_BATCH, DEC_SEQ, D_MODEL), 1.0),
        'cache_ckv': nrm(ks[2], (DEPTH, DEC_BATCH, PAST_LEN, KV_LORA), 1.0),
        'cache_krope': nrm(ks[3], (DEPTH, DEC_BATCH, PAST_LEN, QK_ROPE), 1.0),
        'g_mix': gain(ks[4], (DEPTH, D_MODEL)),
        'w_in': nrm(ks[5], (DEPTH, D_MODEL, IN_COLS), D_MODEL ** -0.5),
        'g_q_lora': gain(ks[6], (DEPTH, Q_LORA)),
        'w_q_up': nrm(ks[7], (DEPTH, Q_LORA, N_HEADS * QK_HEAD), Q_LORA ** -0.5),
        'g_qn': gain(ks[8], (DEPTH, QK_NOPE)),
        'g_qr': gain(ks[9], (DEPTH, QK_ROPE)),
        'g_kv_lora': gain(ks[10], (DEPTH, KV_LORA)),
        'g_kr': gain(ks[11], (DEPTH, QK_ROPE)),
        'w_kv_up': nrm(ks[12], (DEPTH, KV_LORA, N_HEADS * (QK_NOPE + V_HEAD)), KV_LORA ** -0.5),
        'g_kn': gain(ks[13], (DEPTH, QK_NOPE)),
        'gm_ln_g': gain(ks[14], (DEPTH, GMLP_GROUPS, GMLP_GROUP_DIM)),
        'gm_ln_b': nrm(ks[15], (DEPTH, GMLP_GROUPS, GMLP_GROUP_DIM), 0.02),
        'gm_w_s': nrm(ks[16], (DEPTH, GMLP_GROUPS, GMLP_CHUNK, GMLP_CHUNK), GMLP_CHUNK ** -0.5),
        'gm_b_s': 1.0 + nrm(ks[17], (DEPTH, GMLP_GROUPS, GMLP_CHUNK), 0.1),
        'g_out_att': gain(ks[18], (DEPTH, N_HEADS, V_HEAD)),
        'g_out_gm': gain(ks[19], (DEPTH, GMLP_GROUPS, GMLP_GROUP_DIM)),
        'w_o': nrm(ks[20], (DEPTH, MIX_WIDTH, D_MODEL), MIX_WIDTH ** -0.5),
        'g_ffn': gain(ks[21], (DEPTH, D_MODEL)),
        'w_gate': nrm(ks[22], (DEPTH, D_MODEL, D_FF), D_MODEL ** -0.5),
        'w_up': nrm(ks[23], (DEPTH, D_MODEL, D_FF), D_MODEL ** -0.5),
        'w_down': nrm(ks[24], (DEPTH, D_FF, D_MODEL), D_FF ** -0.5),
    }


def reference(x_prompt, x_sample, cache_ckv, cache_krope, g_mix, w_in, g_q_lora, w_q_up,
              g_qn, g_qr, g_kv_lora, g_kr, w_kv_up, g_kn, gm_ln_g, gm_ln_b, gm_w_s, gm_b_s,
              g_out_att, g_out_gm, w_o, g_ffn, w_gate, w_up, w_down):
    past = cache_ckv.shape[2]
    pos_p = jnp.arange(x_prompt.shape[1])
    pos_s = past + jnp.arange(x_sample.shape[1])
    yp, ys = x_prompt, x_sample
    ckv_p, kr_p, ckv_s, kr_s, gv_s = [], [], [], [], []
    for l in range(DEPTH):
        p = {'g_mix': g_mix[l], 'w_in': w_in[l], 'g_q_lora': g_q_lora[l], 'w_q_up': w_q_up[l],
             'g_qn': g_qn[l], 'g_qr': g_qr[l], 'g_kv_lora': g_kv_lora[l], 'g_kr': g_kr[l],
             'w_kv_up': w_kv_up[l], 'g_kn': g_kn[l], 'gm_ln_g': gm_ln_g[l], 'gm_ln_b': gm_ln_b[l],
             'gm_w_s': gm_w_s[l], 'gm_b_s': gm_b_s[l], 'g_out_att': g_out_att[l],
             'g_out_gm': g_out_gm[l], 'w_o': w_o[l], 'g_ffn': g_ffn[l], 'w_gate': w_gate[l],
             'w_up': w_up[l], 'w_down': w_down[l]}
        yp, c, r, _ = hybrid_layer(yp, pos_p, None, None, p)
        ckv_p.append(c)
        kr_p.append(r)
        ys, c, r, gv = hybrid_layer(ys, pos_s, cache_ckv[l], cache_krope[l], p)
        ckv_s.append(c)
        kr_s.append(r)
        gv_s.append(gv)
    return (yp, ys, jnp.stack(ckv_p), jnp.stack(kr_p), jnp.stack(ckv_s), jnp.stack(kr_s), jnp.stack(gv_s))
```

```cpp
#include <hip/hip_runtime.h>
#include <cstdio>
#include <cstdint>

#define LAS __attribute__((address_space(3)))
#define GAS __attribute__((address_space(1)))
typedef unsigned short bf16;
typedef short bf16x8 __attribute__((ext_vector_type(8)));
typedef short s16x4 __attribute__((ext_vector_type(4)));
typedef float f32x4 __attribute__((ext_vector_type(4)));
typedef float f32x2 __attribute__((ext_vector_type(2)));
typedef float f32x16 __attribute__((ext_vector_type(16)));
typedef unsigned u32x4 __attribute__((ext_vector_type(4)));
typedef unsigned u32x2 __attribute__((ext_vector_type(2)));
typedef __bf16 bf16x2_t __attribute__((ext_vector_type(2)));

constexpr int DM = 1024, MP = 16384, MS = 512, MT = MP + MS  , MC = 32768  , MA = MT + MC;
constexpr int NZ = 1536, DFF = 2816, NGU = 5632;
constexpr int NLAYER = 2;
constexpr float EPS = 1e-6f;
constexpr float QSCALE = 0.10206207261596577f * 1.4426950408889634f;

constexpr size_t O_Y = 0, O_CKVP = (size_t)MT * 1024, O_KRP = O_CKVP + (size_t)2 * MP * 128, O_CKVS = O_KRP + (size_t)2 * MP * 32,
                 O_KRS = O_CKVS + (size_t)2 * MS * 128, O_GVS = O_KRS + (size_t)2 * MS * 32, O_END = O_GVS + (size_t)2 * MS * 512;

constexpr size_t MiB = 1u << 20;
constexpr size_t WS_CTL = 0, CTL_ZERO_BYTES = 1 * MiB;
constexpr int CW_BAR = 4096;
constexpr size_t CTL_SSQ = 65536;
constexpr size_t WS_W = 1 * MiB, LW = 23461888;
constexpr size_t W_IN = 0, W_QUP = 3145728, W_KV = W_QUP + 393216, W_O = W_KV + 262144, W_GU = W_O + 2097152, W_D = W_GU + 11534336, W_S = W_D + 5767168;
static_assert(W_S + 262144 == LW, "weight block");
constexpr size_t WS_CKVA = WS_W + 2 * LW, L_CKVA = (size_t)MA * 128 * 2;
constexpr size_t WS_KR = WS_CKVA + 2 * L_CKVA, L_KR = (size_t)MA * 32 * 2;
constexpr size_t WS_ROPE = WS_KR + 2 * L_KR;
constexpr size_t WS_PART = 153 * MiB / 2, PART_BYTES = (size_t)64 * 4 * 2 * 34 * 64 * 4;
constexpr size_t WS_BIG = 324 * MiB / 4 - MiB / 4;
constexpr size_t CTL_SCNT = 32768;
constexpr size_t CTL_SSQQ = 524288, CTL_SSQC = CTL_SSQQ + 2 * (size_t)MT * 4;
constexpr size_t B_KN = WS_BIG, B_VV = B_KN + (size_t)MA * 512 * 2, B_QNP = B_VV + (size_t)MA * 512 * 2, B_QRP = B_QNP + (size_t)MT * 512 * 2,
                 B_VN = B_QRP + (size_t)MT * 256 * 2, B_MRG = B_VN + (size_t)MT * 512 * 2, B_MRG_END = B_MRG + (size_t)MT * 1024 * 2;
constexpr size_t B_H = WS_BIG + (size_t)MT * NZ * 2 + (size_t)MT * 1024 * 2, B_H_END = B_H + (size_t)MT * DFF * 2;
constexpr size_t B_XB = 256 * MiB;
constexpr size_t WS_WKVG = B_XB + (size_t)MT * 2048;
constexpr size_t B_Z = WS_WKVG + 2 * 262144;
constexpr size_t WS_END = B_Z + (size_t)MT * NZ * 2;
static_assert(WS_ROPE + 2112 * 16 * 8 <= WS_PART && WS_PART + PART_BYTES <= WS_BIG && WS_BIG % 65536 == 0 && WS_PART % 65536 == 0, "ws map 1");
static_assert(B_MRG_END <= B_XB && B_H_END <= B_XB && B_XB + (size_t)MT * 2048 <= WS_END, "ws map 2");
static_assert(B_Z >= B_XB + (size_t)MT * 2048, "Z above XB");
static_assert(CTL_SSQ + 5 * (size_t)MT * 4 <= CTL_SSQQ && CTL_SSQC + 2 * (size_t)MT * 4 <= CTL_ZERO_BYTES, "ssq arrays inside the memset region");

constexpr int RING_BYTES = 131072, LDS_BYTES = 147456, MISC_OFF = LDS_BYTES - 256;

__device__ __forceinline__ unsigned pk2(float lo, float hi) { f32x2 v = {lo, hi}; bf16x2_t b = __builtin_convertvector(v, bf16x2_t); return __builtin_bit_cast(unsigned, b); }
__device__ __forceinline__ float bflo(unsigned w) { return __uint_as_float(w << 16); }
__device__ __forceinline__ float bfhi(unsigned w) { return __uint_as_float(w & 0xffff0000u); }
#define SWZ_XOR(v, m) __int_as_float(__builtin_amdgcn_ds_swizzle(__float_as_int(v), ((m) << 10) | 0x1f))
__device__ __forceinline__ float sum16(float v) { return v + __int_as_float(__builtin_amdgcn_ds_swizzle(__float_as_int(v), 0x401F)); }
__device__ __forceinline__ float sum32(float v) { auto r = __builtin_amdgcn_permlane32_swap(__float_as_uint(v), __float_as_uint(v), false, false); return __uint_as_float(r[0]) + __uint_as_float(r[1]); }
__device__ __forceinline__ float max32(float v) { auto r = __builtin_amdgcn_permlane32_swap(__float_as_uint(v), __float_as_uint(v), false, false); return fmaxf(__uint_as_float(r[0]), __uint_as_float(r[1])); }
__device__ __forceinline__ float sum8(float v) { v += SWZ_XOR(v, 1); v += SWZ_XOR(v, 2); v += SWZ_XOR(v, 4); return v; }
__device__ __forceinline__ float wave_sum(float v) { v = sum8(v); v += SWZ_XOR(v, 8); v += SWZ_XOR(v, 16); return sum32(v); }
__device__ __forceinline__ float dot4v(const f32x4 a) { return (a[0] * a[0] + a[1] * a[1]) + (a[2] * a[2] + a[3] * a[3]); }
__device__ __forceinline__ float rsq(float x) { return __builtin_amdgcn_rsqf(x); }
__device__ __forceinline__ float gelu_tanh(float x) {
    const float u2 = 1.5957691216057308f * (x + 0.044715f * x * x * x);
    return x * __builtin_amdgcn_rcpf(1.0f + __builtin_amdgcn_exp2f(-1.4426950408889634f * u2));
}
__device__ __forceinline__ float silu_f(float x) { return x * __builtin_amdgcn_rcpf(1.0f + __builtin_amdgcn_exp2f(-1.4426950408889634f * x)); }
namespace pg8 {
#define PG8_LAS __attribute__((address_space(3)))
typedef unsigned short bf16_t;
constexpr int BM = 256, BK = 64, HALF = 128, HTB = HALF * BK * 2  , STAGE_BYTES = 8 * HTB, NXCD = 8, WGM = 8;

__host__ __device__ __forceinline__ int lds_byte(int r, int c) { const int st = (r >> 4) * 2 + (c >> 5), rr = r & 15, cc = c & 31, ob = rr * 64 + cc * 2; return st * 1024 + (ob ^ (((ob >> 9) & 1) << 5)); }
__host__ __device__ __forceinline__ void stage_rc(int b, int& R, int& C) { const int st = b / 1024, sb = b % 1024, swz = sb ^ (((sb >> 9) & 1) << 5); R = (st >> 1) * 16 + swz / 64; C = (st & 1) * 32 + (swz % 64) / 2; }
__host__ __device__ __forceinline__ int perm32(int rho) { const int n = rho >> 4, i = rho & 15; return 8 * (i >> 2) + 4 * n + (i & 3); }

struct Unit { int pm, pn; };
struct Gemm { const bf16_t* A; const bf16_t* Bt; int M, N, K, lda; };

struct StaticOrder {
    int nM, nN, nwg, G, c, i0 = 0, i1 = 1 << 20;
    __host__ __device__ void init(int M, int N, int G_, int c_) { nM = M / BM; nN = N / BM; nwg = nM * nN; G = G_; c = c_; }
    __host__ __device__ bool next(int i_, Unit& u) const {
        const int i = i_ + i0; if (i >= i1) return false;
        const long L = (long)i * G + c; if (L >= nwg) return false;
        int wgid = (int)L; { const int q = nwg / NXCD, r = nwg % NXCD, xcd = wgid % NXCD, off = wgid / NXCD; wgid = (xcd < r ? xcd * (q + 1) : r * (q + 1) + (xcd - r) * q) + off; }
        const int nig = WGM * nN, gid = wgid / nig, fm = gid * WGM, gsz = (nM - fm) < WGM ? (nM - fm) : WGM;
        u.pm = fm + ((wgid % nig) % gsz); u.pn = (wgid % nig) / gsz; return true;
    }
    __device__ __forceinline__ void a_ready(const Unit&) const {}
    __device__ __forceinline__ void done(const Unit&) const {}
};
__device__ __forceinline__ float dot4(const f32x4 a) { return (a[0] * a[0] + a[1] * a[1]) + (a[2] * a[2] + a[3] * a[3]); }

struct EpiZ {
    static constexpr bool PERM = true, AFTER_DRAIN = false;
    bf16_t* Z; const float* ssq; bf16_t* MRG; bf16_t* VN; float* gvs; const float* lng; const float* lnb; float* ssqQ; float* ssqC;
    __device__ __forceinline__ void operator()(const f32x4 (&acc)[2][2][4][2], const Unit& u, int wr, int wc, int fr_, int fq_) const {
        unsigned z_e = 0u; asm volatile("" : "+v"(z_e)); const int lane_e = (int)__builtin_amdgcn_mbcnt_hi(~0u, __builtin_amdgcn_mbcnt_lo(~0u, z_e)), fr = lane_e & 15, fq = lane_e >> 4; (void)fr_; (void)fq_;
        const int row0 = u.pm * BM + wr * 64 + fr;
        float rs[2][4];
#pragma unroll
        for (int ai = 0; ai < 2; ++ai)
#pragma unroll
            for (int m = 0; m < 4; ++m) rs[ai][m] = ssq[row0 + ai * HALF + m * 16];
        if (u.pn < 4) {
            bf16_t* dst; int ld;
            if (u.pn < 2) { dst = Z + u.pn * BM + wc * 32 + 8 * fq; ld = NZ; } else { dst = MRG + 512 + (u.pn - 2) * BM + wc * 32 + 8 * fq; ld = 1024; }
            const bool act = u.pn >= 2;
#pragma unroll
            for (int ai = 0; ai < 2; ++ai)
#pragma unroll
                for (int m = 0; m < 4; ++m) { const int row = row0 + ai * HALF + m * 16; const float r = rsq(rs[ai][m] * (1.0f / 1024.0f) + EPS); float sq = 0.f;
                    bf16_t* rowp = dst + (size_t)row * ld;
#pragma unroll
                    for (int bj = 0; bj < 2; ++bj) { f32x4 v0 = acc[ai][bj][m][0] * r, v1 = acc[ai][bj][m][1] * r;
                        if (act) {
#pragma unroll
                            for (int e = 0; e < 4; ++e) { v0[e] = gelu_tanh(v0[e]); v1[e] = gelu_tanh(v1[e]); } }
                        u32x4 w; w.x = pk2(v0[0], v0[1]); w.y = pk2(v0[2], v0[3]); w.z = pk2(v1[0], v1[1]); w.w = pk2(v1[2], v1[3]);
                        *(u32x4*)(rowp + bj * HALF) = w;
                        if (!act && (u.pn == 0 || bj == 0)) sq += dot4(v0) + dot4(v1); }
                    if (!act) { sq = sum32(sum16(sq)); if (fq == 0) atomicAdd((u.pn == 0 ? ssqQ : ssqC) + row, sq); }
                    __builtin_amdgcn_sched_barrier(0); }
        } else {
            const int grp = 4 * (u.pn - 4) + wc;
            f32x4 gg[2][2], gb[2][2];
#pragma unroll
            for (int bj = 0; bj < 2; ++bj)
#pragma unroll
                for (int n = 0; n < 2; ++n) { gg[bj][n] = *(const f32x4*)(lng + grp * 64 + 32 * bj + 8 * fq + 4 * n); gb[bj][n] = *(const f32x4*)(lnb + grp * 64 + 32 * bj + 8 * fq + 4 * n); }
#pragma unroll
            for (int ai = 0; ai < 2; ++ai)
#pragma unroll
                for (int m = 0; m < 4; ++m) { const int row = row0 + ai * HALF + m * 16; const float r = rsq(rs[ai][m] * (1.0f / 1024.0f) + EPS);
                    f32x4 y[2][2]; float s = 0.f;
#pragma unroll
                    for (int bj = 0; bj < 2; ++bj)
#pragma unroll
                        for (int n = 0; n < 2; ++n) { const f32x4 a = acc[ai][bj][m][n] * r;
#pragma unroll
                            for (int e = 0; e < 4; ++e) { y[bj][n][e] = gelu_tanh(a[e]); s += y[bj][n][e]; } }
                    s = sum32(sum16(s)); const float mean = s * (1.0f / 64.0f); float s2 = 0.f;
#pragma unroll
                    for (int bj = 0; bj < 2; ++bj)
#pragma unroll
                        for (int n = 0; n < 2; ++n) { y[bj][n] = y[bj][n] - mean; s2 += dot4(y[bj][n]); }
                    s2 = sum32(sum16(s2)); const float rstd = rsq(s2 * (1.0f / 64.0f) + EPS);
#pragma unroll
                    for (int bj = 0; bj < 2; ++bj) { const f32x4 o0 = y[bj][0] * rstd * gg[bj][0] + gb[bj][0], o1 = y[bj][1] * rstd * gg[bj][1] + gb[bj][1];
                        u32x4 w; w.x = pk2(o0[0], o0[1]); w.y = pk2(o0[2], o0[3]); w.z = pk2(o1[0], o1[1]); w.w = pk2(o1[2], o1[3]);
                        *(u32x4*)(VN + (size_t)row * 512 + grp * 64 + 32 * bj + 8 * fq) = w;
                        if (row >= MP) { float* op = gvs + (size_t)(row - MP) * 512 + grp * 64 + 32 * bj + 8 * fq; *(f32x4*)op = o0; *(f32x4*)(op + 4) = o1; } }
                    __builtin_amdgcn_sched_barrier(0); }
        }
    }
};

struct EpiGU {
    static constexpr bool PERM = true, AFTER_DRAIN = false;
    bf16_t* H; const float* ssq;
    __device__ __forceinline__ void operator()(const f32x4 (&acc)[2][2][4][2], const Unit& u, int wr, int wc, int fr_, int fq_) const {
        unsigned z_e = 0u; asm volatile("" : "+v"(z_e)); const int lane_e = (int)__builtin_amdgcn_mbcnt_hi(~0u, __builtin_amdgcn_mbcnt_lo(~0u, z_e)), fr = lane_e & 15, fq = lane_e >> 4; (void)fr_; (void)fq_;
        const int row0 = u.pm * BM + wr * 64 + fr, colh = u.pn * HALF + wc * 32 + 8 * fq;
        float rs[2][4];
#pragma unroll
        for (int ai = 0; ai < 2; ++ai)
#pragma unroll
            for (int m = 0; m < 4; ++m) rs[ai][m] = ssq[row0 + ai * HALF + m * 16];
#pragma unroll
        for (int ai = 0; ai < 2; ++ai)
#pragma unroll
            for (int m = 0; m < 4; ++m) { const int row = row0 + ai * HALF + m * 16; const float r = rsq(rs[ai][m] * (1.0f / 1024.0f) + EPS);
                const f32x4 g0 = acc[ai][0][m][0] * r, g1 = acc[ai][0][m][1] * r, u0 = acc[ai][1][m][0] * r, u1 = acc[ai][1][m][1] * r;
                f32x4 h0, h1;
#pragma unroll
                for (int e = 0; e < 4; ++e) { h0[e] = silu_f(g0[e]) * u0[e]; h1[e] = silu_f(g1[e]) * u1[e]; }
                u32x4 w; w.x = pk2(h0[0], h0[1]); w.y = pk2(h0[2], h0[3]); w.z = pk2(h1[0], h1[1]); w.w = pk2(h1[2], h1[3]);
                *(u32x4*)(H + (size_t)row * DFF + colh) = w; }
    }
};

struct EpiRes {
    static constexpr bool PERM = true, AFTER_DRAIN = false;
    float* out; bf16_t* XB; float* ssq; int final_f32;
    __device__ __forceinline__ void operator()(const f32x4 (&acc)[2][2][4][2], const Unit& u, int wr, int wc, int fr_, int fq_) const {
        unsigned z_e = 0u; asm volatile("" : "+v"(z_e)); const int lane_e = (int)__builtin_amdgcn_mbcnt_hi(~0u, __builtin_amdgcn_mbcnt_lo(~0u, z_e)), fr = lane_e & 15, fq = lane_e >> 4; (void)fr_; (void)fq_;
        const int col0 = u.pn * BM + wc * 32 + 8 * fq;
#pragma unroll
        for (int ai = 0; ai < 2; ++ai)
#pragma unroll
            for (int m = 0; m < 4; ++m) { const size_t row = (size_t)u.pm * BM + ai * HALF + wr * 64 + m * 16 + fr; float ss = 0.f;
#pragma unroll
                for (int bj = 0; bj < 2; ++bj) { bf16_t* xp = XB + row * 1024 + col0 + bj * HALF;
                    const u32x4 xw = *(const u32x4*)xp;
                    const f32x4 o0 = (f32x4){bflo(xw.x), bfhi(xw.x), bflo(xw.y), bfhi(xw.y)} + acc[ai][bj][m][0], o1 = (f32x4){bflo(xw.z), bfhi(xw.z), bflo(xw.w), bfhi(xw.w)} + acc[ai][bj][m][1];
                    if (final_f32) { float* op = out + row * 1024 + col0 + bj * HALF; *(f32x4*)op = o0; *(f32x4*)(op + 4) = o1; }
                    else { u32x4 w; w.x = pk2(o0[0], o0[1]); w.y = pk2(o0[2], o0[3]); w.z = pk2(o1[0], o1[1]); w.w = pk2(o1[2], o1[3]); *(u32x4*)xp = w; ss += dot4(o0) + dot4(o1); } }
                if (!final_f32) { ss = sum32(sum16(ss)); if (fq == 0) atomicAdd(ssq + row, ss); }
                if (m & 1) asm volatile("" ::: "memory"); }
    }
};

struct EpiQ {
    static constexpr bool PERM = true, AFTER_DRAIN = false;
    bf16_t* QNP; bf16_t* QRP; const float* gqn; const float* gqr; const float* rope; const float* ssqQ;
    __device__ __forceinline__ void operator()(const f32x4 (&acc)[2][2][4][2], const Unit& u, int wr, int wc, int fr_, int fq_) const {
        unsigned z_e = 0u; asm volatile("" : "+v"(z_e)); const int lane_e = (int)__builtin_amdgcn_mbcnt_hi(~0u, __builtin_amdgcn_mbcnt_lo(~0u, z_e)), fr = lane_e & 15, fq = lane_e >> 4; (void)fr_; (void)fq_;
        const int row0 = u.pm * BM + wr * 64 + fr;
        float rq[2][4];
#pragma unroll
        for (int ai = 0; ai < 2; ++ai)
#pragma unroll
            for (int m = 0; m < 4; ++m) rq[ai][m] = ssqQ[row0 + ai * HALF + m * 16];
#pragma unroll
        for (int ai = 0; ai < 2; ++ai)
#pragma unroll
            for (int m = 0; m < 4; ++m) rq[ai][m] = rsq(rq[ai][m] * (1.0f / 256.0f) + EPS);
        if (u.pn < 2) {
            const int head = 4 * u.pn + wc;
            f32x4 gv[2][2];
#pragma unroll
            for (int bj = 0; bj < 2; ++bj)
#pragma unroll
                for (int n = 0; n < 2; ++n) gv[bj][n] = *(const f32x4*)(gqn + 32 * bj + 8 * fq + 4 * n) * QSCALE;
#pragma unroll
            for (int ai = 0; ai < 2; ++ai)
#pragma unroll
                for (int m = 0; m < 4; ++m) { const int row = row0 + ai * HALF + m * 16;
                    float ss = (dot4(acc[ai][0][m][0]) + dot4(acc[ai][0][m][1])) + (dot4(acc[ai][1][m][0]) + dot4(acc[ai][1][m][1]));
                    ss = sum32(sum16(ss)) * (rq[ai][m] * rq[ai][m]);
                    const float rn = rsq(ss * (1.0f / 64.0f) + EPS) * rq[ai][m];
#pragma unroll
                    for (int bj = 0; bj < 2; ++bj) { const f32x4 v0 = acc[ai][bj][m][0] * gv[bj][0] * rn, v1 = acc[ai][bj][m][1] * gv[bj][1] * rn;
                        u32x4 w; w.x = pk2(v0[0], v0[1]); w.y = pk2(v0[2], v0[3]); w.z = pk2(v1[0], v1[1]); w.w = pk2(v1[2], v1[3]);
                        *(u32x4*)(QNP + (size_t)row * 512 + head * 64 + 32 * bj + 8 * fq) = w; }  __builtin_amdgcn_sched_barrier(0); }
        } else {
            const f32x4 g1 = *(const f32x4*)(gqr + 4 * fq) * QSCALE, g2 = *(const f32x4*)(gqr + 16 + 4 * fq) * QSCALE;
#pragma unroll
            for (int ai = 0; ai < 2; ++ai)
#pragma unroll
                for (int m = 0; m < 4; ++m) { const int row = row0 + ai * HALF + m * 16;
                    const int posidx = row < MP ? (row & 2047) : 2048 + ((row - MP) & 63);
                    const float* rp = rope + (size_t)(posidx * 16 + 4 * fq) * 2;
                    const f32x4 cs0 = *(const f32x4*)rp, cs1 = *(const f32x4*)(rp + 4);
                    const f32x4 cc = {cs0[0], cs0[2], cs1[0], cs1[2]}, sn = {cs0[1], cs0[3], cs1[1], cs1[3]};
#pragma unroll
                    for (int bj = 0; bj < 2; ++bj) { const f32x4 x1 = acc[ai][bj][m][0], x2 = acc[ai][bj][m][1];
                        float ss = dot4(x1) + dot4(x2); ss = sum32(sum16(ss)) * (rq[ai][m] * rq[ai][m]);
                        const float rn = rsq(ss * (1.0f / 32.0f) + EPS) * rq[ai][m];
                        const f32x4 a = x1 * g1 * rn, b = x2 * g2 * rn;
                        const f32x4 o1 = a * cc - b * sn, o2 = a * sn + b * cc;
                        const int head = 2 * wc + bj;
                        u32x2 w1, w2; w1.x = pk2(o1[0], o1[1]); w1.y = pk2(o1[2], o1[3]); w2.x = pk2(o2[0], o2[1]); w2.y = pk2(o2[2], o2[3]);
                        bf16_t* qp = QRP + (size_t)row * 256 + head * 32 + 4 * fq;
                        *(u32x2*)qp = w1; *(u32x2*)(qp + 16) = w2; }  __builtin_amdgcn_sched_barrier(0); }
        }
    }
};

struct EpiKV {
    static constexpr bool PERM = true, AFTER_DRAIN = false;
    bf16_t* KN; bf16_t* VV; const float* gkn; const float* ssqC;
    __device__ __forceinline__ void operator()(const f32x4 (&acc)[2][2][4][2], const Unit& u, int wr, int wc, int fr_, int fq_) const {
        unsigned z_e = 0u; asm volatile("" : "+v"(z_e)); const int lane_e = (int)__builtin_amdgcn_mbcnt_hi(~0u, __builtin_amdgcn_mbcnt_lo(~0u, z_e)), fr = lane_e & 15, fq = lane_e >> 4; (void)fr_; (void)fq_;
        const int row0 = u.pm * BM + wr * 64 + fr;
        float rc[2][4];
#pragma unroll
        for (int ai = 0; ai < 2; ++ai)
#pragma unroll
            for (int m = 0; m < 4; ++m) rc[ai][m] = ssqC ? ssqC[row0 + ai * HALF + m * 16] : 0.f;
#pragma unroll
        for (int ai = 0; ai < 2; ++ai)
#pragma unroll
            for (int m = 0; m < 4; ++m) rc[ai][m] = ssqC ? rsq(rc[ai][m] * (1.0f / 128.0f) + EPS) : 1.0f;
        if (u.pn < 2) {
            const int head = 4 * u.pn + wc;
            f32x4 gv[2][2];
#pragma unroll
            for (int bj = 0; bj < 2; ++bj)
#pragma unroll
                for (int n = 0; n < 2; ++n) gv[bj][n] = *(const f32x4*)(gkn + 32 * bj + 8 * fq + 4 * n);
#pragma unroll
            for (int ai = 0; ai < 2; ++ai)
#pragma unroll
                for (int m = 0; m < 4; ++m) { const int row = row0 + ai * HALF + m * 16;
                    float ss = (dot4(acc[ai][0][m][0]) + dot4(acc[ai][0][m][1])) + (dot4(acc[ai][1][m][0]) + dot4(acc[ai][1][m][1]));
                    ss = sum32(sum16(ss)) * (rc[ai][m] * rc[ai][m]);
                    const float rn = rsq(ss * (1.0f / 64.0f) + EPS) * rc[ai][m];
#pragma unroll
                    for (int bj = 0; bj < 2; ++bj) { const f32x4 v0 = acc[ai][bj][m][0] * gv[bj][0] * rn, v1 = acc[ai][bj][m][1] * gv[bj][1] * rn;
                        u32x4 w; w.x = pk2(v0[0], v0[1]); w.y = pk2(v0[2], v0[3]); w.z = pk2(v1[0], v1[1]); w.w = pk2(v1[2], v1[3]);
                        *(u32x4*)(KN + (size_t)row * 512 + head * 64 + 32 * bj + 8 * fq) = w; }  __builtin_amdgcn_sched_barrier(0); }
        } else {
            const int head = 4 * (u.pn - 2) + wc;
#pragma unroll
            for (int ai = 0; ai < 2; ++ai)
#pragma unroll
                for (int m = 0; m < 4; ++m) { const int row = row0 + ai * HALF + m * 16;
#pragma unroll
                    for (int bj = 0; bj < 2; ++bj) { const f32x4 v0 = acc[ai][bj][m][0] * rc[ai][m], v1 = acc[ai][bj][m][1] * rc[ai][m];
                        u32x4 w; w.x = pk2(v0[0], v0[1]); w.y = pk2(v0[2], v0[3]); w.z = pk2(v1[0], v1[1]); w.w = pk2(v1[2], v1[3]);
                        *(u32x4*)(VV + (size_t)row * 512 + head * 64 + 32 * bj + 8 * fq) = w; }  __builtin_amdgcn_sched_barrier(0); }
        }
    }
};

template <class Epi, class Sched, bool ALIGN_EPI = false, bool SP2 = false>
__device__ __forceinline__ void gemm_phase(PG8_LAS unsigned char* lds, const Gemm g, const Sched& S, const Epi& E, const int wid_in) {
    int wid = wid_in; asm volatile("" : "+s"(wid));
    unsigned z_ = 0u; asm volatile("" : "+v"(z_)); const int lane_ = (int)__builtin_amdgcn_mbcnt_hi(~0u, __builtin_amdgcn_mbcnt_lo(~0u, z_));
    const int lane = lane_, tid = wid * 64 + lane, wr = wid >> 2, wc = wid & 3, fr = lane & 15, fq = lane >> 4;
    const int K = g.K, nt = K / BK;
    unsigned voffA[2], voffB[2];
#pragma unroll
    for (int i = 0; i < 2; ++i) { int R, C; stage_rc(tid * 16 + i * 8192, R, C); const int Rb = Epi::PERM ? ((R & ~31) + perm32(R & 31)) : R;
        voffA[i] = (unsigned)(R * g.lda + C) * 2u; voffB[i] = (unsigned)(Rb * K + C) * 2u; }
    const size_t kstep = (size_t)(BK * 2);
    const size_t hstepA = (size_t)HALF * g.lda * 2, hstepB = (size_t)HALF * K * 2;
    const size_t tstepA = 2 * hstepA, tstepB = 2 * hstepB;
    const unsigned ldsw = (unsigned)wid * 1024u;
    const int aoff = lds_byte(wr * 64 + fr, fq * 8), boff = lds_byte(wc * 32 + fr, fq * 8);
#define PG8_SA(b, h) (((b) * 2 + (h)) * HTB)
#define PG8_SB(b, h) ((4 + (b) * 2 + (h)) * HTB)
#define PG8_STAGE(bufoff, gbase, voff) do { _Pragma("unroll") for (int _i = 0; _i < 2; ++_i) \
        __builtin_amdgcn_global_load_lds((const unsigned*)((const char*)(gbase) + (voff)[_i]), (PG8_LAS unsigned*)(lds + (bufoff) + ldsw + _i * 8192), 16, 0, 0); } while (0)
#define PG8_LDA(dst, b, h) do { _Pragma("unroll") for (int m = 0; m < 4; ++m) _Pragma("unroll") for (int k = 0; k < 2; ++k) dst[m][k] = *(const PG8_LAS bf16x8*)(lds + PG8_SA(b, h) + aoff + m * 2048 + k * 1024); } while (0)
#define PG8_LDB(dst, b, h) do { _Pragma("unroll") for (int n = 0; n < 2; ++n) _Pragma("unroll") for (int k = 0; k < 2; ++k) dst[n][k] = *(const PG8_LAS bf16x8*)(lds + PG8_SB(b, h) + boff + n * 2048 + k * 1024); } while (0)
#define PG8_MMA(ai, bj, At, Bt) do { __builtin_amdgcn_s_setprio(1); _Pragma("unroll") for (int m = 0; m < 4; ++m) _Pragma("unroll") for (int n = 0; n < 2; ++n) _Pragma("unroll") for (int k = 0; k < 2; ++k) \
        acc[ai][bj][m][n] = __builtin_amdgcn_mfma_f32_16x16x32_bf16(Bt[n][k], At[m][k], acc[ai][bj][m][n], 0, 0, 0); __builtin_amdgcn_s_setprio(0); } while (0)
#define PG8_WAIT_V(n) asm volatile("s_waitcnt vmcnt(" #n ")" ::: "memory")
#define PG8_WAIT_L(n) asm volatile("s_waitcnt lgkmcnt(" #n ")" ::: "memory")
#define PG8_BAR __builtin_amdgcn_s_barrier()
#define PG8_SCHED __builtin_amdgcn_sched_barrier(0)
    Unit cur, nxt; int ui = 0;
    if (!S.next(0, cur)) return;
    f32x4 acc[2][2][4][2];
#pragma unroll
    for (int a = 0; a < 2; ++a)
#pragma unroll
        for (int b = 0; b < 2; ++b)
#pragma unroll
            for (int m = 0; m < 4; ++m)
#pragma unroll
                for (int n = 0; n < 2; ++n) acc[a][b][m][n] = (f32x4){0.f, 0.f, 0.f, 0.f};
    bf16x8 At[4][2], B0[2][2], B1[2][2];
    const char* cA = (const char*)g.A + (size_t)cur.pm * tstepA; const char* cB = (const char*)g.Bt + (size_t)cur.pn * tstepB;
    S.a_ready(cur);
    if constexpr (SP2) {
        PG8_STAGE(PG8_SB(0, 0), cB, voffB); PG8_STAGE(PG8_SB(0, 1), cB + hstepB, voffB); PG8_STAGE(PG8_SA(0, 0), cA, voffA); PG8_STAGE(PG8_SA(0, 1), cA + hstepA, voffA);
        if (wr == 1) PG8_BAR;
        PG8_WAIT_V(2); PG8_BAR;
        PG8_STAGE(PG8_SB(1, 0), cB + kstep, voffB); PG8_STAGE(PG8_SA(1, 0), cA + kstep, voffA); PG8_STAGE(PG8_SB(1, 1), cB + hstepB + kstep, voffB);
        PG8_WAIT_V(6); PG8_BAR;
    } else {
        PG8_STAGE(PG8_SB(0, 0), cB, voffB); PG8_STAGE(PG8_SA(0, 0), cA, voffA); PG8_STAGE(PG8_SB(0, 1), cB + hstepB, voffB); PG8_STAGE(PG8_SA(0, 1), cA + hstepA, voffA);
        if (wr == 1) PG8_BAR;
        PG8_WAIT_V(4); PG8_BAR;
        PG8_STAGE(PG8_SB(1, 0), cB + kstep, voffB); PG8_STAGE(PG8_SA(1, 0), cA + kstep, voffA); PG8_STAGE(PG8_SB(1, 1), cB + hstepB + kstep, voffB);
        PG8_WAIT_V(6); PG8_BAR;
    }
    for (;;) {
        const bool has_next = S.next(ui + 1, nxt);
        const char* nA = has_next ? (const char*)g.A + (size_t)nxt.pm * tstepA : cA; const char* nB = has_next ? (const char*)g.Bt + (size_t)nxt.pn * tstepB : cB;
        for (int t = 0; t < nt; t += 2) {
            const bool last = (t == nt - 2);
            const char* a1 = cA + (size_t)(t + 1) * kstep;
            const char* a2 = last ? nA : cA + (size_t)(t + 2) * kstep; const char* b2 = last ? nB : cB + (size_t)(t + 2) * kstep;
            const char* a3 = a2 + kstep; const char* b3 = b2 + kstep;
            if (last && has_next) S.a_ready(nxt);
            if constexpr (SP2) {
            PG8_LDB(B0, 0, 0); PG8_LDB(B1, 0, 1); PG8_SCHED; PG8_LDA(At, 0, 0); PG8_STAGE(PG8_SA(1, 1), a1 + hstepA, voffA);
            PG8_WAIT_V(8); PG8_WAIT_L(0); PG8_BAR; PG8_MMA(0, 0, At, B0); PG8_MMA(0, 1, At, B1); PG8_BAR; PG8_SCHED;
            PG8_LDA(At, 0, 1); PG8_STAGE(PG8_SB(0, 0), b2, voffB); PG8_STAGE(PG8_SB(0, 1), b2 + hstepB, voffB); PG8_STAGE(PG8_SA(0, 0), a2, voffA);
            PG8_WAIT_V(8); PG8_WAIT_L(0); PG8_BAR; PG8_MMA(1, 0, At, B0); PG8_MMA(1, 1, At, B1); PG8_BAR; PG8_SCHED;
            PG8_LDB(B0, 1, 0); PG8_LDB(B1, 1, 1); PG8_SCHED; PG8_LDA(At, 1, 0); PG8_STAGE(PG8_SA(0, 1), a2 + hstepA, voffA);
            PG8_WAIT_V(8); PG8_WAIT_L(0); PG8_BAR; PG8_MMA(0, 0, At, B0); PG8_MMA(0, 1, At, B1); PG8_BAR; PG8_SCHED;
            PG8_LDA(At, 1, 1); PG8_STAGE(PG8_SB(1, 0), b3, voffB); PG8_STAGE(PG8_SB(1, 1), b3 + hstepB, voffB); PG8_STAGE(PG8_SA(1, 0), a3, voffA);
            PG8_WAIT_V(8); PG8_WAIT_L(0); PG8_BAR; PG8_MMA(1, 0, At, B0); PG8_MMA(1, 1, At, B1); PG8_BAR; PG8_SCHED;
            } else {
            PG8_LDB(B0, 0, 0); PG8_SCHED; PG8_LDA(At, 0, 0); PG8_STAGE(PG8_SA(1, 1), a1 + hstepA, voffA);
            PG8_WAIT_L(8); PG8_BAR; PG8_WAIT_L(0); PG8_MMA(0, 0, At, B0); PG8_BAR; PG8_SCHED;
            PG8_LDB(B1, 0, 1); PG8_STAGE(PG8_SB(0, 0), b2, voffB);
            PG8_BAR; PG8_WAIT_L(0); PG8_MMA(0, 1, At, B1); PG8_BAR;
            PG8_LDA(At, 0, 1); PG8_STAGE(PG8_SA(0, 0), a2, voffA);
            PG8_BAR; PG8_WAIT_L(0); PG8_MMA(1, 0, At, B0); PG8_BAR; PG8_SCHED;
            PG8_STAGE(PG8_SB(0, 1), b2 + hstepB, voffB);
            PG8_WAIT_V(6); PG8_BAR; PG8_MMA(1, 1, At, B1); PG8_BAR;
            PG8_LDB(B0, 1, 0); PG8_SCHED; PG8_LDA(At, 1, 0); PG8_STAGE(PG8_SA(0, 1), a2 + hstepA, voffA);
            PG8_WAIT_L(8); PG8_BAR; PG8_WAIT_L(0); PG8_MMA(0, 0, At, B0); PG8_BAR; PG8_SCHED;
            PG8_LDB(B1, 1, 1); PG8_STAGE(PG8_SB(1, 0), b3, voffB);
            PG8_BAR; PG8_WAIT_L(0); PG8_MMA(0, 1, At, B1); PG8_BAR;
            PG8_LDA(At, 1, 1); PG8_STAGE(PG8_SA(1, 0), a3, voffA);
            PG8_BAR; PG8_WAIT_L(0); PG8_MMA(1, 0, At, B0); PG8_BAR; PG8_SCHED;
            PG8_STAGE(PG8_SB(1, 1), b3 + hstepB, voffB);
            PG8_WAIT_V(6); PG8_BAR; PG8_MMA(1, 1, At, B1); PG8_BAR;
            }
        }
        if constexpr (ALIGN_EPI) { if (wr == 0) PG8_BAR; }
        if constexpr (!Epi::AFTER_DRAIN) { E(acc, cur, wr, wc, fr, fq); S.done(cur); }
        if (!has_next) break;
#pragma unroll
        for (int a = 0; a < 2; ++a)
#pragma unroll
            for (int b = 0; b < 2; ++b)
#pragma unroll
                for (int m = 0; m < 4; ++m)
#pragma unroll
                    for (int n = 0; n < 2; ++n) acc[a][b][m][n] = (f32x4){0.f, 0.f, 0.f, 0.f};
        cur = nxt; cA = nA; cB = nB; ++ui;
        if constexpr (ALIGN_EPI) { if (wr == 1) PG8_BAR; }
    }
    PG8_WAIT_V(0);
    if constexpr (!ALIGN_EPI) { if (wr == 0) PG8_BAR; }
    PG8_BAR;
    if constexpr (Epi::AFTER_DRAIN) { E.fused(acc, cur, wr, wc, fr, fq, lds, wid, lane); S.done(cur); }
#undef PG8_SA
#undef PG8_SB
#undef PG8_STAGE
#undef PG8_LDA
#undef PG8_LDB
#undef PG8_MMA
#undef PG8_WAIT_V
#undef PG8_WAIT_L
#undef PG8_BAR
#undef PG8_SCHED
}
}
namespace att {
constexpr int KSTR = 208, VSTR = 192, KB_BYTES = 64 * KSTR, VB_BYTES = 64 * VSTR, TILE_BYTES = KB_BYTES + VB_BYTES;
typedef short v4i16_t __attribute__((ext_vector_type(4)));
__device__ __forceinline__ s16x4 vtr(const LAS char* p) { return __builtin_bit_cast(s16x4, __builtin_amdgcn_ds_read_tr16_b64_v4i16((LAS v4i16_t*)p)); }
__device__ __forceinline__ bf16x8 cat8(s16x4 lo, s16x4 hi) { return (bf16x8){lo[0], lo[1], lo[2], lo[3], hi[0], hi[1], hi[2], hi[3]}; }

struct Ptrs { const bf16* QNP; const bf16* QRP; const bf16* KN; const bf16* VV; const bf16* KR; bf16* MRG; const float* gout; };
struct Stage { u32x4 kn, kr, vv; };

__device__ __forceinline__ void stage_load(Stage& s, const Ptrs& P, size_t krow0, int h, int tid) {
    const int row = tid >> 3, ch = tid & 7;
    s.kn = *(const u32x4*)(P.KN + (krow0 + row) * 512 + h * 64 + ch * 8);
    s.vv = *(const u32x4*)(P.VV + (krow0 + row) * 512 + h * 64 + ch * 8);
    s.kr = (u32x4){0u, 0u, 0u, 0u};
    if (tid < 256) { const int r2 = tid >> 2, c2 = tid & 3; s.kr = *(const u32x4*)(P.KR + (krow0 + r2) * 32 + c2 * 8); }
}
__device__ __forceinline__ void stage_store(const Stage& s, LAS char* buf, int tid) {
    const int row = tid >> 3, ch = tid & 7;
    *(LAS u32x4*)(buf + row * KSTR + ch * 16) = s.kn;
    *(LAS u32x4*)(buf + KB_BYTES + row * VSTR + ch * 16) = s.vv;
    if (tid < 256) { const int r2 = tid >> 2, c2 = tid & 3; *(LAS u32x4*)(buf + r2 * KSTR + 128 + c2 * 16) = s.kr; }
}
__device__ __forceinline__ void load_q(bf16x8 (&qf)[6], const Ptrs& P, size_t qrow, int h, int hi) {
#pragma unroll
    for (int s = 0; s < 4; ++s) qf[s] = *(const bf16x8*)(P.QNP + qrow * 512 + h * 64 + 16 * s + 8 * hi);
#pragma unroll
    for (int s = 0; s < 2; ++s) qf[4 + s] = *(const bf16x8*)(P.QRP + qrow * 256 + h * 32 + 16 * s + 8 * hi);
}

template <bool FIRST>
__device__ __forceinline__ void attn_tile(const LAS char* buf, const bf16x8 (&qf)[6], float& mrun, float& lrun, f32x16& o0, f32x16& o1, f32x16& negm, int lane) {
    const int r32 = lane & 31, hi = lane >> 5;
    const LAS char* kp = buf + r32 * KSTR + hi * 16;
    f32x16 p0, p1;
    { const bf16x8 a0 = *(const LAS bf16x8*)(kp), a1 = *(const LAS bf16x8*)(kp + 32 * KSTR);
      if (FIRST) { const f32x16 z = {}; p0 = __builtin_amdgcn_mfma_f32_32x32x16_bf16(a0, qf[0], z, 0, 0, 0); p1 = __builtin_amdgcn_mfma_f32_32x32x16_bf16(a1, qf[0], z, 0, 0, 0); }
      else { p0 = __builtin_amdgcn_mfma_f32_32x32x16_bf16(a0, qf[0], negm, 0, 0, 0); p1 = __builtin_amdgcn_mfma_f32_32x32x16_bf16(a1, qf[0], negm, 0, 0, 0); } }
#pragma unroll
    for (int s = 1; s < 6; ++s) {
        const bf16x8 a0 = *(const LAS bf16x8*)(kp + s * 32), a1 = *(const LAS bf16x8*)(kp + 32 * KSTR + s * 32);
        p0 = __builtin_amdgcn_mfma_f32_32x32x16_bf16(a0, qf[s], p0, 0, 0, 0);
        p1 = __builtin_amdgcn_mfma_f32_32x32x16_bf16(a1, qf[s], p1, 0, 0, 0);
    }
    float mx = fmaxf(p0[0], p1[0]);
#pragma unroll
    for (int r = 1; r < 16; ++r) mx = fmaxf(mx, fmaxf(p0[r], p1[r]));
    mx = max32(mx);
    if (FIRST) {
        mrun = mx;
#pragma unroll
        for (int r = 0; r < 16; ++r) { p0[r] -= mx; p1[r] -= mx; negm[r] = -mx; }
    } else if (__any(mx > 6.0f)) {
        const float dl = fmaxf(mx, 0.f), alpha = __builtin_amdgcn_exp2f(-dl);
        mrun += dl; lrun *= alpha;
#pragma unroll
        for (int r = 0; r < 16; ++r) { p0[r] -= dl; p1[r] -= dl; negm[r] = -mrun; }
        o0 *= alpha; o1 *= alpha;
    }
    float sum = 0.f;
#pragma unroll
    for (int r = 0; r < 16; ++r) { p0[r] = __builtin_amdgcn_exp2f(p0[r]); p1[r] = __builtin_amdgcn_exp2f(p1[r]); sum += p0[r] + p1[r]; }
    lrun += sum;
    u32x4 pw[4];
#pragma unroll
    for (int j = 0; j < 4; ++j) { pw[0][j] = pk2(p0[2 * j], p0[2 * j + 1]); pw[1][j] = pk2(p0[8 + 2 * j], p0[8 + 2 * j + 1]); pw[2][j] = pk2(p1[2 * j], p1[2 * j + 1]); pw[3][j] = pk2(p1[8 + 2 * j], p1[8 + 2 * j + 1]); }
    const LAS char* vp = buf + KB_BYTES + (4 * hi + ((lane & 15) >> 2)) * VSTR + (16 * ((lane >> 4) & 1) + 4 * (lane & 3)) * 2;
#pragma unroll
    for (int ks = 0; ks < 4; ++ks) {
        const bf16x8 pf = __builtin_bit_cast(bf16x8, pw[ks]);
        const bf16x8 v0 = cat8(vtr(vp + ks * 16 * VSTR), vtr(vp + (ks * 16 + 8) * VSTR));
        const bf16x8 v1 = cat8(vtr(vp + ks * 16 * VSTR + 64), vtr(vp + (ks * 16 + 8) * VSTR + 64));
        o0 = __builtin_amdgcn_mfma_f32_32x32x16_bf16(v0, pf, o0, 0, 0, 0);
        o1 = __builtin_amdgcn_mfma_f32_32x32x16_bf16(v1, pf, o1, 0, 0, 0);
    }
}

__device__ __forceinline__ void finalize(const Ptrs& P, size_t qrow, int h, float lrun, f32x16& o0, f32x16& o1, int lane) {
    const int hi = lane >> 5;
    const float l = sum32(lrun), inv = 1.0f / l;
    o0 *= inv; o1 *= inv;
    float ss = 0.f;
#pragma unroll
    for (int r = 0; r < 16; ++r) ss += o0[r] * o0[r] + o1[r] * o1[r];
    ss = sum32(ss);
    const float rn = rsq(ss * (1.0f / 64.0f) + EPS);
    const float* g = P.gout + h * 64; bf16* op = P.MRG + qrow * 1024 + h * 64;
#pragma unroll
    for (int rg = 0; rg < 4; ++rg) { const int d0 = 8 * rg + 4 * hi;
        const f32x4 g0 = *(const f32x4*)(g + d0), g1 = *(const f32x4*)(g + 32 + d0);
        u32x2 w0, w1;
        w0.x = pk2(o0[4 * rg] * rn * g0[0], o0[4 * rg + 1] * rn * g0[1]); w0.y = pk2(o0[4 * rg + 2] * rn * g0[2], o0[4 * rg + 3] * rn * g0[3]);
        w1.x = pk2(o1[4 * rg] * rn * g1[0], o1[4 * rg + 1] * rn * g1[1]); w1.y = pk2(o1[4 * rg + 2] * rn * g1[2], o1[4 * rg + 3] * rn * g1[3]);
        *(u32x2*)(op + d0) = w0; *(u32x2*)(op + 32 + d0) = w1; }
}

template <bool FIRST>
__device__ __forceinline__ void attn_tile2(const LAS char* bufA, const LAS char* bufB, int nv, const bf16x8 (&qf)[6], float& mrun, float& lrun, f32x16& o0, f32x16& o1, f32x16& negm, int lane) {
    const int r32 = lane & 31, hi = lane >> 5;
    const LAS char* kpa = bufA + r32 * KSTR + hi * 16; const LAS char* kpb = bufB + r32 * KSTR + hi * 16;
    f32x16 p0, p1, p2, p3;
    { const bf16x8 a0 = *(const LAS bf16x8*)(kpa), a1 = *(const LAS bf16x8*)(kpa + 32 * KSTR), a2 = *(const LAS bf16x8*)(kpb), a3 = *(const LAS bf16x8*)(kpb + 32 * KSTR);
      if (FIRST) { const f32x16 z = {}; p0 = __builtin_amdgcn_mfma_f32_32x32x16_bf16(a0, qf[0], z, 0, 0, 0); p1 = __builtin_amdgcn_mfma_f32_32x32x16_bf16(a1, qf[0], z, 0, 0, 0);
                   p2 = __builtin_amdgcn_mfma_f32_32x32x16_bf16(a2, qf[0], z, 0, 0, 0); p3 = __builtin_amdgcn_mfma_f32_32x32x16_bf16(a3, qf[0], z, 0, 0, 0); }
      else { p0 = __builtin_amdgcn_mfma_f32_32x32x16_bf16(a0, qf[0], negm, 0, 0, 0); p1 = __builtin_amdgcn_mfma_f32_32x32x16_bf16(a1, qf[0], negm, 0, 0, 0);
             p2 = __builtin_amdgcn_mfma_f32_32x32x16_bf16(a2, qf[0], negm, 0, 0, 0); p3 = __builtin_amdgcn_mfma_f32_32x32x16_bf16(a3, qf[0], negm, 0, 0, 0); } }
#pragma unroll
    for (int s = 1; s < 6; ++s) {
        const bf16x8 a0 = *(const LAS bf16x8*)(kpa + s * 32), a1 = *(const LAS bf16x8*)(kpa + 32 * KSTR + s * 32), a2 = *(const LAS bf16x8*)(kpb + s * 32), a3 = *(const LAS bf16x8*)(kpb + 32 * KSTR + s * 32);
        p0 = __builtin_amdgcn_mfma_f32_32x32x16_bf16(a0, qf[s], p0, 0, 0, 0); p1 = __builtin_amdgcn_mfma_f32_32x32x16_bf16(a1, qf[s], p1, 0, 0, 0);
        p2 = __builtin_amdgcn_mfma_f32_32x32x16_bf16(a2, qf[s], p2, 0, 0, 0); p3 = __builtin_amdgcn_mfma_f32_32x32x16_bf16(a3, qf[s], p3, 0, 0, 0);
    }
    if (nv < 2) {
#pragma unroll
        for (int r = 0; r < 16; ++r) { p2[r] = -1e30f; p3[r] = -1e30f; } }
    float mx = fmaxf(fmaxf(p0[0], p1[0]), fmaxf(p2[0], p3[0]));
#pragma unroll
    for (int r = 1; r < 16; ++r) mx = fmaxf(mx, fmaxf(fmaxf(p0[r], p1[r]), fmaxf(p2[r], p3[r])));
    mx = max32(mx);
    if (FIRST) {
        mrun = mx;
#pragma unroll
        for (int r = 0; r < 16; ++r) { p0[r] -= mx; p1[r] -= mx; p2[r] -= mx; p3[r] -= mx; negm[r] = -mx; }
    } else if (__any(mx > 6.0f)) {
        const float dl = fmaxf(mx, 0.f), alpha = __builtin_amdgcn_exp2f(-dl);
        mrun += dl; lrun *= alpha;
#pragma unroll
        for (int r = 0; r < 16; ++r) { p0[r] -= dl; p1[r] -= dl; p2[r] -= dl; p3[r] -= dl; negm[r] = -mrun; }
        o0 *= alpha; o1 *= alpha;
    }
    float sa = 0.f, sb = 0.f;
#pragma unroll
    for (int r = 0; r < 16; ++r) { p0[r] = __builtin_amdgcn_exp2f(p0[r]); p1[r] = __builtin_amdgcn_exp2f(p1[r]); p2[r] = __builtin_amdgcn_exp2f(p2[r]); p3[r] = __builtin_amdgcn_exp2f(p3[r]); sa += p0[r] + p1[r]; sb += p2[r] + p3[r]; }
    lrun += sa + sb;
    u32x4 pw[8];
#pragma unroll
    for (int j = 0; j < 4; ++j) { pw[0][j] = pk2(p0[2 * j], p0[2 * j + 1]); pw[1][j] = pk2(p0[8 + 2 * j], p0[8 + 2 * j + 1]); pw[2][j] = pk2(p1[2 * j], p1[2 * j + 1]); pw[3][j] = pk2(p1[8 + 2 * j], p1[8 + 2 * j + 1]);
                                  pw[4][j] = pk2(p2[2 * j], p2[2 * j + 1]); pw[5][j] = pk2(p2[8 + 2 * j], p2[8 + 2 * j + 1]); pw[6][j] = pk2(p3[2 * j], p3[2 * j + 1]); pw[7][j] = pk2(p3[8 + 2 * j], p3[8 + 2 * j + 1]); }
    const int voff = (4 * hi + ((lane & 15) >> 2)) * VSTR + (16 * ((lane >> 4) & 1) + 4 * (lane & 3)) * 2;
#pragma unroll
    for (int ks = 0; ks < 8; ++ks) {
        if (ks >= 4 && nv < 2) break;
        const LAS char* vp = (ks < 4 ? bufA : bufB) + KB_BYTES + voff;
        const int kk = ks & 3;
        const bf16x8 pf = __builtin_bit_cast(bf16x8, pw[ks]);
        const bf16x8 v0 = cat8(vtr(vp + kk * 16 * VSTR), vtr(vp + (kk * 16 + 8) * VSTR));
        const bf16x8 v1 = cat8(vtr(vp + kk * 16 * VSTR + 64), vtr(vp + (kk * 16 + 8) * VSTR + 64));
        o0 = __builtin_amdgcn_mfma_f32_32x32x16_bf16(v0, pf, o0, 0, 0, 0);
        o1 = __builtin_amdgcn_mfma_f32_32x32x16_bf16(v1, pf, o1, 0, 0, 0);
    }
}

template <bool PRE, bool NEXT>
__device__ __forceinline__ void prompt_unit(const Ptrs& P, int b, int h, int qb, size_t nrow, int nh, Stage& sa, Stage& sb, LAS char* lds, int tid_in, int lane_in, int wid) {
    int tid = tid_in, lane = lane_in; asm volatile("" : "+v"(tid), "+v"(lane));
    const size_t rowbase = (size_t)b * 2048; const int r32 = lane & 31, hi = lane >> 5;
    const size_t qrow = rowbase + qb * 256 + wid * 32 + r32;
    bf16x8 qf[6]; load_q(qf, P, qrow, h, hi);
    const int NT = 4 * qb + 4, myNT = 4 * qb + (wid >> 1) + 1, NP = NT >> 1;
    float mrun = 0.f, lrun = 0.f; f32x16 o0 = {}, o1 = {}, negm = {};
    if (!PRE) { stage_load(sa, P, rowbase, h, tid); stage_load(sb, P, rowbase + 64, h, tid); }
    stage_store(sa, lds, tid); stage_store(sb, lds + TILE_BYTES, tid); __syncthreads();
    stage_load(sa, P, rowbase + 128, h, tid); stage_load(sb, P, rowbase + 192, h, tid);
    for (int i = 0; i < NP; ++i) {
        LAS char* cur = lds + (i & 1) * (2 * TILE_BYTES); LAS char* nxt = lds + ((i + 1) & 1) * (2 * TILE_BYTES);
        const int nv = myNT - 2 * i;
        if (i == 0) attn_tile2<true>(cur, cur + TILE_BYTES, nv, qf, mrun, lrun, o0, o1, negm, lane);
        else if (nv >= 1) attn_tile2<false>(cur, cur + TILE_BYTES, nv, qf, mrun, lrun, o0, o1, negm, lane);
        if (i + 1 < NP) { stage_store(sa, nxt, tid); stage_store(sb, nxt + TILE_BYTES, tid); }
        __syncthreads();
        if (i + 2 < NP) { stage_load(sa, P, rowbase + (size_t)(2 * i + 4) * 64, h, tid); stage_load(sb, P, rowbase + (size_t)(2 * i + 5) * 64, h, tid); }
        else if (NEXT && i + 2 == NP) { int tid2 = tid; asm volatile("" : "+v"(tid2)); stage_load(sa, P, nrow, nh, tid2); stage_load(sb, P, nrow + 64, nh, tid2); }
    }
    finalize(P, qrow, h, lrun, o0, o1, lane);
}

constexpr int LSTR = 320, STILE_BYTES = KB_BYTES + 64 * LSTR;
struct SStage { u32x4 kn, kr, c0, c1; };
__device__ __forceinline__ void sstage_load(SStage& s, const Ptrs& P, const bf16* CL, size_t krow0, int h, int tid) {
    const int row = tid >> 3, ch = tid & 7;
    s.kn = *(const u32x4*)(P.KN + (krow0 + row) * 512 + h * 64 + ch * 8);
    if (tid < 256) { const int r2 = tid >> 2, c2 = tid & 3; s.kr = *(const u32x4*)(P.KR + (krow0 + r2) * 32 + c2 * 8); }
    const int lr = tid >> 4, lc = tid & 15;
    s.c0 = *(const u32x4*)(CL + (krow0 + lr) * 128 + lc * 8);
    s.c1 = *(const u32x4*)(CL + (krow0 + 32 + lr) * 128 + lc * 8);
}
__device__ __forceinline__ void sstage_store(const SStage& s, LAS char* buf, int tid) {
    const int row = tid >> 3, ch = tid & 7;
    *(LAS u32x4*)(buf + row * KSTR + ch * 16) = s.kn;
    if (tid < 256) { const int r2 = tid >> 2, c2 = tid & 3; *(LAS u32x4*)(buf + r2 * KSTR + 128 + c2 * 16) = s.kr; }
    const int lr = tid >> 4, lc = tid & 15;
    *(LAS u32x4*)(buf + KB_BYTES + lr * LSTR + lc * 16) = s.c0;
    *(LAS u32x4*)(buf + KB_BYTES + (32 + lr) * LSTR + lc * 16) = s.c1;
}
template <bool FIRST>
__device__ __forceinline__ void attn_tile_lat(const LAS char* buf, const bf16x8 (&qf)[6], float& mrun, float& lrun, f32x16 (&ol)[4], int lane) {
    const int r32 = lane & 31, hi = lane >> 5;
    const LAS char* kp = buf + r32 * KSTR + hi * 16;
    f32x16 p0 = {}, p1 = {};
#pragma unroll
    for (int s = 0; s < 6; ++s) {
        const bf16x8 a0 = *(const LAS bf16x8*)(kp + s * 32), a1 = *(const LAS bf16x8*)(kp + 32 * KSTR + s * 32);
        p0 = __builtin_amdgcn_mfma_f32_32x32x16_bf16(a0, qf[s], p0, 0, 0, 0);
        p1 = __builtin_amdgcn_mfma_f32_32x32x16_bf16(a1, qf[s], p1, 0, 0, 0);
    }
    float mx = fmaxf(p0[0], p1[0]);
#pragma unroll
    for (int r = 1; r < 16; ++r) mx = fmaxf(mx, fmaxf(p0[r], p1[r]));
    mx = max32(mx);
    const float mnew = FIRST ? mx : fmaxf(mrun, mx);
    if (!FIRST && __any(mnew > mrun)) { const float alpha = __builtin_amdgcn_exp2f(mrun - mnew); lrun *= alpha;
#pragma unroll
        for (int cb = 0; cb < 4; ++cb) ol[cb] *= alpha; }
    mrun = mnew;
    float sum = 0.f;
#pragma unroll
    for (int r = 0; r < 16; ++r) { p0[r] = __builtin_amdgcn_exp2f(p0[r] - mnew); p1[r] = __builtin_amdgcn_exp2f(p1[r] - mnew); sum += p0[r] + p1[r]; }
    lrun += sum;
    u32x4 pw[4];
#pragma unroll
    for (int j = 0; j < 4; ++j) { pw[0][j] = pk2(p0[2 * j], p0[2 * j + 1]); pw[1][j] = pk2(p0[8 + 2 * j], p0[8 + 2 * j + 1]); pw[2][j] = pk2(p1[2 * j], p1[2 * j + 1]); pw[3][j] = pk2(p1[8 + 2 * j], p1[8 + 2 * j + 1]); }
    const LAS char* vp = buf + KB_BYTES + (4 * hi + ((lane & 15) >> 2)) * LSTR + (16 * ((lane >> 4) & 1) + 4 * (lane & 3)) * 2;
#pragma unroll
    for (int ks = 0; ks < 4; ++ks) {
        const bf16x8 pf = __builtin_bit_cast(bf16x8, pw[ks]);
#pragma unroll
        for (int cb = 0; cb < 4; ++cb) {
            const bf16x8 v = cat8(vtr(vp + ks * 16 * LSTR + cb * 64), vtr(vp + (ks * 16 + 8) * LSTR + cb * 64));
            ol[cb] = __builtin_amdgcn_mfma_f32_32x32x16_bf16(v, pf, ol[cb], 0, 0, 0);
        }
    }
}
__device__ __forceinline__ void project_v(const bf16* WkvT, int h, const f32x16 (&ol)[4], f32x16& o0, f32x16& o1, int lane) {
    const int d_lo = lane & 31, hi = lane >> 5;
    const bf16* w0 = WkvT + (size_t)(256 * (2 + (h >> 2)) + 32 * (h & 3) + d_lo) * 128 + 4 * hi;
    const bf16* w1 = w0 + (size_t)128 * 128;
    o0 = f32x16{}; o1 = f32x16{};
#pragma unroll
    for (int s = 0; s < 8; ++s) {
        const int cb = s >> 1, rb = 8 * (s & 1), c0 = 32 * cb + 16 * (s & 1);
        u32x4 bw; bw.x = pk2(ol[cb][rb], ol[cb][rb + 1]); bw.y = pk2(ol[cb][rb + 2], ol[cb][rb + 3]); bw.z = pk2(ol[cb][rb + 4], ol[cb][rb + 5]); bw.w = pk2(ol[cb][rb + 6], ol[cb][rb + 7]);
        const bf16x8 bfr = __builtin_bit_cast(bf16x8, bw);
        const u32x2 a00 = *(const u32x2*)(w0 + c0), a01 = *(const u32x2*)(w0 + c0 + 8), a10 = *(const u32x2*)(w1 + c0), a11 = *(const u32x2*)(w1 + c0 + 8);
        const bf16x8 af0 = __builtin_bit_cast(bf16x8, (u32x4){a00.x, a00.y, a01.x, a01.y}), af1 = __builtin_bit_cast(bf16x8, (u32x4){a10.x, a10.y, a11.x, a11.y});
        o0 = __builtin_amdgcn_mfma_f32_32x32x16_bf16(af0, bfr, o0, 0, 0, 0);
        o1 = __builtin_amdgcn_mfma_f32_32x32x16_bf16(af1, bfr, o1, 0, 0, 0);
    }
}

__device__ __forceinline__ void sample_unit(const Ptrs& P, const bf16* CL  , const bf16* WkvT, int b, int h, int qk, float* part, unsigned* cnt, LAS char* lds, int tid_in, int lane_in, int wid) {
    int tid = tid_in, lane = lane_in; asm volatile("" : "+v"(tid), "+v"(lane));
    const int r32 = lane & 31, hi = lane >> 5, qblk = wid & 1, ks = wid >> 1;
    const size_t qrow = (size_t)MP + b * 64 + qblk * 32 + r32;
    bf16x8 qf[6]; load_q(qf, P, qrow, h, hi);
    float mrun = 0.f, lrun = 0.f; f32x16 ol[4] = {f32x16{}, f32x16{}, f32x16{}, f32x16{}};
    const size_t cbase = (size_t)MT + (size_t)b * 4096, nbase = (size_t)MP + b * 64;
    const int t0 = 16 * qk, ntile = (qk == 3) ? 17 : 16, nit = (ntile + 3) >> 2;
    SStage st[4];
#pragma unroll
    for (int j = 0; j < 4; ++j) { sstage_load(st[j], P, CL, cbase + (size_t)(t0 + j) * 64, h, tid); }
#pragma unroll
    for (int j = 0; j < 4; ++j) { sstage_store(st[j], lds + j * STILE_BYTES, tid); }
    __syncthreads();
    for (int it = 0; it < nit; ++it) {
        const int tn = 4 * (it + 1);
#pragma unroll
        for (int j = 0; j < 4; ++j) if (tn + j < ntile) sstage_load(st[j], P, CL, (t0 + tn + j < 64) ? cbase + (size_t)(t0 + tn + j) * 64 : nbase, h, tid);
        if (it == 0) attn_tile_lat<true>(lds + ks * STILE_BYTES, qf, mrun, lrun, ol, lane);
        else if (4 * it + ks < ntile) attn_tile_lat<false>(lds + ks * STILE_BYTES, qf, mrun, lrun, ol, lane);
        __syncthreads();
#pragma unroll
        for (int j = 0; j < 4; ++j) if (tn + j < ntile) sstage_store(st[j], lds + j * STILE_BYTES, tid);
        __syncthreads();
    }
    f32x16 o0, o1; project_v(WkvT, h, ol, o0, o1, lane);
    LAS float* xs = (LAS float*)lds;
    if (ks > 0) { LAS float* s = xs + ((ks - 1) * 2 + qblk) * (34 * 64) + lane; s[0] = mrun; s[64] = lrun;
#pragma unroll
        for (int r = 0; r < 16; ++r) { s[(2 + r) * 64] = o0[r]; s[(18 + r) * 64] = o1[r]; } }
    __syncthreads();
    float* mypart = part + ((size_t)((b * 8 + h) * 4 + qk) * 2 + qblk) * (34 * 64) + lane;
    if (ks == 0) {
        float mt = mrun, mo[3];
#pragma unroll
        for (int s = 0; s < 3; ++s) { mo[s] = xs[(s * 2 + qblk) * (34 * 64) + lane]; mt = fmaxf(mt, mo[s]); }
        const float a0 = __builtin_amdgcn_exp2f(mrun - mt); lrun *= a0; o0 *= a0; o1 *= a0; mrun = mt;
#pragma unroll
        for (int s = 0; s < 3; ++s) { const LAS float* sp = xs + (s * 2 + qblk) * (34 * 64) + lane; const float as = __builtin_amdgcn_exp2f(mo[s] - mt);
            lrun += sp[64] * as;
#pragma unroll
            for (int r = 0; r < 16; ++r) { o0[r] += sp[(2 + r) * 64] * as; o1[r] += sp[(18 + r) * 64] * as; } }
        mypart[0] = mrun; mypart[64] = lrun;
#pragma unroll
        for (int r = 0; r < 16; ++r) { mypart[(2 + r) * 64] = o0[r]; mypart[(18 + r) * 64] = o1[r]; }
    }
    asm volatile("s_waitcnt vmcnt(0)" ::: "memory");
    __syncthreads();
    LAS unsigned* flag = (LAS unsigned*)(lds + 6 * 34 * 64 * 4);
    if (tid == 0) {
        __builtin_amdgcn_fence(__ATOMIC_RELEASE, "agent");
        asm volatile("s_waitcnt vmcnt(0)" ::: "memory");
        const unsigned old = __hip_atomic_fetch_add(cnt + (b * 8 + h), 1u, __ATOMIC_RELAXED, __HIP_MEMORY_SCOPE_AGENT);
        if (old == 3u) { __builtin_amdgcn_fence(__ATOMIC_ACQUIRE, "agent"); asm volatile("s_waitcnt vmcnt(0)" ::: "memory"); }
        flag[0] = (old == 3u) ? 1u : 0u;
    }
    __syncthreads();
    if (flag[0] != 0u && ks == 0) {
        float mt = mrun, mo[3]; const float* op[3];
#pragma unroll
        for (int s = 0; s < 3; ++s) { const int q2 = (qk + 1 + s) & 3; op[s] = part + ((size_t)((b * 8 + h) * 4 + q2) * 2 + qblk) * (34 * 64) + lane; mo[s] = op[s][0]; mt = fmaxf(mt, mo[s]); }
        const float a0 = __builtin_amdgcn_exp2f(mrun - mt); lrun *= a0; o0 *= a0; o1 *= a0;
#pragma unroll
        for (int s = 0; s < 3; ++s) { const float as = __builtin_amdgcn_exp2f(mo[s] - mt);
            lrun += op[s][64] * as;
#pragma unroll
            for (int r = 0; r < 16; ++r) { o0[r] += op[s][(2 + r) * 64] * as; o1[r] += op[s][(18 + r) * 64] * as; } }
        finalize(P, qrow, h, lrun, o0, o1, lane);
    }
    __syncthreads();
}

struct GmPtrs { const bf16* VN; bf16* MRG; const bf16* WsB; const float* bs; const float* gog; };
constexpr int WSTR = 272, WS_LDS = 128 * WSTR;
__device__ __forceinline__ void gmlp_wg(const GmPtrs& G, int vcu, LAS char* lds, int tid_in, int lane_in, int wave) {
    int tid = tid_in, lane = lane_in; asm volatile("" : "+v"(tid), "+v"(lane));
    const int g = vcu & 7, cs = vcu >> 3;
    { const bf16* Wg = G.WsB + (size_t)g * 128 * 128;
#pragma unroll
      for (int k = 0; k < 4; ++k) { const int idx = k * 512 + tid, r = idx >> 4, ch = idx & 15;
          const u32x4 v = *(const u32x4*)(Wg + r * 128 + ch * 8); *(LAS u32x4*)(lds + r * WSTR + ch * 16) = v; } }
    __syncthreads();
    if (wave < 4 || (wave == 4 && cs < 8)) {
        int L; size_t row0;
        if (wave < 4) { const int cidx = 4 * cs + wave; row0 = (size_t)(cidx >> 4) * 2048 + (cidx & 15) * 128; L = 128; }
        else { row0 = (size_t)MP + cs * 64; L = 64; }
        LAS char* wl = lds + WS_LDS + wave * 12288;
        const int r32 = lane & 31, hi = lane >> 5, nib = L >> 5;
        f32x16 acc[4][2];
#pragma unroll
        for (int ib = 0; ib < 4; ++ib) { acc[ib][0] = f32x16{}; acc[ib][1] = f32x16{}; }
        const LAS char* vp = wl + (8 * hi + ((lane & 15) >> 2)) * VSTR + (16 * ((lane >> 4) & 1) + 4 * (lane & 3)) * 2;
        const LAS char* wp = lds + r32 * WSTR + hi * 16;
#pragma unroll
        for (int hj = 0; hj < 2; ++hj) {
            if (hj * 64 < L) {
#pragma unroll
                for (int k = 0; k < 8; ++k) { const int idx = k * 64 + lane, r = idx >> 3, ch = idx & 7;
                    const u32x4 v = *(const u32x4*)(G.VN + (row0 + 64 * hj + r) * 512 + g * 64 + ch * 8);
                    *(LAS u32x4*)(wl + r * VSTR + ch * 16) = v; }
#pragma unroll
                for (int ib = 0; ib < 4; ++ib) {
                    if (ib < nib && (hj == 0 || ib >= 2)) {
#pragma unroll
                        for (int ks = 0; ks < 4; ++ks) {
                            const bf16x8 bfr = *(const LAS bf16x8*)(wp + 32 * ib * WSTR + (64 * hj + 16 * ks) * 2);
                            const bf16x8 a0 = cat8(vtr(vp + ks * 16 * VSTR), vtr(vp + (ks * 16 + 4) * VSTR));
                            const bf16x8 a1 = cat8(vtr(vp + ks * 16 * VSTR + 64), vtr(vp + (ks * 16 + 4) * VSTR + 64));
                            acc[ib][0] = __builtin_amdgcn_mfma_f32_32x32x16_bf16(a0, bfr, acc[ib][0], 0, 0, 0);
                            acc[ib][1] = __builtin_amdgcn_mfma_f32_32x32x16_bf16(a1, bfr, acc[ib][1], 0, 0, 0);
                        }
                    }
                }
            }
        }
#pragma unroll
        for (int ib = 0; ib < 4; ++ib) {
            if (ib < nib) {
                const int i = 32 * ib + r32; const size_t row = row0 + i; const float bsv = G.bs[g * 128 + i];
                bf16* up = G.MRG + row * 1024 + 512 + g * 64; const float* gg = G.gog + g * 64;
                u32x2 ur[4][2];
#pragma unroll
                for (int rg = 0; rg < 4; ++rg) { const int d0 = 8 * rg + 4 * hi; ur[rg][0] = *(const u32x2*)(up + d0); ur[rg][1] = *(const u32x2*)(up + 32 + d0); }
                float ss = 0.f;
#pragma unroll
                for (int rg = 0; rg < 4; ++rg) {
                    const u32x2 u0 = ur[rg][0], u1 = ur[rg][1];
                    const float ua[4] = {bflo(u0.x), bfhi(u0.x), bflo(u0.y), bfhi(u0.y)}, ub[4] = {bflo(u1.x), bfhi(u1.x), bflo(u1.y), bfhi(u1.y)};
#pragma unroll
                    for (int e = 0; e < 4; ++e) { const float x0 = ua[e] * (acc[ib][0][4 * rg + e] + bsv), x1 = ub[e] * (acc[ib][1][4 * rg + e] + bsv);
                        acc[ib][0][4 * rg + e] = x0; acc[ib][1][4 * rg + e] = x1; ss += x0 * x0 + x1 * x1; } }
                ss = sum32(ss);
                const float rn = rsq(ss * (1.0f / 64.0f) + EPS);
#pragma unroll
                for (int rg = 0; rg < 4; ++rg) { const int d0 = 8 * rg + 4 * hi;
                    const f32x4 g0 = *(const f32x4*)(gg + d0), g1 = *(const f32x4*)(gg + 32 + d0);
                    u32x2 w0, w1;
                    w0.x = pk2(acc[ib][0][4 * rg] * rn * g0[0], acc[ib][0][4 * rg + 1] * rn * g0[1]); w0.y = pk2(acc[ib][0][4 * rg + 2] * rn * g0[2], acc[ib][0][4 * rg + 3] * rn * g0[3]);
                    w1.x = pk2(acc[ib][1][4 * rg] * rn * g1[0], acc[ib][1][4 * rg + 1] * rn * g1[1]); w1.y = pk2(acc[ib][1][4 * rg + 2] * rn * g1[2], acc[ib][1][4 * rg + 3] * rn * g1[3]);
                    *(u32x2*)(up + d0) = w0; *(u32x2*)(up + 32 + d0) = w1; }
            }
        }
    }
    __syncthreads();
}
}
typedef GAS unsigned gu32;
#define RLX_AGENT __ATOMIC_RELAXED, __HIP_MEMORY_SCOPE_AGENT
#define LDS_WAIT() asm volatile("s_waitcnt lgkmcnt(0)" ::: "memory")
#define VM_WAIT() asm volatile("s_waitcnt vmcnt(0)" ::: "memory")
#define XB_TMO      128
#define XB_XCNT(j)  (256  + 64 * (j))
#define XB_XSUB(j)  (1280 + 64 * (j))
#define XB_XGEN(j)  (2304 + 64 * (j))
#define XB_TOP      3328
#define XB_TOPGEN   3392
#define XCD_BAR_WORDS 3456
#define XB_SPIN_CAP (1u << 22)

__device__ __forceinline__ unsigned xb_ld(unsigned* p)              { return __hip_atomic_load(p, __ATOMIC_RELAXED, __HIP_MEMORY_SCOPE_AGENT); }
__device__ __forceinline__ unsigned xb_add(unsigned* p, unsigned v) { return __hip_atomic_fetch_add(p, v, __ATOMIC_RELAXED, __HIP_MEMORY_SCOPE_AGENT); }
__device__ __forceinline__ unsigned xb_xcc_id() { return (unsigned)__builtin_amdgcn_s_getreg((3 << 11) | 20) & 0xFu; }
#define XB_SPIN(cond, bar) do { unsigned _sp = 0; while (cond) { __builtin_amdgcn_s_sleep(1); \
    if ((++_sp & 255u) == 0u) { if (xb_ld(&(bar)[XB_TMO])) break; if (_sp > XB_SPIN_CAP) { atomicAdd(&(bar)[XB_TMO], 1u); break; } } } } while (0)

struct XcdBarrier {
    unsigned* bar; unsigned x;
    volatile LAS unsigned* st;
};

__device__ __forceinline__ bool xb_first_thread(int wave) { unsigned z = 0u; asm volatile("" : "+v"(z)); return wave == 0 && __builtin_amdgcn_mbcnt_hi(~0u, __builtin_amdgcn_mbcnt_lo(~0u, z)) == 0u; }
__device__ __forceinline__ XcdBarrier xcd_barrier_post(unsigned* bar, volatile LAS unsigned* st, int wave) {
    XcdBarrier b; b.bar = bar; b.x = xb_xcc_id(); b.st = st;
    if (xb_first_thread(wave)) (void)xb_add(&bar[XB_XCNT(b.x)], 1u);
    return b;
}
__device__ __forceinline__ void xcd_barrier_complete(unsigned* bar, unsigned x, unsigned& nloc, unsigned& nx) {
    const unsigned G = gridDim.x * gridDim.y * gridDim.z;
    unsigned sum, cnt, mine, sp = 0u;
    for (;;) {
        sum = 0u; cnt = 0u; mine = 0u;
#pragma unroll
        for (unsigned j = 0; j < 16; ++j) { const unsigned c = xb_ld(&bar[XB_XCNT(j)]); sum += c; cnt += (c > 0u) ? 1u : 0u; mine = (j == x) ? c : mine; }
        if (sum == G) break;
        __builtin_amdgcn_s_sleep(1);
        if ((++sp & 255u) == 0u) { if (xb_ld(&bar[XB_TMO])) break; if (sp > XB_SPIN_CAP) { atomicAdd(&bar[XB_TMO], 1u); break; } }
    }
    nloc = mine > 0u ? mine : 1u; nx = cnt > 0u ? cnt : 1u;
}

__device__ __forceinline__ void xcd_barrier(const XcdBarrier& b, int wave) {
    asm volatile("s_waitcnt vmcnt(0)" ::: "memory");
    __syncthreads();
    if (xb_first_thread(wave)) {
        unsigned* bar = b.bar; const unsigned x = xb_xcc_id();
        __builtin_amdgcn_s_waitcnt(0);
        unsigned nloc = b.st[0], nx = b.st[1];
        if (nloc == 0u) { xcd_barrier_complete(bar, x, nloc, nx); b.st[0] = nloc; b.st[1] = nx; }
        const unsigned old = xb_add(&bar[XB_XSUB(x)], 1u);
        const unsigned gen = old / nloc;
        if (old + 1u == (gen + 1u) * nloc) {
            __builtin_amdgcn_fence(__ATOMIC_RELEASE, "agent");
            asm volatile("s_waitcnt vmcnt(0)" ::: "memory");
            const unsigned og = xb_add(&bar[XB_TOP], 1u);
            const unsigned tg = og / nx;
            if (og + 1u == (tg + 1u) * nx) xb_add(&bar[XB_TOPGEN], 1u);
            else XB_SPIN(xb_ld(&bar[XB_TOPGEN]) == tg, bar);
            __builtin_amdgcn_fence(__ATOMIC_ACQUIRE, "agent");
            xb_add(&bar[XB_XGEN(x)], 1u);
            asm volatile("s_waitcnt vmcnt(0)" ::: "memory");
        } else {
            XB_SPIN(xb_ld(&bar[XB_XGEN(x)]) == gen, bar);
            __builtin_amdgcn_fence(__ATOMIC_ACQUIRE, "agent");
            asm volatile("s_waitcnt vmcnt(0)" ::: "memory");
        }
    }
    __syncthreads();
}

__device__ __forceinline__ int cmap_in(int n)  {
    if (n < 416) return n; if (n < 512) return -1; if (n < 1024) return n - 96;
    const int t = (n - 1024) >> 8, p = n & 255, bj = p >> 7, wc = (p >> 5) & 3, q = p & 31; return 928 + 64 * (4 * t + wc) + 32 * bj + q; }
__device__ __forceinline__ int cmap_qup(int n) { const int t = n >> 8, p = n & 255, bj = p >> 7, wc = (p >> 5) & 3, q = p & 31;
    if (t < 2) return (4 * t + wc) * 96 + 32 * bj + q;
    return (2 * wc + bj) * 96 + 64 + 16 * ((q >> 2) & 1) + 4 * (q >> 3) + (q & 3); }
__device__ __forceinline__ int cmap_kv(int n)  { const int t = n >> 8, p = n & 255, bj = p >> 7, wc = (p >> 5) & 3, q = p & 31;
    return (t < 2) ? (4 * t + wc) * 128 + 32 * bj + q : (4 * (t - 2) + wc) * 128 + 64 + 32 * bj + q; }

template <int WHICH  , bool GAIN>
__device__ __forceinline__ void transpose_item(const float* W, const float* W2, int K, int Nsrc, const float* gain, bf16* WT, LAS float* scr, int item, int nblk, int lane) {
    (void)scr;
    const int kb = item / nblk, nb = item % nblk, k0 = 64 * kb + 8 * (lane >> 3), n0 = 32 * nb, n = n0 + 4 * (lane & 7);
    int colq; const float* srcq = W;
    if (WHICH == 0) colq = cmap_in(n); else if (WHICH == 1) colq = cmap_qup(n); else if (WHICH == 2) colq = cmap_kv(n); else if (WHICH == 3) colq = n;
    else { const int t = n >> 8, p = n & 255; if (p < 128) colq = 128 * t + p; else { colq = 128 * t + p - 128; srcq = W2; } }
    f32x4 v[8];
#pragma unroll
    for (int j = 0; j < 8; ++j) v[j] = (f32x4){0.f, 0.f, 0.f, 0.f};
    if (colq >= 0) {
#pragma unroll
        for (int j = 0; j < 8; ++j) v[j] = *(const f32x4*)(srcq + (size_t)(k0 + j) * Nsrc + colq);
        if (GAIN) { const f32x4 g0 = *(const f32x4*)(gain + k0), g1 = *(const f32x4*)(gain + k0 + 4);
#pragma unroll
            for (int j = 0; j < 4; ++j) { v[j] = v[j] * g0[j]; v[4 + j] = v[4 + j] * g1[j]; } }
    }
#pragma unroll
    for (int e = 0; e < 4; ++e) { u32x4 o; o.x = pk2(v[0][e], v[1][e]); o.y = pk2(v[2][e], v[3][e]); o.z = pk2(v[4][e], v[5][e]); o.w = pk2(v[6][e], v[7][e]);
        *(u32x4*)(WT + (size_t)(n + e) * K + k0) = o; }
}

template <int KTOT>
__device__ __forceinline__ void sample_res_gemm(const bf16* A, int lda, const bf16* Bt, float* out, bf16* XB, float* ssq, int final_f32, int task, LAS char* lds, int lane, int wave) {
    const int r32 = lane & 31, hi = lane >> 5, t0 = 64 * (task >> 5), n0 = 32 * (task & 31);
    constexpr int KW = KTOT / 8, NS = KW / 16;
    const bf16* ap = Bt + (size_t)(n0 + r32) * KTOT + wave * KW + 8 * hi;
    const bf16* b0p = A + (size_t)(MP + t0 + r32) * lda + wave * KW + 8 * hi;
    const bf16* b1p = b0p + (size_t)32 * lda;
    f32x16 acc0 = {}, acc1 = {};
#pragma unroll 11
    for (int s = 0; s < NS; ++s) {
        const bf16x8 a = *(const bf16x8*)(ap + 16 * s), b0 = *(const bf16x8*)(b0p + 16 * s), b1 = *(const bf16x8*)(b1p + 16 * s);
        acc0 = __builtin_amdgcn_mfma_f32_32x32x16_bf16(a, b0, acc0, 0, 0, 0);
        acc1 = __builtin_amdgcn_mfma_f32_32x32x16_bf16(a, b1, acc1, 0, 0, 0);
    }
    LAS float* ps = (LAS float*)lds + wave * 2048 + lane;
#pragma unroll
    for (int r = 0; r < 16; ++r) { ps[r * 64] = acc0[r]; ps[(16 + r) * 64] = acc1[r]; }
    __syncthreads();
    { const int tb = wave >> 2, ng = wave & 3; f32x4 sum = {0.f, 0.f, 0.f, 0.f};
      const LAS float* rp = (const LAS float*)lds + (tb * 16 + 4 * ng) * 64 + lane;
#pragma unroll
      for (int p = 0; p < 8; ++p)
#pragma unroll
          for (int e = 0; e < 4; ++e) sum[e] += rp[p * 2048 + e * 64];
      const size_t rs = (size_t)t0 + 32 * tb + r32;
      const int col = n0 + 8 * ng + 4 * hi;
      bf16* xp = XB + ((size_t)MP + rs) * 1024 + col; const u32x2 xw = *(const u32x2*)xp;
      const f32x4 o = (f32x4){bflo(xw.x), bfhi(xw.x), bflo(xw.y), bfhi(xw.y)} + sum;
      if (final_f32) *(f32x4*)(out + ((size_t)MP + rs) * 1024 + col) = o;
      else { u32x2 w; w.x = pk2(o[0], o[1]); w.y = pk2(o[2], o[3]); *(u32x2*)xp = w; atomicAdd(ssq + MP + rs, dot4v(o)); } }
    __syncthreads();
}

struct Args { const float* in[25]; float* out; unsigned char* ws; };
enum { I_XP = 0, I_XS, I_CCKV, I_CKR, I_GMIX, I_WIN, I_GQL, I_WQUP, I_GQN, I_GQR, I_GKVL, I_GKR, I_WKV, I_GKN, I_LNG, I_LNB, I_WS, I_BS, I_GOA, I_GOG, I_WO, I_GFFN, I_WG, I_WU, I_WD };

constexpr int I_IN = 16 * 48, I_QU = 4 * 24, I_KV = 2 * 32, I_KVG = 2 * 32, I_O = 16 * 32, I_GU = 16 * 176, I_D = 44 * 32, I_LAYER = I_IN + I_QU + I_KV + I_KVG + I_O + I_GU + I_D, I_EARLY = I_IN + I_QU + I_KV + I_KVG;
__device__ __forceinline__ void convert_items(const Args& A, unsigned char* ws, LAS float* scr, int first, int last, int widx, int nw, int lane) {
    for (int it = first + widx; it < last; it += nw) {
        const int l = it / I_LAYER; int r = it % I_LAYER; unsigned char* wb = ws + WS_W + (size_t)l * LW;
        if (r < I_IN) { transpose_item<0, true>(A.in[I_WIN] + (size_t)l * 1024 * 1440, nullptr, 1024, 1440, A.in[I_GMIX] + l * 1024, (bf16*)(wb + W_IN), scr, r, 48, lane); continue; } r -= I_IN;
        if (r < I_QU) { transpose_item<1, true>(A.in[I_WQUP] + (size_t)l * 256 * 768, nullptr, 256, 768, A.in[I_GQL] + l * 256, (bf16*)(wb + W_QUP), scr, r, 24, lane); continue; } r -= I_QU;
        if (r < I_KV) { transpose_item<2, false>(A.in[I_WKV] + (size_t)l * 128 * 1024, nullptr, 128, 1024, nullptr, (bf16*)(wb + W_KV), scr, r, 32, lane); continue; } r -= I_KV;
        if (r < I_KVG) { transpose_item<2, true>(A.in[I_WKV] + (size_t)l * 128 * 1024, nullptr, 128, 1024, A.in[I_GKVL] + l * 128, (bf16*)(ws + WS_WKVG + (size_t)l * 262144), scr, r, 32, lane); continue; } r -= I_KVG;
        if (r < I_O) { transpose_item<3, false>(A.in[I_WO] + (size_t)l * 1024 * 1024, nullptr, 1024, 1024, nullptr, (bf16*)(wb + W_O), scr, r, 32, lane); continue; } r -= I_O;
        if (r < I_GU) { transpose_item<4, true>(A.in[I_WG] + (size_t)l * 1024 * DFF, A.in[I_WU] + (size_t)l * 1024 * DFF, 1024, DFF, A.in[I_GFFN] + l * 1024, (bf16*)(wb + W_GU), scr, r, 176, lane); continue; } r -= I_GU;
        transpose_item<3, false>(A.in[I_WD] + (size_t)l * DFF * 1024, nullptr, DFF, 1024, nullptr, (bf16*)(wb + W_D), scr, r, 32, lane);
    }
}
__device__ __forceinline__ void convert_cache(const Args& A, unsigned char* ws, int l, int tix, int ntx) {
    for (int i0 = tix; i0 < MC * 16; i0 += 4 * ntx) { f32x4 a[4], b[4];
#pragma unroll
        for (int u = 0; u < 4; ++u) { const int i = i0 + u * ntx; if (i < MC * 16) { const float* s = A.in[I_CCKV] + ((size_t)l * MC + (i >> 4)) * 128 + (i & 15) * 8; a[u] = *(const f32x4*)s; b[u] = *(const f32x4*)(s + 4); } }
#pragma unroll
        for (int u = 0; u < 4; ++u) { const int i = i0 + u * ntx; if (i < MC * 16) { u32x4 o; o.x = pk2(a[u][0], a[u][1]); o.y = pk2(a[u][2], a[u][3]); o.z = pk2(b[u][0], b[u][1]); o.w = pk2(b[u][2], b[u][3]);
            *(u32x4*)(ws + WS_CKVA + (size_t)l * L_CKVA + ((size_t)(MT + (i >> 4)) * 128 + (i & 15) * 8) * 2) = o; } } }
    for (int i = tix; i < MC * 4; i += ntx) { const int r = i >> 2, c0 = (i & 3) * 8;
        const float* s = A.in[I_CKR] + ((size_t)l * MC + r) * 32 + c0; const f32x4 a = *(const f32x4*)s, b = *(const f32x4*)(s + 4);
        u32x4 o; o.x = pk2(a[0], a[1]); o.y = pk2(a[2], a[3]); o.z = pk2(b[0], b[1]); o.w = pk2(b[2], b[3]);
        *(u32x4*)(ws + WS_KR + (size_t)l * L_KR + ((size_t)(MT + r) * 32 + c0) * 2) = o; }
}
__device__ __forceinline__ void p0_prologue(const Args& A, unsigned char* ws, LAS unsigned char* lds, int vcu, int G, int wave, int lane, int tid) {
    LAS float* scr = (LAS float*)(lds + wave * 16384);
    const int gw = vcu * 8 + wave, NGW = G * 8;
#ifdef NO_DEFER
    convert_items(A, ws, scr, 0, 2 * I_LAYER, gw, NGW, lane);
#else
    convert_items(A, ws, scr, 0, I_EARLY, gw, NGW, lane);
#endif
    const int gt = vcu * 512 + tid, NGT = G * 512;
    for (int i = gt; i < 2 * 8 * 128 * 16; i += NGT) { const int l = i >> 14, rem = i & 16383, gi = rem >> 4, j0 = (rem & 15) * 8, ii = gi & 127;
        const float* s = A.in[I_WS] + (size_t)l * 131072 + (size_t)gi * 128 + j0; const bool vis = (ii >> 6) >= (j0 >> 6);
        const f32x4 a = *(const f32x4*)s, b = *(const f32x4*)(s + 4);
        u32x4 o; o.x = pk2(a[0], a[1]); o.y = pk2(a[2], a[3]); o.z = pk2(b[0], b[1]); o.w = pk2(b[2], b[3]); if (!vis) o = (u32x4){0u, 0u, 0u, 0u};
        *(u32x4*)(ws + WS_W + (size_t)l * LW + W_S + ((size_t)gi * 128 + j0) * 2) = o; }
#ifdef NO_DEFER
    convert_cache(A, ws, 0, gt, NGT); convert_cache(A, ws, 1, gt, NGT);
#endif
    for (int i = gt; i < 2112 * 16; i += NGT) { const int pi = i >> 4, j = i & 15; const int pos = pi < 2048 ? pi : 4096 + (pi - 2048);
        const float inv = __builtin_amdgcn_exp2f(-(float)j * (13.287712379549449f / 16.0f)); const float ang = (float)pos * inv;
        const double t = (double)ang * 0.15915494309189535; const float fr = (float)(t - __builtin_rint(t));
        f32x2 cs; cs.x = __builtin_amdgcn_cosf(fr); cs.y = __builtin_amdgcn_sinf(fr);
        *(f32x2*)(ws + WS_ROPE + (size_t)i * 8) = cs; }
    bf16* XB = (bf16*)(ws + B_XB); float* ssq0 = (float*)(ws + WS_CTL + CTL_SSQ);
    for (int mp = gw; mp < MT / 2; mp += NGW) {
        f32x4 v[2][4];
#pragma unroll
        for (int u = 0; u < 2; ++u) { const int m = 2 * mp + u; const float* xr = (m < MP) ? A.in[I_XP] + (size_t)m * 1024 : A.in[I_XS] + (size_t)(m - MP) * 1024;
#pragma unroll
            for (int j = 0; j < 4; ++j) v[u][j] = *(const f32x4*)(xr + 256 * j + 4 * lane); }
#pragma unroll
        for (int u = 0; u < 2; ++u) { const int m = 2 * mp + u; float s = 0.f;
#pragma unroll
            for (int j = 0; j < 4; ++j) { s += dot4v(v[u][j]); u32x2 w; w.x = pk2(v[u][j][0], v[u][j][1]); w.y = pk2(v[u][j][2], v[u][j][3]); *(u32x2*)(XB + (size_t)m * 1024 + 256 * j + 4 * lane) = w; }
            s = wave_sum(s); if (lane == 0) ssq0[m] = s; } }
}

struct P2Ptrs { const bf16* Z; bf16* MRG; bf16* CKVA; bf16* KR; bf16* VN; const float* rope; float* out;
                const float* gql; const float* gkvl; const float* gkr; const float* lng; const float* lnb; };
__device__ __forceinline__ void p2_row(const P2Ptrs& P, int l, int m, int lane) {
    const bf16* z = P.Z + (size_t)m * NZ;
    const unsigned cw = *(const unsigned*)(z + 256 + 2 * lane);
    float k1 = 0.f, k2 = 0.f; if (lane < 16) { k1 = __uint_as_float((unsigned)z[384 + lane] << 16); k2 = __uint_as_float((unsigned)z[400 + lane] << 16); }
    const bool smp = m >= MP; const int ms = m - MP; const int posidx = smp ? 2048 + (ms & 63) : (m & 2047);
    { const float c0 = bflo(cw), c1 = bfhi(cw); const float ss = wave_sum(c0 * c0 + c1 * c1); const float rn = rsq(ss * (1.0f / 128.0f) + EPS);
      const f32x2 g = *(const f32x2*)(P.gkvl + 2 * lane); f32x2 y; y.x = c0 * rn * g.x; y.y = c1 * rn * g.y;
      float* o = smp ? P.out + O_CKVS + ((size_t)l * MS + ms) * 128 : P.out + O_CKVP + ((size_t)l * MP + m) * 128;
      *(f32x2*)(o + 2 * lane) = y; if (smp) *(unsigned*)(P.CKVA + (size_t)m * 128 + 2 * lane) = pk2(y.x, y.y); }
    { const float ss = wave_sum(k1 * k1 + k2 * k2); const float rn = rsq(ss * (1.0f / 32.0f) + EPS);
      if (lane < 16) { const float a = k1 * rn * P.gkr[lane], b = k2 * rn * P.gkr[16 + lane]; const f32x2 cs = *(const f32x2*)(P.rope + (size_t)(posidx * 16 + lane) * 2);
          const float o1 = a * cs.x - b * cs.y, o2 = a * cs.y + b * cs.x;
          float* o = smp ? P.out + O_KRS + ((size_t)l * MS + ms) * 32 : P.out + O_KRP + ((size_t)l * MP + m) * 32;
          o[lane] = o1; o[16 + lane] = o2;
          bf16* kb = P.KR + (size_t)m * 32; kb[lane] = (bf16)(pk2(o1, 0.f) & 0xffffu); kb[16 + lane] = (bf16)(pk2(o2, 0.f) & 0xffffu); } }
}

#ifndef REP_P0
#define REP_P0 1
#endif
#ifndef REP_P1
#define REP_P1 1
#endif
#ifndef REP_P2
#define REP_P2 1
#endif
#ifndef REP_P3
#define REP_P3 1
#endif
#ifndef REP_P4A
#define REP_P4A 1
#endif
#ifndef REP_P4B
#define REP_P4B 1
#endif
#ifndef REP_P6
#define REP_P6 1
#endif
#ifndef REP_BAR
#define REP_BAR 1
#endif
template <class T> __device__ __forceinline__ T* as_global(T* p) {
#if defined(__HIP_DEVICE_COMPILE__)
    __builtin_assume(!__builtin_amdgcn_is_shared((const __attribute__((address_space(0))) void*)p));
    __builtin_assume(!__builtin_amdgcn_is_private((const __attribute__((address_space(0))) void*)p));
#endif
    return p;
}
#define FRESH_TID() unsigned z_p = 0u; asm volatile("" : "+v"(z_p)); const int lane_p = (int)__builtin_amdgcn_mbcnt_hi(~0u, __builtin_amdgcn_mbcnt_lo(~0u, z_p)); const int tid_p = wave * 64 + lane_p
#define FRESH_PTRS() size_t zo_p = 0; asm volatile("" : "+s"(zo_p)); \
    unsigned char* ws = args.ws + zo_p; float* out = args.out + zo_p;     \
    int G = gridDim.x, bx = blockIdx.x; asm volatile("" : "+s"(G), "+s"(bx)); const int vcu = (G % 8 == 0) ? (bx % 8) * (G / 8) + bx / 8 : bx; (void)vcu; (void)out
#define GRID_BAR() for (int repb_ = 0; repb_ < REP_BAR; ++repb_) do { size_t zo_b = 0; asm volatile("" : "+s"(zo_b)); unsigned char* wsb = args.ws + zo_b; XcdBarrier bar_; bar_.bar = (unsigned*)(wsb + WS_CTL) + CW_BAR; bar_.x = 0; bar_.st = (volatile LAS unsigned*)(lds + MISC_OFF) + 8; xcd_barrier(bar_, wave); } while (0)
__global__ void __launch_bounds__(512, 2) hybrid_fwd(Args args) {
    extern __shared__ __attribute__((aligned(16))) unsigned char lds_raw[];
    LAS unsigned char* lds = (LAS unsigned char*)lds_raw;
    const int wave = __builtin_amdgcn_readfirstlane(threadIdx.x >> 6);
    { FRESH_TID(); for (int u = tid_p; u < (LDS_BYTES - RING_BYTES) / 4; u += 512) ((LAS unsigned*)(lds + RING_BYTES))[u] = 0u; }
    __syncthreads();
    { FRESH_PTRS(); (void)xcd_barrier_post((unsigned*)(ws + WS_CTL) + CW_BAR, (volatile LAS unsigned*)(lds + MISC_OFF) + 8, wave); }

#ifndef NO_P0
    asm volatile("; MARK_P0");
    for (int rep_ = 0; rep_ < REP_P0; ++rep_) { FRESH_TID(); FRESH_PTRS(); p0_prologue(args, ws, lds, vcu, G, wave, lane_p, tid_p); }
#endif
    GRID_BAR();

    for (int l = 0; l < NLAYER; ++l) {
#ifndef NO_P1
        asm volatile("; MARK_P1");
        for (int rep_ = 0; rep_ < REP_P1; ++rep_) { FRESH_PTRS(); unsigned char* wb = ws + WS_W + (size_t)l * LW;
          pg8::Gemm g{(const bf16*)(ws + B_XB), (const bf16*)(wb + W_IN), MT, NZ, 1024, 1024}; pg8::StaticOrder S; S.init(MT, NZ, G, bx);
          pg8::EpiZ E{(bf16*)(ws + B_Z), (const float*)(ws + WS_CTL + CTL_SSQ) + (size_t)(2 * l) * MT, (bf16*)(ws + B_MRG), (bf16*)(ws + B_VN), out + O_GVS + (size_t)l * MS * 512, args.in[I_LNG] + l * 512, args.in[I_LNB] + l * 512,
                      (float*)(ws + WS_CTL + CTL_SSQQ) + (size_t)l * MT, (float*)(ws + WS_CTL + CTL_SSQC) + (size_t)l * MT};
          pg8::gemm_phase<pg8::EpiZ, pg8::StaticOrder, true, true>(lds, g, S, E, wave);
          if (l == 1 && bx >= 140) {
              pg8::Gemm g3{(const bf16*)(ws + WS_CKVA + (size_t)l * L_CKVA) + (size_t)MT * 128, (const bf16*)(wb + W_KV), MC, 512, 128, 128}; pg8::StaticOrder S3; S3.init(MC, 512, G - 140, bx - 140);
              pg8::EpiKV E3{(bf16*)(ws + B_KN) + (size_t)MT * 512, (bf16*)(ws + B_VV) + (size_t)MT * 512, args.in[I_GKN] + l * 64, nullptr};
              pg8::gemm_phase<pg8::EpiKV, pg8::StaticOrder, true, true>(lds, g3, S3, E3, wave); }
#ifndef NO_DEFER
          if (l == 0 && bx >= 140) { FRESH_TID(); convert_items(args, ws, (LAS float*)(lds + wave * 16384), I_EARLY, I_LAYER, (bx - 140) * 8 + wave, (G - 140) * 8, lane_p);
                                     convert_cache(args, ws, 0, (bx - 140) * 512 + tid_p, (G - 140) * 512); }
#endif
          }
#endif
        GRID_BAR();
#ifndef NO_P3
        asm volatile("; MARK_P3");
        { FRESH_TID(); FRESH_PTRS();
          P2Ptrs P{(const bf16*)(ws + B_Z), (bf16*)(ws + B_MRG), (bf16*)(ws + WS_CKVA + (size_t)l * L_CKVA), (bf16*)(ws + WS_KR + (size_t)l * L_KR), (bf16*)(ws + B_VN), (const float*)(ws + WS_ROPE), out,
                   args.in[I_GQL] + l * 256, args.in[I_GKVL] + l * 128, args.in[I_GKR] + l * 32, args.in[I_LNG] + l * 512, args.in[I_LNB] + l * 512};
          const int gw = vcu * 8 + wave, NGW = G * 8;
          for (int mp = gw; mp < MT / 2; mp += NGW) { p2_row(P, l, 2 * mp, lane_p); p2_row(P, l, 2 * mp + 1, lane_p); } }
        { FRESH_PTRS(); unsigned char* wb = ws + WS_W + (size_t)l * LW;
          pg8::Gemm g{(const bf16*)(ws + B_Z), (const bf16*)(wb + W_QUP), MT, 768, 256, NZ}; pg8::StaticOrder S; S.init(MT, 768, G, bx);
          pg8::EpiQ E{(bf16*)(ws + B_QNP), (bf16*)(ws + B_QRP), args.in[I_GQN] + l * 64, args.in[I_GQR] + l * 32, (const float*)(ws + WS_ROPE), (const float*)(ws + WS_CTL + CTL_SSQQ) + (size_t)l * MT};
          pg8::gemm_phase<pg8::EpiQ, pg8::StaticOrder, true, true>(lds, g, S, E, wave); }
        asm volatile("; MARK_P3B");
        { FRESH_PTRS();
          pg8::Gemm g{(const bf16*)(ws + B_Z) + 256, (const bf16*)(ws + WS_WKVG + (size_t)l * 262144), MT, 1024, 128, NZ}; pg8::StaticOrder S; S.init(MT, 1024, G, (bx + 58) % G);
          pg8::EpiKV E{(bf16*)(ws + B_KN), (bf16*)(ws + B_VV), args.in[I_GKN] + l * 64, (const float*)(ws + WS_CTL + CTL_SSQC) + (size_t)l * MT};
          pg8::gemm_phase<pg8::EpiKV, pg8::StaticOrder, true, true>(lds, g, S, E, wave); }
        if (l == 0) { FRESH_PTRS(); unsigned char* wb = ws + WS_W + (size_t)l * LW;
          pg8::Gemm g{(const bf16*)(ws + WS_CKVA + (size_t)l * L_CKVA) + (size_t)MT * 128, (const bf16*)(wb + W_KV), MC, 512, 128, 128}; pg8::StaticOrder S; S.init(MC, 512, G, bx);
          pg8::EpiKV E{(bf16*)(ws + B_KN) + (size_t)MT * 512, (bf16*)(ws + B_VV) + (size_t)MT * 512, args.in[I_GKN] + l * 64, nullptr};
          pg8::gemm_phase<pg8::EpiKV, pg8::StaticOrder, true, true>(lds, g, S, E, wave); }
#endif
        GRID_BAR();
#ifndef NO_P4
        asm volatile("; MARK_P4");
        { FRESH_TID(); FRESH_PTRS();
          att::Ptrs P{(const bf16*)(ws + B_QNP), (const bf16*)(ws + B_QRP), (const bf16*)(ws + B_KN), (const bf16*)(ws + B_VV), (const bf16*)(ws + WS_KR + (size_t)l * L_KR), (bf16*)(ws + B_MRG), args.in[I_GOA] + l * 512};
          const int bh = vcu >> 2, s = vcu & 3;
          const int par = bh & 1;
          if (par) att::sample_unit(P, (const bf16*)(ws + WS_CKVA + (size_t)l * L_CKVA), (const bf16*)(ws + WS_W + (size_t)l * LW + W_KV), vcu >> 5, (vcu >> 2) & 7, vcu & 3, (float*)(ws + WS_PART), (unsigned*)(ws + WS_CTL + CTL_SCNT) + l * 64, (LAS char*)lds, tid_p, lane_p, wave);
          { att::Stage sa, sb;
            att::prompt_unit<false, true>(P, bh >> 3, bh & 7, 7 - s, (size_t)(bh >> 3) * 2048, bh & 7, sa, sb, (LAS char*)lds, tid_p, lane_p, wave);
            att::prompt_unit<true, false>(P, bh >> 3, bh & 7, s, 0, 0, sa, sb, (LAS char*)lds, tid_p, lane_p, wave); }
          if (!par) att::sample_unit(P, (const bf16*)(ws + WS_CKVA + (size_t)l * L_CKVA), (const bf16*)(ws + WS_W + (size_t)l * LW + W_KV), vcu >> 5, (vcu >> 2) & 7, vcu & 3, (float*)(ws + WS_PART), (unsigned*)(ws + WS_CTL + CTL_SCNT) + l * 64, (LAS char*)lds, tid_p, lane_p, wave);
#ifndef NO_P4C
          asm volatile("; MARK_P4C");
          { att::GmPtrs Gm{(const bf16*)(ws + B_VN), (bf16*)(ws + B_MRG), (const bf16*)(ws + WS_W + (size_t)l * LW + W_S), args.in[I_BS] + l * 1024, args.in[I_GOG] + l * 512};
                 att::gmlp_wg(Gm, vcu, (LAS char*)lds, tid_p, lane_p, wave); }
#endif
        }
#endif
        GRID_BAR();
#ifndef NO_P5
        asm volatile("; MARK_P5");
        { FRESH_PTRS(); unsigned char* wb = ws + WS_W + (size_t)l * LW;
          pg8::Gemm g{(const bf16*)(ws + B_MRG), (const bf16*)(wb + W_O), MP, 1024, 1024, 1024}; pg8::StaticOrder S; S.init(MP, 1024, G, bx);
          pg8::EpiRes E{out, (bf16*)(ws + B_XB), (float*)(ws + WS_CTL + CTL_SSQ) + (size_t)(2 * l + 1) * MT, 0};
          pg8::gemm_phase<pg8::EpiRes, pg8::StaticOrder, true, true>(lds, g, S, E, wave);
          { FRESH_TID(); if (vcu < 256) sample_res_gemm<1024>((const bf16*)(ws + B_MRG), 1024, (const bf16*)(wb + W_O), out, E.XB, E.ssq, 0, vcu, (LAS char*)lds, lane_p, wave); } }
#endif
        GRID_BAR();
#ifndef NO_P6
        asm volatile("; MARK_P6");
        for (int rep_ = 0; rep_ < REP_P6; ++rep_) { FRESH_PTRS(); unsigned char* wb = ws + WS_W + (size_t)l * LW;
          pg8::Gemm g{(const bf16*)(ws + B_XB), (const bf16*)(wb + W_GU), MT, NGU, 1024, 1024}; pg8::StaticOrder S; S.init(MT, NGU, G, bx);
          pg8::EpiGU E{(bf16*)(ws + B_H), (const float*)(ws + WS_CTL + CTL_SSQ) + (size_t)(2 * l + 1) * MT};
#ifdef PROBE_SPLIT6
          S.i1 = 3; pg8::gemm_phase<pg8::EpiGU, pg8::StaticOrder, true, true>(lds, g, S, E, wave); GRID_BAR(); S.i0 = 3; S.i1 = 1 << 20;
#endif
          pg8::gemm_phase<pg8::EpiGU, pg8::StaticOrder, true, true>(lds, g, S, E, wave);
#ifndef NO_DEFER
          if (l == 0 && bx >= 172) { FRESH_TID(); convert_items(args, ws, (LAS float*)(lds + wave * 16384), I_LAYER, 2 * I_LAYER, (bx - 172) * 8 + wave, (G - 172) * 8, lane_p);
                                     convert_cache(args, ws, 1, (bx - 172) * 512 + tid_p, (G - 172) * 512); }
#endif
          }
#endif
        GRID_BAR();
#ifndef NO_P7
        asm volatile("; MARK_P7");
        { FRESH_PTRS(); unsigned char* wb = ws + WS_W + (size_t)l * LW;
          pg8::Gemm g{(const bf16*)(ws + B_H), (const bf16*)(wb + W_D), MP, 1024, DFF, DFF}; pg8::StaticOrder S; S.init(MP, 1024, G, bx);
          pg8::EpiRes E{out, (bf16*)(ws + B_XB), (float*)(ws + WS_CTL + CTL_SSQ) + (size_t)(2 * l + 2) * MT, l == NLAYER - 1 ? 1 : 0};
          pg8::gemm_phase<pg8::EpiRes, pg8::StaticOrder, true, true>(lds, g, S, E, wave);
          { FRESH_TID(); if (vcu < 256) sample_res_gemm<DFF>((const bf16*)(ws + B_H), DFF, (const bf16*)(wb + W_D), out, E.XB, E.ssq, E.final_f32, vcu, (LAS char*)lds, lane_p, wave); } }
#endif
        if (l + 1 < NLAYER) GRID_BAR();
    }
}

extern "C" void kernel_launch(void* const* d_in, const int* in_sizes, int n_in, void* d_out, int out_size, void* d_ws, size_t ws_size, hipStream_t stream) {
    static int grid = 0;
    if (grid == 0) {
        #ifdef PROBE_WSMIN
        if (ws_size < (size_t)PROBE_WSMIN * MiB) { grid = -1; return; }
#endif
        if (n_in != 25 || (size_t)out_size != O_END || ws_size < WS_END) { fprintf(stderr, "kernel_launch: unexpected shapes (n_in %d, out %d, ws %zu); nothing launched\n", n_in, out_size, ws_size); grid = -1; return; }
        int dev = 0, cus = 0, per_cu = 0;
        if (hipGetDevice(&dev) != hipSuccess || hipDeviceGetAttribute(&cus, hipDeviceAttributeMultiprocessorCount, dev) != hipSuccess) { grid = -1; return; }
        if (hipFuncSetAttribute((const void*)hybrid_fwd, hipFuncAttributeMaxDynamicSharedMemorySize, LDS_BYTES) != hipSuccess) { fprintf(stderr, "kernel_launch: hipFuncSetAttribute failed\n"); grid = -1; return; }
        if (hipOccupancyMaxActiveBlocksPerMultiprocessor(&per_cu, (const void*)hybrid_fwd, 512, LDS_BYTES) != hipSuccess || per_cu < 1) { fprintf(stderr, "kernel_launch: occupancy query reports %d blocks per CU\n", per_cu); (void)hipGetLastError(); grid = -1; return; }
        if (cus < 256) { fprintf(stderr, "kernel_launch: built for a 256-CU device (found %d CUs); nothing launched\n", cus); grid = -1; return; }
        grid = 256;
    }
    if (grid < 0) return;
    if (hipMemsetAsync((char*)d_ws + WS_CTL, 0, CTL_ZERO_BYTES, stream) != hipSuccess) return;
    Args a{};
    for (int i = 0; i < 25; ++i) a.in[i] = (const float*)d_in[i];
    a.out = (float*)d_out; a.ws = (unsigned char*)d_ws;
    hipLaunchKernelGGL(hybrid_fwd, dim3(grid), dim3(512), LDS_BYTES, stream, a);
}
```

```cpp
#include <hip/hip_runtime.h>
#include <cstdio>
#include <cstdint>

#define LAS __attribute__((address_space(3)))
#define GAS __attribute__((address_space(1)))
typedef unsigned short bf16;
typedef short bf16x8 __attribute__((ext_vector_type(8)));
typedef short s16x4 __attribute__((ext_vector_type(4)));
typedef float f32x4 __attribute__((ext_vector_type(4)));
typedef float f32x2 __attribute__((ext_vector_type(2)));
typedef float f32x16 __attribute__((ext_vector_type(16)));
typedef unsigned u32x4 __attribute__((ext_vector_type(4)));
typedef unsigned u32x2 __attribute__((ext_vector_type(2)));
typedef __bf16 bf16x2_t __attribute__((ext_vector_type(2)));

constexpr int DM = 1024, MP = 16384, MS = 512, MT = MP + MS  , MC = 32768  , MA = MT + MC;
constexpr int NZ = 1536, DFF = 2816, NGU = 5632;
constexpr int NLAYER = 2;
constexpr float EPS = 1e-6f;
constexpr float QSCALE = 0.10206207261596577f * 1.4426950408889634f;

constexpr size_t O_Y = 0, O_CKVP = (size_t)MT * 1024, O_KRP = O_CKVP + (size_t)2 * MP * 128, O_CKVS = O_KRP + (size_t)2 * MP * 32,
                 O_KRS = O_CKVS + (size_t)2 * MS * 128, O_GVS = O_KRS + (size_t)2 * MS * 32, O_END = O_GVS + (size_t)2 * MS * 512;

constexpr size_t MiB = 1u << 20;
constexpr size_t WS_CTL = 0, CTL_ZERO_BYTES = 1 * MiB;
constexpr int CW_BAR = 4096;
constexpr size_t CTL_SSQ = 65536;
constexpr size_t WS_W = 1 * MiB, LW = 23461888;
constexpr size_t W_IN = 0, W_QUP = 3145728, W_KV = W_QUP + 393216, W_O = W_KV + 262144, W_GU = W_O + 2097152, W_D = W_GU + 11534336, W_S = W_D + 5767168;
static_assert(W_S + 262144 == LW, "weight block");
constexpr size_t WS_CKVA = WS_W + 2 * LW, L_CKVA = (size_t)MA * 128 * 2;
constexpr size_t WS_KR = WS_CKVA + 2 * L_CKVA, L_KR = (size_t)MA * 32 * 2;
constexpr size_t WS_ROPE = WS_KR + 2 * L_KR;
constexpr size_t WS_PART = 153 * MiB / 2, PART_BYTES = (size_t)64 * 4 * 2 * 34 * 64 * 4;
constexpr size_t WS_BIG = 324 * MiB / 4 - MiB / 4;
constexpr size_t CTL_SCNT = 32768;
constexpr size_t CTL_SSQQ = 524288, CTL_SSQC = CTL_SSQQ + 2 * (size_t)MT * 4;
constexpr size_t B_KN = WS_BIG, B_VV = B_KN + (size_t)MA * 512 * 2, B_QNP = B_VV + (size_t)MA * 512 * 2, B_QRP = B_QNP + (size_t)MT * 512 * 2,
                 B_VN = B_QRP + (size_t)MT * 256 * 2, B_MRG = B_VN + (size_t)MT * 512 * 2, B_MRG_END = B_MRG + (size_t)MT * 1024 * 2;
constexpr size_t B_H = WS_BIG + (size_t)MT * NZ * 2 + (size_t)MT * 1024 * 2, B_H_END = B_H + (size_t)MT * DFF * 2;
constexpr size_t B_XB = 256 * MiB;
constexpr size_t WS_WKVG = B_XB + (size_t)MT * 2048;
constexpr size_t B_Z = WS_WKVG + 2 * 262144;
constexpr size_t WS_END = B_Z + (size_t)MT * NZ * 2;
static_assert(WS_ROPE + 2112 * 16 * 8 <= WS_PART && WS_PART + PART_BYTES <= WS_BIG && WS_BIG % 65536 == 0 && WS_PART % 65536 == 0, "ws map 1");
static_assert(B_MRG_END <= B_XB && B_H_END <= B_XB && B_XB + (size_t)MT * 2048 <= WS_END, "ws map 2");
static_assert(B_Z >= B_XB + (size_t)MT * 2048, "Z above XB");
static_assert(CTL_SSQ + 5 * (size_t)MT * 4 <= CTL_SSQQ && CTL_SSQC + 2 * (size_t)MT * 4 <= CTL_ZERO_BYTES, "ssq arrays inside the memset region");

constexpr int RING_BYTES = 131072, LDS_BYTES = 147456, MISC_OFF = LDS_BYTES - 256;

__device__ __forceinline__ unsigned pk2(float lo, float hi) { f32x2 v = {lo, hi}; bf16x2_t b = __builtin_convertvector(v, bf16x2_t); return __builtin_bit_cast(unsigned, b); }
__device__ __forceinline__ float bflo(unsigned w) { return __uint_as_float(w << 16); }
__device__ __forceinline__ float bfhi(unsigned w) { return __uint_as_float(w & 0xffff0000u); }
#define SWZ_XOR(v, m) __int_as_float(__builtin_amdgcn_ds_swizzle(__float_as_int(v), ((m) << 10) | 0x1f))
__device__ __forceinline__ float sum16(float v) { return v + __int_as_float(__builtin_amdgcn_ds_swizzle(__float_as_int(v), 0x401F)); }
__device__ __forceinline__ float sum32(float v) { auto r = __builtin_amdgcn_permlane32_swap(__float_as_uint(v), __float_as_uint(v), false, false); return __uint_as_float(r[0]) + __uint_as_float(r[1]); }
__device__ __forceinline__ float max32(float v) { auto r = __builtin_amdgcn_permlane32_swap(__float_as_uint(v), __float_as_uint(v), false, false); return fmaxf(__uint_as_float(r[0]), __uint_as_float(r[1])); }
__device__ __forceinline__ float sum8(float v) { v += SWZ_XOR(v, 1); v += SWZ_XOR(v, 2); v += SWZ_XOR(v, 4); return v; }
__device__ __forceinline__ float wave_sum(float v) { v = sum8(v); v += SWZ_XOR(v, 8); v += SWZ_XOR(v, 16); return sum32(v); }
__device__ __forceinline__ float dot4v(const f32x4 a) { return (a[0] * a[0] + a[1] * a[1]) + (a[2] * a[2] + a[3] * a[3]); }
__device__ __forceinline__ float rsq(float x) { return __builtin_amdgcn_rsqf(x); }
__device__ __forceinline__ float gelu_tanh(float x) {
    const float u2 = 1.5957691216057308f * (x + 0.044715f * x * x * x);
    return x * __builtin_amdgcn_rcpf(1.0f + __builtin_amdgcn_exp2f(-1.4426950408889634f * u2));
}
__device__ __forceinline__ float silu_f(float x) { return x * __builtin_amdgcn_rcpf(1.0f + __builtin_amdgcn_exp2f(-1.4426950408889634f * x)); }
namespace pg8 {
#define PG8_LAS __attribute__((address_space(3)))
typedef unsigned short bf16_t;
constexpr int BM = 256, BK = 64, HALF = 128, HTB = HALF * BK * 2  , STAGE_BYTES = 8 * HTB, NXCD = 8, WGM = 8;

__host__ __device__ __forceinline__ int lds_byte(int r, int c) { const int st = (r >> 4) * 2 + (c >> 5), rr = r & 15, cc = c & 31, ob = rr * 64 + cc * 2; return st * 1024 + (ob ^ (((ob >> 9) & 1) << 5)); }
__host__ __device__ __forceinline__ void stage_rc(int b, int& R, int& C) { const int st = b / 1024, sb = b % 1024, swz = sb ^ (((sb >> 9) & 1) << 5); R = (st >> 1) * 16 + swz / 64; C = (st & 1) * 32 + (swz % 64) / 2; }
__host__ __device__ __forceinline__ int perm32(int rho) { const int n = rho >> 4, i = rho & 15; return 8 * (i >> 2) + 4 * n + (i & 3); }

struct Unit { int pm, pn; };
struct Gemm { const bf16_t* A; const bf16_t* Bt; int M, N, K, lda; };

struct StaticOrder {
    int nM, nN, nwg, G, c, i0 = 0, i1 = 1 << 20;
    __host__ __device__ void init(int M, int N, int G_, int c_) { nM = M / BM; nN = N / BM; nwg = nM * nN; G = G_; c = c_; }
    __host__ __device__ bool next(int i_, Unit& u) const {
        const int i = i_ + i0; if (i >= i1) return false;
        const long L = (long)i * G + c; if (L >= nwg) return false;
        int wgid = (int)L; { const int q = nwg / NXCD, r = nwg % NXCD, xcd = wgid % NXCD, off = wgid / NXCD; wgid = (xcd < r ? xcd * (q + 1) : r * (q + 1) + (xcd - r) * q) + off; }
        const int nig = WGM * nN, gid = wgid / nig, fm = gid * WGM, gsz = (nM - fm) < WGM ? (nM - fm) : WGM;
        u.pm = fm + ((wgid % nig) % gsz); u.pn = (wgid % nig) / gsz; return true;
    }
    __device__ __forceinline__ void a_ready(const Unit&) const {}
    __device__ __forceinline__ void done(const Unit&) const {}
};
__device__ __forceinline__ float dot4(const f32x4 a) { return (a[0] * a[0] + a[1] * a[1]) + (a[2] * a[2] + a[3] * a[3]); }

struct EpiZ {
    static constexpr bool PERM = true, AFTER_DRAIN = false;
    bf16_t* Z; const float* ssq; bf16_t* MRG; bf16_t* VN; float* gvs; const float* lng; const float* lnb; float* ssqQ; float* ssqC;
    __device__ __forceinline__ void operator()(const f32x4 (&acc)[2][2][4][2], const Unit& u, int wr, int wc, int fr_, int fq_) const {
        unsigned z_e = 0u; asm volatile("" : "+v"(z_e)); const int lane_e = (int)__builtin_amdgcn_mbcnt_hi(~0u, __builtin_amdgcn_mbcnt_lo(~0u, z_e)), fr = lane_e & 15, fq = lane_e >> 4; (void)fr_; (void)fq_;
        const int row0 = u.pm * BM + wr * 64 + fr;
        float rs[2][4];
#pragma unroll
        for (int ai = 0; ai < 2; ++ai)
#pragma unroll
            for (int m = 0; m < 4; ++m) rs[ai][m] = ssq[row0 + ai * HALF + m * 16];
        if (u.pn < 4) {
            bf16_t* dst; int ld;
            if (u.pn < 2) { dst = Z + u.pn * BM + wc * 32 + 8 * fq; ld = NZ; } else { dst = MRG + 512 + (u.pn - 2) * BM + wc * 32 + 8 * fq; ld = 1024; }
            const bool act = u.pn >= 2;
#pragma unroll
            for (int ai = 0; ai < 2; ++ai)
#pragma unroll
                for (int m = 0; m < 4; ++m) { const int row = row0 + ai * HALF + m * 16; const float r = rsq(rs[ai][m] * (1.0f / 1024.0f) + EPS); float sq = 0.f;
                    bf16_t* rowp = dst + (size_t)row * ld;
#pragma unroll
                    for (int bj = 0; bj < 2; ++bj) { f32x4 v0 = acc[ai][bj][m][0] * r, v1 = acc[ai][bj][m][1] * r;
                        if (act) {
#pragma unroll
                            for (int e = 0; e < 4; ++e) { v0[e] = gelu_tanh(v0[e]); v1[e] = gelu_tanh(v1[e]); } }
                        u32x4 w; w.x = pk2(v0[0], v0[1]); w.y = pk2(v0[2], v0[3]); w.z = pk2(v1[0], v1[1]); w.w = pk2(v1[2], v1[3]);
                        *(u32x4*)(rowp + bj * HALF) = w;
                        if (!act && (u.pn == 0 || bj == 0)) sq += dot4(v0) + dot4(v1); }
                    if (!act) { sq = sum32(sum16(sq)); if (fq == 0) atomicAdd((u.pn == 0 ? ssqQ : ssqC) + row, sq); }
                    __builtin_amdgcn_sched_barrier(0); }
        } else {
            const int grp = 4 * (u.pn - 4) + wc;
            f32x4 gg[2][2], gb[2][2];
#pragma unroll
            for (int bj = 0; bj < 2; ++bj)
#pragma unroll
                for (int n = 0; n < 2; ++n) { gg[bj][n] = *(const f32x4*)(lng + grp * 64 + 32 * bj + 8 * fq + 4 * n); gb[bj][n] = *(const f32x4*)(lnb + grp * 64 + 32 * bj + 8 * fq + 4 * n); }
#pragma unroll
            for (int ai = 0; ai < 2; ++ai)
#pragma unroll
                for (int m = 0; m < 4; ++m) { const int row = row0 + ai * HALF + m * 16; const float r = rsq(rs[ai][m] * (1.0f / 1024.0f) + EPS);
                    f32x4 y[2][2]; float s = 0.f;
#pragma unroll
                    for (int bj = 0; bj < 2; ++bj)
#pragma unroll
                        for (int n = 0; n < 2; ++n) { const f32x4 a = acc[ai][bj][m][n] * r;
#pragma unroll
                            for (int e = 0; e < 4; ++e) { y[bj][n][e] = gelu_tanh(a[e]); s += y[bj][n][e]; } }
                    s = sum32(sum16(s)); const float mean = s * (1.0f / 64.0f); float s2 = 0.f;
#pragma unroll
                    for (int bj = 0; bj < 2; ++bj)
#pragma unroll
                        for (int n = 0; n < 2; ++n) { y[bj][n] = y[bj][n] - mean; s2 += dot4(y[bj][n]); }
                    s2 = sum32(sum16(s2)); const float rstd = rsq(s2 * (1.0f / 64.0f) + EPS);
#pragma unroll
                    for (int bj = 0; bj < 2; ++bj) { const f32x4 o0 = y[bj][0] * rstd * gg[bj][0] + gb[bj][0], o1 = y[bj][1] * rstd * gg[bj][1] + gb[bj][1];
                        u32x4 w; w.x = pk2(o0[0], o0[1]); w.y = pk2(o0[2], o0[3]); w.z = pk2(o1[0], o1[1]); w.w = pk2(o1[2], o1[3]);
                        *(u32x4*)(VN + (size_t)row * 512 + grp * 64 + 32 * bj + 8 * fq) = w;
                        if (row >= MP) { float* op = gvs + (size_t)(row - MP) * 512 + grp * 64 + 32 * bj + 8 * fq; *(f32x4*)op = o0; *(f32x4*)(op + 4) = o1; } }
                    __builtin_amdgcn_sched_barrier(0); }
        }
    }
};

struct EpiGU {
    static constexpr bool PERM = true, AFTER_DRAIN = false;
    bf16_t* H; const float* ssq;
    __device__ __forceinline__ void operator()(const f32x4 (&acc)[2][2][4][2], const Unit& u, int wr, int wc, int fr_, int fq_) const {
        unsigned z_e = 0u; asm volatile("" : "+v"(z_e)); const int lane_e = (int)__builtin_amdgcn_mbcnt_hi(~0u, __builtin_amdgcn_mbcnt_lo(~0u, z_e)), fr = lane_e & 15, fq = lane_e >> 4; (void)fr_; (void)fq_;
        const int row0 = u.pm * BM + wr * 64 + fr, colh = u.pn * HALF + wc * 32 + 8 * fq;
        float rs[2][4];
#pragma unroll
        for (int ai = 0; ai < 2; ++ai)
#pragma unroll
            for (int m = 0; m < 4; ++m) rs[ai][m] = ssq[row0 + ai * HALF + m * 16];
#pragma unroll
        for (int ai = 0; ai < 2; ++ai)
#pragma unroll
            for (int m = 0; m < 4; ++m) { const int row = row0 + ai * HALF + m * 16; const float r = rsq(rs[ai][m] * (1.0f / 1024.0f) + EPS);
                const f32x4 g0 = acc[ai][0][m][0] * r, g1 = acc[ai][0][m][1] * r, u0 = acc[ai][1][m][0] * r, u1 = acc[ai][1][m][1] * r;
                f32x4 h0, h1;
#pragma unroll
                for (int e = 0; e < 4; ++e) { h0[e] = silu_f(g0[e]) * u0[e]; h1[e] = silu_f(g1[e]) * u1[e]; }
                u32x4 w; w.x = pk2(h0[0], h0[1]); w.y = pk2(h0[2], h0[3]); w.z = pk2(h1[0], h1[1]); w.w = pk2(h1[2], h1[3]);
                *(u32x4*)(H + (size_t)row * DFF + colh) = w; }
    }
};

struct EpiRes {
    static constexpr bool PERM = true, AFTER_DRAIN = false;
    float* out; bf16_t* XB; float* ssq; int final_f32;
    __device__ __forceinline__ void operator()(const f32x4 (&acc)[2][2][4][2], const Unit& u, int wr, int wc, int fr_, int fq_) const {
        unsigned z_e = 0u; asm volatile("" : "+v"(z_e)); const int lane_e = (int)__builtin_amdgcn_mbcnt_hi(~0u, __builtin_amdgcn_mbcnt_lo(~0u, z_e)), fr = lane_e & 15, fq = lane_e >> 4; (void)fr_; (void)fq_;
        const int col0 = u.pn * BM + wc * 32 + 8 * fq;
#pragma unroll
        for (int ai = 0; ai < 2; ++ai)
#pragma unroll
            for (int m = 0; m < 4; ++m) { const size_t row = (size_t)u.pm * BM + ai * HALF + wr * 64 + m * 16 + fr; float ss = 0.f;
#pragma unroll
                for (int bj = 0; bj < 2; ++bj) { bf16_t* xp = XB + row * 1024 + col0 + bj * HALF;
                    const u32x4 xw = *(const u32x4*)xp;
                    const f32x4 o0 = (f32x4){bflo(xw.x), bfhi(xw.x), bflo(xw.y), bfhi(xw.y)} + acc[ai][bj][m][0], o1 = (f32x4){bflo(xw.z), bfhi(xw.z), bflo(xw.w), bfhi(xw.w)} + acc[ai][bj][m][1];
                    if (final_f32) { float* op = out + row * 1024 + col0 + bj * HALF; *(f32x4*)op = o0; *(f32x4*)(op + 4) = o1; }
                    else { u32x4 w; w.x = pk2(o0[0], o0[1]); w.y = pk2(o0[2], o0[3]); w.z = pk2(o1[0], o1[1]); w.w = pk2(o1[2], o1[3]); *(u32x4*)xp = w; ss += dot4(o0) + dot4(o1); } }
                if (!final_f32) { ss = sum32(sum16(ss)); if (fq == 0) atomicAdd(ssq + row, ss); }
                if (m & 1) asm volatile("" ::: "memory"); }
    }
};

struct EpiQ {
    static constexpr bool PERM = true, AFTER_DRAIN = false;
    bf16_t* QNP; bf16_t* QRP; const float* gqn; const float* gqr; const float* rope; const float* ssqQ;
    __device__ __forceinline__ void operator()(const f32x4 (&acc)[2][2][4][2], const Unit& u, int wr, int wc, int fr_, int fq_) const {
        unsigned z_e = 0u; asm volatile("" : "+v"(z_e)); const int lane_e = (int)__builtin_amdgcn_mbcnt_hi(~0u, __builtin_amdgcn_mbcnt_lo(~0u, z_e)), fr = lane_e & 15, fq = lane_e >> 4; (void)fr_; (void)fq_;
        const int row0 = u.pm * BM + wr * 64 + fr;
        float rq[2][4];
#pragma unroll
        for (int ai = 0; ai < 2; ++ai)
#pragma unroll
            for (int m = 0; m < 4; ++m) rq[ai][m] = ssqQ[row0 + ai * HALF + m * 16];
#pragma unroll
        for (int ai = 0; ai < 2; ++ai)
#pragma unroll
            for (int m = 0; m < 4; ++m) rq[ai][m] = rsq(rq[ai][m] * (1.0f / 256.0f) + EPS);
        if (u.pn < 2) {
            const int head = 4 * u.pn + wc;
            f32x4 gv[2][2];
#pragma unroll
            for (int bj = 0; bj < 2; ++bj)
#pragma unroll
                for (int n = 0; n < 2; ++n) gv[bj][n] = *(const f32x4*)(gqn + 32 * bj + 8 * fq + 4 * n) * QSCALE;
#pragma unroll
            for (int ai = 0; ai < 2; ++ai)
#pragma unroll
                for (int m = 0; m < 4; ++m) { const int row = row0 + ai * HALF + m * 16;
                    float ss = (dot4(acc[ai][0][m][0]) + dot4(acc[ai][0][m][1])) + (dot4(acc[ai][1][m][0]) + dot4(acc[ai][1][m][1]));
                    ss = sum32(sum16(ss)) * (rq[ai][m] * rq[ai][m]);
                    const float rn = rsq(ss * (1.0f / 64.0f) + EPS) * rq[ai][m];
#pragma unroll
                    for (int bj = 0; bj < 2; ++bj) { const f32x4 v0 = acc[ai][bj][m][0] * gv[bj][0] * rn, v1 = acc[ai][bj][m][1] * gv[bj][1] * rn;
                        u32x4 w; w.x = pk2(v0[0], v0[1]); w.y = pk2(v0[2], v0[3]); w.z = pk2(v1[0], v1[1]); w.w = pk2(v1[2], v1[3]);
                        *(u32x4*)(QNP + (size_t)row * 512 + head * 64 + 32 * bj + 8 * fq) = w; }  __builtin_amdgcn_sched_barrier(0); }
        } else {
            const f32x4 g1 = *(const f32x4*)(gqr + 4 * fq) * QSCALE, g2 = *(const f32x4*)(gqr + 16 + 4 * fq) * QSCALE;
#pragma unroll
            for (int ai = 0; ai < 2; ++ai)
#pragma unroll
                for (int m = 0; m < 4; ++m) { const int row = row0 + ai * HALF + m * 16;
                    const int posidx = row < MP ? (row & 2047) : 2048 + ((row - MP) & 63);
                    const float* rp = rope + (size_t)(posidx * 16 + 4 * fq) * 2;
                    const f32x4 cs0 = *(const f32x4*)rp, cs1 = *(const f32x4*)(rp + 4);
                    const f32x4 cc = {cs0[0], cs0[2], cs1[0], cs1[2]}, sn = {cs0[1], cs0[3], cs1[1], cs1[3]};
#pragma unroll
                    for (int bj = 0; bj < 2; ++bj) { const f32x4 x1 = acc[ai][bj][m][0], x2 = acc[ai][bj][m][1];
                        float ss = dot4(x1) + dot4(x2); ss = sum32(sum16(ss)) * (rq[ai][m] * rq[ai][m]);
                        const float rn = rsq(ss * (1.0f / 32.0f) + EPS) * rq[ai][m];
                        const f32x4 a = x1 * g1 * rn, b = x2 * g2 * rn;
                        const f32x4 o1 = a * cc - b * sn, o2 = a * sn + b * cc;
                        const int head = 2 * wc + bj;
                        u32x2 w1, w2; w1.x = pk2(o1[0], o1[1]); w1.y = pk2(o1[2], o1[3]); w2.x = pk2(o2[0], o2[1]); w2.y = pk2(o2[2], o2[3]);
                        bf16_t* qp = QRP + (size_t)row * 256 + head * 32 + 4 * fq;
                        *(u32x2*)qp = w1; *(u32x2*)(qp + 16) = w2; }  __builtin_amdgcn_sched_barrier(0); }
        }
    }
};

struct EpiKV {
    static constexpr bool PERM = true, AFTER_DRAIN = false;
    bf16_t* KN; bf16_t* VV; const float* gkn; const float* ssqC;
    __device__ __forceinline__ void operator()(const f32x4 (&acc)[2][2][4][2], const Unit& u, int wr, int wc, int fr_, int fq_) const {
        unsigned z_e = 0u; asm volatile("" : "+v"(z_e)); const int lane_e = (int)__builtin_amdgcn_mbcnt_hi(~0u, __builtin_amdgcn_mbcnt_lo(~0u, z_e)), fr = lane_e & 15, fq = lane_e >> 4; (void)fr_; (void)fq_;
        const int row0 = u.pm * BM + wr * 64 + fr;
        float rc[2][4];
#pragma unroll
        for (int ai = 0; ai < 2; ++ai)
#pragma unroll
            for (int m = 0; m < 4; ++m) rc[ai][m] = ssqC ? ssqC[row0 + ai * HALF + m * 16] : 0.f;
#pragma unroll
        for (int ai = 0; ai < 2; ++ai)
#pragma unroll
            for (int m = 0; m < 4; ++m) rc[ai][m] = ssqC ? rsq(rc[ai][m] * (1.0f / 128.0f) + EPS) : 1.0f;
        if (u.pn < 2) {
            const int head = 4 * u.pn + wc;
            f32x4 gv[2][2];
#pragma unroll
            for (int bj = 0; bj < 2; ++bj)
#pragma unroll
                for (int n = 0; n < 2; ++n) gv[bj][n] = *(const f32x4*)(gkn + 32 * bj + 8 * fq + 4 * n);
#pragma unroll
            for (int ai = 0; ai < 2; ++ai)
#pragma unroll
                for (int m = 0; m < 4; ++m) { const int row = row0 + ai * HALF + m * 16;
                    float ss = (dot4(acc[ai][0][m][0]) + dot4(acc[ai][0][m][1])) + (dot4(acc[ai][1][m][0]) + dot4(acc[ai][1][m][1]));
                    ss = sum32(sum16(ss)) * (rc[ai][m] * rc[ai][m]);
                    const float rn = rsq(ss * (1.0f / 64.0f) + EPS) * rc[ai][m];
#pragma unroll
                    for (int bj = 0; bj < 2; ++bj) { const f32x4 v0 = acc[ai][bj][m][0] * gv[bj][0] * rn, v1 = acc[ai][bj][m][1] * gv[bj][1] * rn;
                        u32x4 w; w.x = pk2(v0[0], v0[1]); w.y = pk2(v0[2], v0[3]); w.z = pk2(v1[0], v1[1]); w.w = pk2(v1[2], v1[3]);
                        *(u32x4*)(KN + (size_t)row * 512 + head * 64 + 32 * bj + 8 * fq) = w; }  __builtin_amdgcn_sched_barrier(0); }
        } else {
            const int head = 4 * (u.pn - 2) + wc;
#pragma unroll
            for (int ai = 0; ai < 2; ++ai)
#pragma unroll
                for (int m = 0; m < 4; ++m) { const int row = row0 + ai * HALF + m * 16;
#pragma unroll
                    for (int bj = 0; bj < 2; ++bj) { const f32x4 v0 = acc[ai][bj][m][0] * rc[ai][m], v1 = acc[ai][bj][m][1] * rc[ai][m];
                        u32x4 w; w.x = pk2(v0[0], v0[1]); w.y = pk2(v0[2], v0[3]); w.z = pk2(v1[0], v1[1]); w.w = pk2(v1[2], v1[3]);
                        *(u32x4*)(VV + (size_t)row * 512 + head * 64 + 32 * bj + 8 * fq) = w; }  __builtin_amdgcn_sched_barrier(0); }
        }
    }
};

template <class Epi, class Sched, bool ALIGN_EPI = false, bool SP2 = false>
__device__ __forceinline__ void gemm_phase(PG8_LAS unsigned char* lds, const Gemm g, const Sched& S, const Epi& E, const int wid_in) {
    int wid = wid_in; asm volatile("" : "+s"(wid));
    unsigned z_ = 0u; asm volatile("" : "+v"(z_)); const int lane_ = (int)__builtin_amdgcn_mbcnt_hi(~0u, __builtin_amdgcn_mbcnt_lo(~0u, z_));
    const int lane = lane_, tid = wid * 64 + lane, wr = wid >> 2, wc = wid & 3, fr = lane & 15, fq = lane >> 4;
    const int K = g.K, nt = K / BK;
    unsigned voffA[2], voffB[2];
#pragma unroll
    for (int i = 0; i < 2; ++i) { int R, C; stage_rc(tid * 16 + i * 8192, R, C); const int Rb = Epi::PERM ? ((R & ~31) + perm32(R & 31)) : R;
        voffA[i] = (unsigned)(R * g.lda + C) * 2u; voffB[i] = (unsigned)(Rb * K + C) * 2u; }
    const size_t kstep = (size_t)(BK * 2);
    const size_t hstepA = (size_t)HALF * g.lda * 2, hstepB = (size_t)HALF * K * 2;
    const size_t tstepA = 2 * hstepA, tstepB = 2 * hstepB;
    const unsigned ldsw = (unsigned)wid * 1024u;
    const int aoff = lds_byte(wr * 64 + fr, fq * 8), boff = lds_byte(wc * 32 + fr, fq * 8);
#define PG8_SA(b, h) (((b) * 2 + (h)) * HTB)
#define PG8_SB(b, h) ((4 + (b) * 2 + (h)) * HTB)
#define PG8_STAGE(bufoff, gbase, voff) do { _Pragma("unroll") for (int _i = 0; _i < 2; ++_i) \
        __builtin_amdgcn_global_load_lds((const unsigned*)((const char*)(gbase) + (voff)[_i]), (PG8_LAS unsigned*)(lds + (bufoff) + ldsw + _i * 8192), 16, 0, 0); } while (0)
#define PG8_LDA(dst, b, h) do { _Pragma("unroll") for (int m = 0; m < 4; ++m) _Pragma("unroll") for (int k = 0; k < 2; ++k) dst[m][k] = *(const PG8_LAS bf16x8*)(lds + PG8_SA(b, h) + aoff + m * 2048 + k * 1024); } while (0)
#define PG8_LDB(dst, b, h) do { _Pragma("unroll") for (int n = 0; n < 2; ++n) _Pragma("unroll") for (int k = 0; k < 2; ++k) dst[n][k] = *(const PG8_LAS bf16x8*)(lds + PG8_SB(b, h) + boff + n * 2048 + k * 1024); } while (0)
#define PG8_MMA(ai, bj, At, Bt) do { __builtin_amdgcn_s_setprio(1); _Pragma("unroll") for (int m = 0; m < 4; ++m) _Pragma("unroll") for (int n = 0; n < 2; ++n) _Pragma("unroll") for (int k = 0; k < 2; ++k) \
        acc[ai][bj][m][n] = __builtin_amdgcn_mfma_f32_16x16x32_bf16(Bt[n][k], At[m][k], acc[ai][bj][m][n], 0, 0, 0); __builtin_amdgcn_s_setprio(0); } while (0)
#define PG8_WAIT_V(n) asm volatile("s_waitcnt vmcnt(" #n ")" ::: "memory")
#define PG8_WAIT_L(n) asm volatile("s_waitcnt lgkmcnt(" #n ")" ::: "memory")
#define PG8_BAR __builtin_amdgcn_s_barrier()
#define PG8_SCHED __builtin_amdgcn_sched_barrier(0)
    Unit cur, nxt; int ui = 0;
    if (!S.next(0, cur)) return;
    f32x4 acc[2][2][4][2];
#pragma unroll
    for (int a = 0; a < 2; ++a)
#pragma unroll
        for (int b = 0; b < 2; ++b)
#pragma unroll
            for (int m = 0; m < 4; ++m)
#pragma unroll
                for (int n = 0; n < 2; ++n) acc[a][b][m][n] = (f32x4){0.f, 0.f, 0.f, 0.f};
    bf16x8 At[4][2], B0[2][2], B1[2][2];
    const char* cA = (const char*)g.A + (size_t)cur.pm * tstepA; const char* cB = (const char*)g.Bt + (size_t)cur.pn * tstepB;
    S.a_ready(cur);
    if constexpr (SP2) {
        PG8_STAGE(PG8_SB(0, 0), cB, voffB); PG8_STAGE(PG8_SB(0, 1), cB + hstepB, voffB); PG8_STAGE(PG8_SA(0, 0), cA, voffA); PG8_STAGE(PG8_SA(0, 1), cA + hstepA, voffA);
        if (wr == 1) PG8_BAR;
        PG8_WAIT_V(2); PG8_BAR;
        PG8_STAGE(PG8_SB(1, 0), cB + kstep, voffB); PG8_STAGE(PG8_SA(1, 0), cA + kstep, voffA); PG8_STAGE(PG8_SB(1, 1), cB + hstepB + kstep, voffB);
        PG8_WAIT_V(6); PG8_BAR;
    } else {
        PG8_STAGE(PG8_SB(0, 0), cB, voffB); PG8_STAGE(PG8_SA(0, 0), cA, voffA); PG8_STAGE(PG8_SB(0, 1), cB + hstepB, voffB); PG8_STAGE(PG8_SA(0, 1), cA + hstepA, voffA);
        if (wr == 1) PG8_BAR;
        PG8_WAIT_V(4); PG8_BAR;
        PG8_STAGE(PG8_SB(1, 0), cB + kstep, voffB); PG8_STAGE(PG8_SA(1, 0), cA + kstep, voffA); PG8_STAGE(PG8_SB(1, 1), cB + hstepB + kstep, voffB);
        PG8_WAIT_V(6); PG8_BAR;
    }
    for (;;) {
        const bool has_next = S.next(ui + 1, nxt);
        const char* nA = has_next ? (const char*)g.A + (size_t)nxt.pm * tstepA : cA; const char* nB = has_next ? (const char*)g.Bt + (size_t)nxt.pn * tstepB : cB;
        for (int t = 0; t < nt; t += 2) {
            const bool last = (t == nt - 2);
            const char* a1 = cA + (size_t)(t + 1) * kstep;
            const char* a2 = last ? nA : cA + (size_t)(t + 2) * kstep; const char* b2 = last ? nB : cB + (size_t)(t + 2) * kstep;
            const char* a3 = a2 + kstep; const char* b3 = b2 + kstep;
            if (last && has_next) S.a_ready(nxt);
            if constexpr (SP2) {
            PG8_LDB(B0, 0, 0); PG8_LDB(B1, 0, 1); PG8_SCHED; PG8_LDA(At, 0, 0); PG8_STAGE(PG8_SA(1, 1), a1 + hstepA, voffA);
            PG8_WAIT_V(8); PG8_WAIT_L(0); PG8_BAR; PG8_MMA(0, 0, At, B0); PG8_MMA(0, 1, At, B1); PG8_BAR; PG8_SCHED;
            PG8_LDA(At, 0, 1); PG8_STAGE(PG8_SB(0, 0), b2, voffB); PG8_STAGE(PG8_SB(0, 1), b2 + hstepB, voffB); PG8_STAGE(PG8_SA(0, 0), a2, voffA);
            PG8_WAIT_V(8); PG8_WAIT_L(0); PG8_BAR; PG8_MMA(1, 0, At, B0); PG8_MMA(1, 1, At, B1); PG8_BAR; PG8_SCHED;
            PG8_LDB(B0, 1, 0); PG8_LDB(B1, 1, 1); PG8_SCHED; PG8_LDA(At, 1, 0); PG8_STAGE(PG8_SA(0, 1), a2 + hstepA, voffA);
            PG8_WAIT_V(8); PG8_WAIT_L(0); PG8_BAR; PG8_MMA(0, 0, At, B0); PG8_MMA(0, 1, At, B1); PG8_BAR; PG8_SCHED;
            PG8_LDA(At, 1, 1); PG8_STAGE(PG8_SB(1, 0), b3, voffB); PG8_STAGE(PG8_SB(1, 1), b3 + hstepB, voffB); PG8_STAGE(PG8_SA(1, 0), a3, voffA);
            PG8_WAIT_V(8); PG8_WAIT_L(0); PG8_BAR; PG8_MMA(1, 0, At, B0); PG8_MMA(1, 1, At, B1); PG8_BAR; PG8_SCHED;
            } else {
            PG8_LDB(B0, 0, 0); PG8_SCHED; PG8_LDA(At, 0, 0); PG8_STAGE(PG8_SA(1, 1), a1 + hstepA, voffA);
            PG8_WAIT_L(8); PG8_BAR; PG8_WAIT_L(0); PG8_MMA(0, 0, At, B0); PG8_BAR; PG8_SCHED;
            PG8_LDB(B1, 0, 1); PG8_STAGE(PG8_SB(0, 0), b2, voffB);
            PG8_BAR; PG8_WAIT_L(0); PG8_MMA(0, 1, At, B1); PG8_BAR;
            PG8_LDA(At, 0, 1); PG8_STAGE(PG8_SA(0, 0), a2, voffA);
            PG8_BAR; PG8_WAIT_L(0); PG8_MMA(1, 0, At, B0); PG8_BAR; PG8_SCHED;
            PG8_STAGE(PG8_SB(0, 1), b2 + hstepB, voffB);
            PG8_WAIT_V(6); PG8_BAR; PG8_MMA(1, 1, At, B1); PG8_BAR;
            PG8_LDB(B0, 1, 0); PG8_SCHED; PG8_LDA(At, 1, 0); PG8_STAGE(PG8_SA(0, 1), a2 + hstepA, voffA);
            PG8_WAIT_L(8); PG8_BAR; PG8_WAIT_L(0); PG8_MMA(0, 0, At, B0); PG8_BAR; PG8_SCHED;
            PG8_LDB(B1, 1, 1); PG8_STAGE(PG8_SB(1, 0), b3, voffB);
            PG8_BAR; PG8_WAIT_L(0); PG8_MMA(0, 1, At, B1); PG8_BAR;
            PG8_LDA(At, 1, 1); PG8_STAGE(PG8_SA(1, 0), a3, voffA);
            PG8_BAR; PG8_WAIT_L(0); PG8_MMA(1, 0, At, B0); PG8_BAR; PG8_SCHED;
            PG8_STAGE(PG8_SB(1, 1), b3 + hstepB, voffB);
            PG8_WAIT_V(6); PG8_BAR; PG8_MMA(1, 1, At, B1); PG8_BAR;
            }
        }
        if constexpr (ALIGN_EPI) { if (wr == 0) PG8_BAR; }
        if constexpr (!Epi::AFTER_DRAIN) { E(acc, cur, wr, wc, fr, fq); S.done(cur); }
        if (!has_next) break;
#pragma unroll
        for (int a = 0; a < 2; ++a)
#pragma unroll
            for (int b = 0; b < 2; ++b)
#pragma unroll
                for (int m = 0; m < 4; ++m)
#pragma unroll
                    for (int n = 0; n < 2; ++n) acc[a][b][m][n] = (f32x4){0.f, 0.f, 0.f, 0.f};
        cur = nxt; cA = nA; cB = nB; ++ui;
        if constexpr (ALIGN_EPI) { if (wr == 1) PG8_BAR; }
    }
    PG8_WAIT_V(0);
    if constexpr (!ALIGN_EPI) { if (wr == 0) PG8_BAR; }
    PG8_BAR;
    if constexpr (Epi::AFTER_DRAIN) { E.fused(acc, cur, wr, wc, fr, fq, lds, wid, lane); S.done(cur); }
#undef PG8_SA
#undef PG8_SB
#undef PG8_STAGE
#undef PG8_LDA
#undef PG8_LDB
#undef PG8_MMA
#undef PG8_WAIT_V
#undef PG8_WAIT_L
#undef PG8_BAR
#undef PG8_SCHED
}
}
namespace att {
constexpr int KSTR = 208, VSTR = 192, KB_BYTES = 64 * KSTR, VB_BYTES = 64 * VSTR, TILE_BYTES = KB_BYTES + VB_BYTES;
typedef short v4i16_t __attribute__((ext_vector_type(4)));
__device__ __forceinline__ s16x4 vtr(const LAS char* p) { return __builtin_bit_cast(s16x4, __builtin_amdgcn_ds_read_tr16_b64_v4i16((LAS v4i16_t*)p)); }
__device__ __forceinline__ bf16x8 cat8(s16x4 lo, s16x4 hi) { return (bf16x8){lo[0], lo[1], lo[2], lo[3], hi[0], hi[1], hi[2], hi[3]}; }

struct Ptrs { const bf16* QNP; const bf16* QRP; const bf16* KN; const bf16* VV; const bf16* KR; bf16* MRG; const float* gout; };
struct Stage { u32x4 kn, kr, vv; };

__device__ __forceinline__ void stage_load(Stage& s, const Ptrs& P, size_t krow0, int h, int tid) {
    const int row = tid >> 3, ch = tid & 7;
    s.kn = *(const u32x4*)(P.KN + (krow0 + row) * 512 + h * 64 + ch * 8);
    s.vv = *(const u32x4*)(P.VV + (krow0 + row) * 512 + h * 64 + ch * 8);
    if (tid < 256) { const int r2 = tid >> 2, c2 = tid & 3; s.kr = *(const u32x4*)(P.KR + (krow0 + r2) * 32 + c2 * 8); }
}
__device__ __forceinline__ void stage_store(const Stage& s, LAS char* buf, int tid) {
    const int row = tid >> 3, ch = tid & 7;
    *(LAS u32x4*)(buf + row * KSTR + ch * 16) = s.kn;
    *(LAS u32x4*)(buf + KB_BYTES + row * VSTR + ch * 16) = s.vv;
    if (tid < 256) { const int r2 = tid >> 2, c2 = tid & 3; *(LAS u32x4*)(buf + r2 * KSTR + 128 + c2 * 16) = s.kr; }
}
__device__ __forceinline__ void load_q(bf16x8 (&qf)[6], const Ptrs& P, size_t qrow, int h, int hi) {
#pragma unroll
    for (int s = 0; s < 4; ++s) qf[s] = *(const bf16x8*)(P.QNP + qrow * 512 + h * 64 + 16 * s + 8 * hi);
#pragma unroll
    for (int s = 0; s < 2; ++s) qf[4 + s] = *(const bf16x8*)(P.QRP + qrow * 256 + h * 32 + 16 * s + 8 * hi);
}

template <bool FIRST>
__device__ __forceinline__ void attn_tile(const LAS char* buf, const bf16x8 (&qf)[6], float& mrun, float& lrun, f32x16& o0, f32x16& o1, f32x16& negm, int lane) {
    const int r32 = lane & 31, hi = lane >> 5;
    const LAS char* kp = buf + r32 * KSTR + hi * 16;
    f32x16 p0, p1;
    { const bf16x8 a0 = *(const LAS bf16x8*)(kp), a1 = *(const LAS bf16x8*)(kp + 32 * KSTR);
      if (FIRST) { const f32x16 z = {}; p0 = __builtin_amdgcn_mfma_f32_32x32x16_bf16(a0, qf[0], z, 0, 0, 0); p1 = __builtin_amdgcn_mfma_f32_32x32x16_bf16(a1, qf[0], z, 0, 0, 0); }
      else { p0 = __builtin_amdgcn_mfma_f32_32x32x16_bf16(a0, qf[0], negm, 0, 0, 0); p1 = __builtin_amdgcn_mfma_f32_32x32x16_bf16(a1, qf[0], negm, 0, 0, 0); } }
#pragma unroll
    for (int s = 1; s < 6; ++s) {
        const bf16x8 a0 = *(const LAS bf16x8*)(kp + s * 32), a1 = *(const LAS bf16x8*)(kp + 32 * KSTR + s * 32);
        p0 = __builtin_amdgcn_mfma_f32_32x32x16_bf16(a0, qf[s], p0, 0, 0, 0);
        p1 = __builtin_amdgcn_mfma_f32_32x32x16_bf16(a1, qf[s], p1, 0, 0, 0);
    }
    float mx = fmaxf(p0[0], p1[0]);
#pragma unroll
    for (int r = 1; r < 16; ++r) mx = fmaxf(mx, fmaxf(p0[r], p1[r]));
    mx = max32(mx);
    if (FIRST) {
        mrun = mx;
#pragma unroll
        for (int r = 0; r < 16; ++r) { p0[r] -= mx; p1[r] -= mx; negm[r] = -mx; }
    } else if (__any(mx > 6.0f)) {
        const float dl = fmaxf(mx, 0.f), alpha = __builtin_amdgcn_exp2f(-dl);
        mrun += dl; lrun *= alpha;
#pragma unroll
        for (int r = 0; r < 16; ++r) { p0[r] -= dl; p1[r] -= dl; negm[r] = -mrun; }
        o0 *= alpha; o1 *= alpha;
    }
    float sum = 0.f;
#pragma unroll
    for (int r = 0; r < 16; ++r) { p0[r] = __builtin_amdgcn_exp2f(p0[r]); p1[r] = __builtin_amdgcn_exp2f(p1[r]); sum += p0[r] + p1[r]; }
    lrun += sum;
    u32x4 pw[4];
#pragma unroll
    for (int j = 0; j < 4; ++j) { pw[0][j] = pk2(p0[2 * j], p0[2 * j + 1]); pw[1][j] = pk2(p0[8 + 2 * j], p0[8 + 2 * j + 1]); pw[2][j] = pk2(p1[2 * j], p1[2 * j + 1]); pw[3][j] = pk2(p1[8 + 2 * j], p1[8 + 2 * j + 1]); }
    const LAS char* vp = buf + KB_BYTES + (4 * hi + ((lane & 15) >> 2)) * VSTR + (16 * ((lane >> 4) & 1) + 4 * (lane & 3)) * 2;
#pragma unroll
    for (int ks = 0; ks < 4; ++ks) {
        const bf16x8 pf = __builtin_bit_cast(bf16x8, pw[ks]);
        const bf16x8 v0 = cat8(vtr(vp + ks * 16 * VSTR), vtr(vp + (ks * 16 + 8) * VSTR));
        const bf16x8 v1 = cat8(vtr(vp + ks * 16 * VSTR + 64), vtr(vp + (ks * 16 + 8) * VSTR + 64));
        o0 = __builtin_amdgcn_mfma_f32_32x32x16_bf16(v0, pf, o0, 0, 0, 0);
        o1 = __builtin_amdgcn_mfma_f32_32x32x16_bf16(v1, pf, o1, 0, 0, 0);
    }
}

__device__ __forceinline__ void finalize(const Ptrs& P, size_t qrow, int h, float lrun, f32x16& o0, f32x16& o1, int lane) {
    const int hi = lane >> 5;
    const float l = sum32(lrun), inv = 1.0f / l;
    o0 *= inv; o1 *= inv;
    float ss = 0.f;
#pragma unroll
    for (int r = 0; r < 16; ++r) ss += o0[r] * o0[r] + o1[r] * o1[r];
    ss = sum32(ss);
    const float rn = rsq(ss * (1.0f / 64.0f) + EPS);
    const float* g = P.gout + h * 64; bf16* op = P.MRG + qrow * 1024 + h * 64;
#pragma unroll
    for (int rg = 0; rg < 4; ++rg) { const int d0 = 8 * rg + 4 * hi;
        const f32x4 g0 = *(const f32x4*)(g + d0), g1 = *(const f32x4*)(g + 32 + d0);
        u32x2 w0, w1;
        w0.x = pk2(o0[4 * rg] * rn * g0[0], o0[4 * rg + 1] * rn * g0[1]); w0.y = pk2(o0[4 * rg + 2] * rn * g0[2], o0[4 * rg + 3] * rn * g0[3]);
        w1.x = pk2(o1[4 * rg] * rn * g1[0], o1[4 * rg + 1] * rn * g1[1]); w1.y = pk2(o1[4 * rg + 2] * rn * g1[2], o1[4 * rg + 3] * rn * g1[3]);
        *(u32x2*)(op + d0) = w0; *(u32x2*)(op + 32 + d0) = w1; }
}

template <bool FIRST>
__device__ __forceinline__ void attn_tile2(const LAS char* bufA, const LAS char* bufB, int nv, const bf16x8 (&qf)[6], float& mrun, float& lrun, f32x16& o0, f32x16& o1, f32x16& negm, int lane) {
    const int r32 = lane & 31, hi = lane >> 5;
    const LAS char* kpa = bufA + r32 * KSTR + hi * 16; const LAS char* kpb = bufB + r32 * KSTR + hi * 16;
    f32x16 p0, p1, p2, p3;
    { const bf16x8 a0 = *(const LAS bf16x8*)(kpa), a1 = *(const LAS bf16x8*)(kpa + 32 * KSTR), a2 = *(const LAS bf16x8*)(kpb), a3 = *(const LAS bf16x8*)(kpb + 32 * KSTR);
      if (FIRST) { const f32x16 z = {}; p0 = __builtin_amdgcn_mfma_f32_32x32x16_bf16(a0, qf[0], z, 0, 0, 0); p1 = __builtin_amdgcn_mfma_f32_32x32x16_bf16(a1, qf[0], z, 0, 0, 0);
                   p2 = __builtin_amdgcn_mfma_f32_32x32x16_bf16(a2, qf[0], z, 0, 0, 0); p3 = __builtin_amdgcn_mfma_f32_32x32x16_bf16(a3, qf[0], z, 0, 0, 0); }
      else { p0 = __builtin_amdgcn_mfma_f32_32x32x16_bf16(a0, qf[0], negm, 0, 0, 0); p1 = __builtin_amdgcn_mfma_f32_32x32x16_bf16(a1, qf[0], negm, 0, 0, 0);
             p2 = __builtin_amdgcn_mfma_f32_32x32x16_bf16(a2, qf[0], negm, 0, 0, 0); p3 = __builtin_amdgcn_mfma_f32_32x32x16_bf16(a3, qf[0], negm, 0, 0, 0); } }
#pragma unroll
    for (int s = 1; s < 6; ++s) {
        const bf16x8 a0 = *(const LAS bf16x8*)(kpa + s * 32), a1 = *(const LAS bf16x8*)(kpa + 32 * KSTR + s * 32), a2 = *(const LAS bf16x8*)(kpb + s * 32), a3 = *(const LAS bf16x8*)(kpb + 32 * KSTR + s * 32);
        p0 = __builtin_amdgcn_mfma_f32_32x32x16_bf16(a0, qf[s], p0, 0, 0, 0); p1 = __builtin_amdgcn_mfma_f32_32x32x16_bf16(a1, qf[s], p1, 0, 0, 0);
        p2 = __builtin_amdgcn_mfma_f32_32x32x16_bf16(a2, qf[s], p2, 0, 0, 0); p3 = __builtin_amdgcn_mfma_f32_32x32x16_bf16(a3, qf[s], p3, 0, 0, 0);
    }
    if (nv < 2) {
#pragma unroll
        for (int r = 0; r < 16; ++r) { p2[r] = -1e30f; p3[r] = -1e30f; } }
    float mx = fmaxf(fmaxf(p0[0], p1[0]), fmaxf(p2[0], p3[0]));
#pragma unroll
    for (int r = 1; r < 16; ++r) mx = fmaxf(mx, fmaxf(fmaxf(p0[r], p1[r]), fmaxf(p2[r], p3[r])));
    mx = max32(mx);
    if (FIRST) {
        mrun = mx;
#pragma unroll
        for (int r = 0; r < 16; ++r) { p0[r] -= mx; p1[r] -= mx; p2[r] -= mx; p3[r] -= mx; negm[r] = -mx; }
    } else if (__any(mx > 6.0f)) {
        const float dl = fmaxf(mx, 0.f), alpha = __builtin_amdgcn_exp2f(-dl);
        mrun += dl; lrun *= alpha;
#pragma unroll
        for (int r = 0; r < 16; ++r) { p0[r] -= dl; p1[r] -= dl; p2[r] -= dl; p3[r] -= dl; negm[r] = -mrun; }
        o0 *= alpha; o1 *= alpha;
    }
    float sa = 0.f, sb = 0.f;
#pragma unroll
    for (int r = 0; r < 16; ++r) { p0[r] = __builtin_amdgcn_exp2f(p0[r]); p1[r] = __builtin_amdgcn_exp2f(p1[r]); p2[r] = __builtin_amdgcn_exp2f(p2[r]); p3[r] = __builtin_amdgcn_exp2f(p3[r]); sa += p0[r] + p1[r]; sb += p2[r] + p3[r]; }
    lrun += sa + sb;
    u32x4 pw[8];
#pragma unroll
    for (int j = 0; j < 4; ++j) { pw[0][j] = pk2(p0[2 * j], p0[2 * j + 1]); pw[1][j] = pk2(p0[8 + 2 * j], p0[8 + 2 * j + 1]); pw[2][j] = pk2(p1[2 * j], p1[2 * j + 1]); pw[3][j] = pk2(p1[8 + 2 * j], p1[8 + 2 * j + 1]);
                                  pw[4][j] = pk2(p2[2 * j], p2[2 * j + 1]); pw[5][j] = pk2(p2[8 + 2 * j], p2[8 + 2 * j + 1]); pw[6][j] = pk2(p3[2 * j], p3[2 * j + 1]); pw[7][j] = pk2(p3[8 + 2 * j], p3[8 + 2 * j + 1]); }
    const int voff = (4 * hi + ((lane & 15) >> 2)) * VSTR + (16 * ((lane >> 4) & 1) + 4 * (lane & 3)) * 2;
#pragma unroll
    for (int ks = 0; ks < 8; ++ks) {
        if (ks >= 4 && nv < 2) break;
        const LAS char* vp = (ks < 4 ? bufA : bufB) + KB_BYTES + voff;
        const int kk = ks & 3;
        const bf16x8 pf = __builtin_bit_cast(bf16x8, pw[ks]);
        const bf16x8 v0 = cat8(vtr(vp + kk * 16 * VSTR), vtr(vp + (kk * 16 + 8) * VSTR));
        const bf16x8 v1 = cat8(vtr(vp + kk * 16 * VSTR + 64), vtr(vp + (kk * 16 + 8) * VSTR + 64));
        o0 = __builtin_amdgcn_mfma_f32_32x32x16_bf16(v0, pf, o0, 0, 0, 0);
        o1 = __builtin_amdgcn_mfma_f32_32x32x16_bf16(v1, pf, o1, 0, 0, 0);
    }
}

__device__ __forceinline__ void prompt_unit(const Ptrs& P, int b, int h, int qb, LAS char* lds, int tid_in, int lane_in, int wid) {
    int tid = tid_in, lane = lane_in; asm volatile("" : "+v"(tid), "+v"(lane));
    const size_t rowbase = (size_t)b * 2048; const int r32 = lane & 31, hi = lane >> 5;
    const size_t qrow = rowbase + qb * 256 + wid * 32 + r32;
    bf16x8 qf[6]; load_q(qf, P, qrow, h, hi);
    const int NT = 4 * qb + 4, myNT = 4 * qb + (wid >> 1) + 1, NP = NT >> 1;
    float mrun = 0.f, lrun = 0.f; f32x16 o0 = {}, o1 = {}, negm = {};
    Stage sa, sb; stage_load(sa, P, rowbase, h, tid); stage_load(sb, P, rowbase + 64, h, tid);
    stage_store(sa, lds, tid); stage_store(sb, lds + TILE_BYTES, tid); __syncthreads();
    stage_load(sa, P, rowbase + 128, h, tid); stage_load(sb, P, rowbase + 192, h, tid);
    for (int i = 0; i < NP; ++i) {
        LAS char* cur = lds + (i & 1) * (2 * TILE_BYTES); LAS char* nxt = lds + ((i + 1) & 1) * (2 * TILE_BYTES);
        const int nv = myNT - 2 * i;
        if (i == 0) attn_tile2<true>(cur, cur + TILE_BYTES, nv, qf, mrun, lrun, o0, o1, negm, lane);
        else if (nv >= 1) attn_tile2<false>(cur, cur + TILE_BYTES, nv, qf, mrun, lrun, o0, o1, negm, lane);
        if (i + 1 < NP) { stage_store(sa, nxt, tid); stage_store(sb, nxt + TILE_BYTES, tid); }
        __syncthreads();
        if (i + 2 < NP) { stage_load(sa, P, rowbase + (size_t)(2 * i + 4) * 64, h, tid); stage_load(sb, P, rowbase + (size_t)(2 * i + 5) * 64, h, tid); }
    }
    finalize(P, qrow, h, lrun, o0, o1, lane);
}

constexpr int LSTR = 320, STILE_BYTES = KB_BYTES + 64 * LSTR;
struct SStage { u32x4 kn, kr, c0, c1; };
__device__ __forceinline__ void sstage_load(SStage& s, const Ptrs& P, const bf16* CL, size_t krow0, int h, int tid) {
    const int row = tid >> 3, ch = tid & 7;
    s.kn = *(const u32x4*)(P.KN + (krow0 + row) * 512 + h * 64 + ch * 8);
    if (tid < 256) { const int r2 = tid >> 2, c2 = tid & 3; s.kr = *(const u32x4*)(P.KR + (krow0 + r2) * 32 + c2 * 8); }
    const int lr = tid >> 4, lc = tid & 15;
    s.c0 = *(const u32x4*)(CL + (krow0 + lr) * 128 + lc * 8);
    s.c1 = *(const u32x4*)(CL + (krow0 + 32 + lr) * 128 + lc * 8);
}
__device__ __forceinline__ void sstage_store(const SStage& s, LAS char* buf, int tid) {
    const int row = tid >> 3, ch = tid & 7;
    *(LAS u32x4*)(buf + row * KSTR + ch * 16) = s.kn;
    if (tid < 256) { const int r2 = tid >> 2, c2 = tid & 3; *(LAS u32x4*)(buf + r2 * KSTR + 128 + c2 * 16) = s.kr; }
    const int lr = tid >> 4, lc = tid & 15;
    *(LAS u32x4*)(buf + KB_BYTES + lr * LSTR + lc * 16) = s.c0;
    *(LAS u32x4*)(buf + KB_BYTES + (32 + lr) * LSTR + lc * 16) = s.c1;
}
template <bool FIRST>
__device__ __forceinline__ void attn_tile_lat(const LAS char* buf, const bf16x8 (&qf)[6], float& mrun, float& lrun, f32x16 (&ol)[4], int lane) {
    const int r32 = lane & 31, hi = lane >> 5;
    const LAS char* kp = buf + r32 * KSTR + hi * 16;
    f32x16 p0 = {}, p1 = {};
#pragma unroll
    for (int s = 0; s < 6; ++s) {
        const bf16x8 a0 = *(const LAS bf16x8*)(kp + s * 32), a1 = *(const LAS bf16x8*)(kp + 32 * KSTR + s * 32);
        p0 = __builtin_amdgcn_mfma_f32_32x32x16_bf16(a0, qf[s], p0, 0, 0, 0);
        p1 = __builtin_amdgcn_mfma_f32_32x32x16_bf16(a1, qf[s], p1, 0, 0, 0);
    }
    float mx = fmaxf(p0[0], p1[0]);
#pragma unroll
    for (int r = 1; r < 16; ++r) mx = fmaxf(mx, fmaxf(p0[r], p1[r]));
    mx = max32(mx);
    const float mnew = FIRST ? mx : fmaxf(mrun, mx);
    if (!FIRST && __any(mnew > mrun)) { const float alpha = __builtin_amdgcn_exp2f(mrun - mnew); lrun *= alpha;
#pragma unroll
        for (int cb = 0; cb < 4; ++cb) ol[cb] *= alpha; }
    mrun = mnew;
    float sum = 0.f;
#pragma unroll
    for (int r = 0; r < 16; ++r) { p0[r] = __builtin_amdgcn_exp2f(p0[r] - mnew); p1[r] = __builtin_amdgcn_exp2f(p1[r] - mnew); sum += p0[r] + p1[r]; }
    lrun += sum;
    u32x4 pw[4];
#pragma unroll
    for (int j = 0; j < 4; ++j) { pw[0][j] = pk2(p0[2 * j], p0[2 * j + 1]); pw[1][j] = pk2(p0[8 + 2 * j], p0[8 + 2 * j + 1]); pw[2][j] = pk2(p1[2 * j], p1[2 * j + 1]); pw[3][j] = pk2(p1[8 + 2 * j], p1[8 + 2 * j + 1]); }
    const LAS char* vp = buf + KB_BYTES + (4 * hi + ((lane & 15) >> 2)) * LSTR + (16 * ((lane >> 4) & 1) + 4 * (lane & 3)) * 2;
#pragma unroll
    for (int ks = 0; ks < 4; ++ks) {
        const bf16x8 pf = __builtin_bit_cast(bf16x8, pw[ks]);
#pragma unroll
        for (int cb = 0; cb < 4; ++cb) {
            const bf16x8 v = cat8(vtr(vp + ks * 16 * LSTR + cb * 64), vtr(vp + (ks * 16 + 8) * LSTR + cb * 64));
            ol[cb] = __builtin_amdgcn_mfma_f32_32x32x16_bf16(v, pf, ol[cb], 0, 0, 0);
        }
    }
}
__device__ __forceinline__ void project_v(const bf16* WkvT, int h, const f32x16 (&ol)[4], f32x16& o0, f32x16& o1, int lane) {
    const int d_lo = lane & 31, hi = lane >> 5;
    const bf16* w0 = WkvT + (size_t)(256 * (2 + (h >> 2)) + 32 * (h & 3) + d_lo) * 128 + 4 * hi;
    const bf16* w1 = w0 + (size_t)128 * 128;
    o0 = f32x16{}; o1 = f32x16{};
#pragma unroll
    for (int s = 0; s < 8; ++s) {
        const int cb = s >> 1, rb = 8 * (s & 1), c0 = 32 * cb + 16 * (s & 1);
        u32x4 bw; bw.x = pk2(ol[cb][rb], ol[cb][rb + 1]); bw.y = pk2(ol[cb][rb + 2], ol[cb][rb + 3]); bw.z = pk2(ol[cb][rb + 4], ol[cb][rb + 5]); bw.w = pk2(ol[cb][rb + 6], ol[cb][rb + 7]);
        const bf16x8 bfr = __builtin_bit_cast(bf16x8, bw);
        const u32x2 a00 = *(const u32x2*)(w0 + c0), a01 = *(const u32x2*)(w0 + c0 + 8), a10 = *(const u32x2*)(w1 + c0), a11 = *(const u32x2*)(w1 + c0 + 8);
        const bf16x8 af0 = __builtin_bit_cast(bf16x8, (u32x4){a00.x, a00.y, a01.x, a01.y}), af1 = __builtin_bit_cast(bf16x8, (u32x4){a10.x, a10.y, a11.x, a11.y});
        o0 = __builtin_amdgcn_mfma_f32_32x32x16_bf16(af0, bfr, o0, 0, 0, 0);
        o1 = __builtin_amdgcn_mfma_f32_32x32x16_bf16(af1, bfr, o1, 0, 0, 0);
    }
}

__device__ __forceinline__ void sample_unit(const Ptrs& P, const bf16* CL  , const bf16* WkvT, int b, int h, int qk, float* part, unsigned* cnt, LAS char* lds, int tid_in, int lane_in, int wid) {
    int tid = tid_in, lane = lane_in; asm volatile("" : "+v"(tid), "+v"(lane));
    const int r32 = lane & 31, hi = lane >> 5, qblk = wid & 1, ks = wid >> 1;
    const size_t qrow = (size_t)MP + b * 64 + qblk * 32 + r32;
    bf16x8 qf[6]; load_q(qf, P, qrow, h, hi);
    float mrun = 0.f, lrun = 0.f; f32x16 ol[4] = {f32x16{}, f32x16{}, f32x16{}, f32x16{}};
    const size_t cbase = (size_t)MT + (size_t)b * 4096, nbase = (size_t)MP + b * 64;
    const int t0 = 16 * qk, ntile = (qk == 3) ? 17 : 16, nit = (ntile + 3) >> 2;
    SStage st[4];
#pragma unroll
    for (int j = 0; j < 4; ++j) { sstage_load(st[j], P, CL, cbase + (size_t)(t0 + j) * 64, h, tid); }
#pragma unroll
    for (int j = 0; j < 4; ++j) { sstage_store(st[j], lds + j * STILE_BYTES, tid); }
    __syncthreads();
    for (int it = 0; it < nit; ++it) {
        const int tn = 4 * (it + 1);
#pragma unroll
        for (int j = 0; j < 4; ++j) if (tn + j < ntile) sstage_load(st[j], P, CL, (t0 + tn + j < 64) ? cbase + (size_t)(t0 + tn + j) * 64 : nbase, h, tid);
        if (it == 0) attn_tile_lat<true>(lds + ks * STILE_BYTES, qf, mrun, lrun, ol, lane);
        else if (4 * it + ks < ntile) attn_tile_lat<false>(lds + ks * STILE_BYTES, qf, mrun, lrun, ol, lane);
        __syncthreads();
#pragma unroll
        for (int j = 0; j < 4; ++j) if (tn + j < ntile) sstage_store(st[j], lds + j * STILE_BYTES, tid);
        __syncthreads();
    }
    f32x16 o0, o1; project_v(WkvT, h, ol, o0, o1, lane);
    LAS float* xs = (LAS float*)lds;
    if (ks > 0) { LAS float* s = xs + ((ks - 1) * 2 + qblk) * (34 * 64) + lane; s[0] = mrun; s[64] = lrun;
#pragma unroll
        for (int r = 0; r < 16; ++r) { s[(2 + r) * 64] = o0[r]; s[(18 + r) * 64] = o1[r]; } }
    __syncthreads();
    float* mypart = part + ((size_t)((b * 8 + h) * 4 + qk) * 2 + qblk) * (34 * 64) + lane;
    if (ks == 0) {
        float mt = mrun, mo[3];
#pragma unroll
        for (int s = 0; s < 3; ++s) { mo[s] = xs[(s * 2 + qblk) * (34 * 64) + lane]; mt = fmaxf(mt, mo[s]); }
        const float a0 = __builtin_amdgcn_exp2f(mrun - mt); lrun *= a0; o0 *= a0; o1 *= a0; mrun = mt;
#pragma unroll
        for (int s = 0; s < 3; ++s) { const LAS float* sp = xs + (s * 2 + qblk) * (34 * 64) + lane; const float as = __builtin_amdgcn_exp2f(mo[s] - mt);
            lrun += sp[64] * as;
#pragma unroll
            for (int r = 0; r < 16; ++r) { o0[r] += sp[(2 + r) * 64] * as; o1[r] += sp[(18 + r) * 64] * as; } }
        mypart[0] = mrun; mypart[64] = lrun;
#pragma unroll
        for (int r = 0; r < 16; ++r) { mypart[(2 + r) * 64] = o0[r]; mypart[(18 + r) * 64] = o1[r]; }
    }
    asm volatile("s_waitcnt vmcnt(0)" ::: "memory");
    __syncthreads();
    LAS unsigned* flag = (LAS unsigned*)(lds + 6 * 34 * 64 * 4);
    if (tid == 0) {
        __builtin_amdgcn_fence(__ATOMIC_RELEASE, "agent");
        asm volatile("s_waitcnt vmcnt(0)" ::: "memory");
        const unsigned old = __hip_atomic_fetch_add(cnt + (b * 8 + h), 1u, __ATOMIC_RELAXED, __HIP_MEMORY_SCOPE_AGENT);
        if (old == 3u) { __builtin_amdgcn_fence(__ATOMIC_ACQUIRE, "agent"); asm volatile("s_waitcnt vmcnt(0)" ::: "memory"); }
        flag[0] = (old == 3u) ? 1u : 0u;
    }
    __syncthreads();
    if (flag[0] != 0u && ks == 0) {
        float mt = mrun, mo[3]; const float* op[3];
#pragma unroll
        for (int s = 0; s < 3; ++s) { const int q2 = (qk + 1 + s) & 3; op[s] = part + ((size_t)((b * 8 + h) * 4 + q2) * 2 + qblk) * (34 * 64) + lane; mo[s] = op[s][0]; mt = fmaxf(mt, mo[s]); }
        const float a0 = __builtin_amdgcn_exp2f(mrun - mt); lrun *= a0; o0 *= a0; o1 *= a0;
#pragma unroll
        for (int s = 0; s < 3; ++s) { const float as = __builtin_amdgcn_exp2f(mo[s] - mt);
            lrun += op[s][64] * as;
#pragma unroll
            for (int r = 0; r < 16; ++r) { o0[r] += op[s][(2 + r) * 64] * as; o1[r] += op[s][(18 + r) * 64] * as; } }
        finalize(P, qrow, h, lrun, o0, o1, lane);
    }
    __syncthreads();
}

struct GmPtrs { const bf16* VN; bf16* MRG; const bf16* WsB; const float* bs; const float* gog; };
constexpr int WSTR = 272, WS_LDS = 128 * WSTR;
__device__ __forceinline__ void gmlp_wg(const GmPtrs& G, int vcu, LAS char* lds, int tid_in, int lane_in, int wave) {
    int tid = tid_in, lane = lane_in; asm volatile("" : "+v"(tid), "+v"(lane));
    const int g = vcu & 7, cs = vcu >> 3;
    { const bf16* Wg = G.WsB + (size_t)g * 128 * 128;
#pragma unroll
      for (int k = 0; k < 4; ++k) { const int idx = k * 512 + tid, r = idx >> 4, ch = idx & 15;
          const u32x4 v = *(const u32x4*)(Wg + r * 128 + ch * 8); *(LAS u32x4*)(lds + r * WSTR + ch * 16) = v; } }
    __syncthreads();
    if (wave < 4 || (wave == 4 && cs < 8)) {
        int L; size_t row0;
        if (wave < 4) { const int cidx = 4 * cs + wave; row0 = (size_t)(cidx >> 4) * 2048 + (cidx & 15) * 128; L = 128; }
        else { row0 = (size_t)MP + cs * 64; L = 64; }
        LAS char* wl = lds + WS_LDS + wave * 12288;
        const int r32 = lane & 31, hi = lane >> 5, nib = L >> 5;
        f32x16 acc[4][2];
#pragma unroll
        for (int ib = 0; ib < 4; ++ib) { acc[ib][0] = f32x16{}; acc[ib][1] = f32x16{}; }
        const LAS char* vp = wl + (8 * hi + ((lane & 15) >> 2)) * VSTR + (16 * ((lane >> 4) & 1) + 4 * (lane & 3)) * 2;
        const LAS char* wp = lds + r32 * WSTR + hi * 16;
#pragma unroll
        for (int hj = 0; hj < 2; ++hj) {
            if (hj * 64 < L) {
#pragma unroll
                for (int k = 0; k < 8; ++k) { const int idx = k * 64 + lane, r = idx >> 3, ch = idx & 7;
                    const u32x4 v = *(const u32x4*)(G.VN + (row0 + 64 * hj + r) * 512 + g * 64 + ch * 8);
                    *(LAS u32x4*)(wl + r * VSTR + ch * 16) = v; }
#pragma unroll
                for (int ib = 0; ib < 4; ++ib) {
                    if (ib < nib && (hj == 0 || ib >= 2)) {
#pragma unroll
                        for (int ks = 0; ks < 4; ++ks) {
                            const bf16x8 bfr = *(const LAS bf16x8*)(wp + 32 * ib * WSTR + (64 * hj + 16 * ks) * 2);
                            const bf16x8 a0 = cat8(vtr(vp + ks * 16 * VSTR), vtr(vp + (ks * 16 + 4) * VSTR));
                            const bf16x8 a1 = cat8(vtr(vp + ks * 16 * VSTR + 64), vtr(vp + (ks * 16 + 4) * VSTR + 64));
                            acc[ib][0] = __builtin_amdgcn_mfma_f32_32x32x16_bf16(a0, bfr, acc[ib][0], 0, 0, 0);
                            acc[ib][1] = __builtin_amdgcn_mfma_f32_32x32x16_bf16(a1, bfr, acc[ib][1], 0, 0, 0);
                        }
                    }
                }
            }
        }
#pragma unroll
        for (int ib = 0; ib < 4; ++ib) {
            if (ib < nib) {
                const int i = 32 * ib + r32; const size_t row = row0 + i; const float bsv = G.bs[g * 128 + i];
                bf16* up = G.MRG + row * 1024 + 512 + g * 64; const float* gg = G.gog + g * 64;
                u32x2 ur[4][2];
#pragma unroll
                for (int rg = 0; rg < 4; ++rg) { const int d0 = 8 * rg + 4 * hi; ur[rg][0] = *(const u32x2*)(up + d0); ur[rg][1] = *(const u32x2*)(up + 32 + d0); }
                float ss = 0.f;
#pragma unroll
                for (int rg = 0; rg < 4; ++rg) {
                    const u32x2 u0 = ur[rg][0], u1 = ur[rg][1];
                    const float ua[4] = {bflo(u0.x), bfhi(u0.x), bflo(u0.y), bfhi(u0.y)}, ub[4] = {bflo(u1.x), bfhi(u1.x), bflo(u1.y), bfhi(u1.y)};
#pragma unroll
                    for (int e = 0; e < 4; ++e) { const float x0 = ua[e] * (acc[ib][0][4 * rg + e] + bsv), x1 = ub[e] * (acc[ib][1][4 * rg + e] + bsv);
                        acc[ib][0][4 * rg + e] = x0; acc[ib][1][4 * rg + e] = x1; ss += x0 * x0 + x1 * x1; } }
                ss = sum32(ss);
                const float rn = rsq(ss * (1.0f / 64.0f) + EPS);
#pragma unroll
                for (int rg = 0; rg < 4; ++rg) { const int d0 = 8 * rg + 4 * hi;
                    const f32x4 g0 = *(const f32x4*)(gg + d0), g1 = *(const f32x4*)(gg + 32 + d0);
                    u32x2 w0, w1;
                    w0.x = pk2(acc[ib][0][4 * rg] * rn * g0[0], acc[ib][0][4 * rg + 1] * rn * g0[1]); w0.y = pk2(acc[ib][0][4 * rg + 2] * rn * g0[2], acc[ib][0][4 * rg + 3] * rn * g0[3]);
                    w1.x = pk2(acc[ib][1][4 * rg] * rn * g1[0], acc[ib][1][4 * rg + 1] * rn * g1[1]); w1.y = pk2(acc[ib][1][4 * rg + 2] * rn * g1[2], acc[ib][1][4 * rg + 3] * rn * g1[3]);
                    *(u32x2*)(up + d0) = w0; *(u32x2*)(up + 32 + d0) = w1; }
            }
        }
    }
    __syncthreads();
}
}
typedef GAS unsigned gu32;
#define RLX_AGENT __ATOMIC_RELAXED, __HIP_MEMORY_SCOPE_AGENT
#define LDS_WAIT() asm volatile("s_waitcnt lgkmcnt(0)" ::: "memory")
#define VM_WAIT() asm volatile("s_waitcnt vmcnt(0)" ::: "memory")
#define XB_TMO      128
#define XB_XCNT(j)  (256  + 64 * (j))
#define XB_XSUB(j)  (1280 + 64 * (j))
#define XB_XGEN(j)  (2304 + 64 * (j))
#define XB_TOP      3328
#define XB_TOPGEN   3392
#define XCD_BAR_WORDS 3456
#define XB_SPIN_CAP (1u << 22)

__device__ __forceinline__ unsigned xb_ld(unsigned* p)              { return __hip_atomic_load(p, __ATOMIC_RELAXED, __HIP_MEMORY_SCOPE_AGENT); }
__device__ __forceinline__ unsigned xb_add(unsigned* p, unsigned v) { return __hip_atomic_fetch_add(p, v, __ATOMIC_RELAXED, __HIP_MEMORY_SCOPE_AGENT); }
__device__ __forceinline__ unsigned xb_xcc_id() { return (unsigned)__builtin_amdgcn_s_getreg((3 << 11) | 20) & 0xFu; }
#define XB_SPIN(cond, bar) do { unsigned _sp = 0; while (cond) { __builtin_amdgcn_s_sleep(1); \
    if ((++_sp & 255u) == 0u) { if (xb_ld(&(bar)[XB_TMO])) break; if (_sp > XB_SPIN_CAP) { atomicAdd(&(bar)[XB_TMO], 1u); break; } } } } while (0)

struct XcdBarrier {
    unsigned* bar; unsigned x;
    volatile LAS unsigned* st;
};

__device__ __forceinline__ bool xb_first_thread(int wave) { unsigned z = 0u; asm volatile("" : "+v"(z)); return wave == 0 && __builtin_amdgcn_mbcnt_hi(~0u, __builtin_amdgcn_mbcnt_lo(~0u, z)) == 0u; }
__device__ __forceinline__ XcdBarrier xcd_barrier_post(unsigned* bar, volatile LAS unsigned* st, int wave) {
    XcdBarrier b; b.bar = bar; b.x = xb_xcc_id(); b.st = st;
    if (xb_first_thread(wave)) (void)xb_add(&bar[XB_XCNT(b.x)], 1u);
    return b;
}
__device__ __forceinline__ void xcd_barrier_complete(unsigned* bar, unsigned x, unsigned& nloc, unsigned& nx) {
    const unsigned G = gridDim.x * gridDim.y * gridDim.z;
    unsigned sum, cnt, mine, sp = 0u;
    for (;;) {
        sum = 0u; cnt = 0u; mine = 0u;
#pragma unroll
        for (unsigned j = 0; j < 16; ++j) { const unsigned c = xb_ld(&bar[XB_XCNT(j)]); sum += c; cnt += (c > 0u) ? 1u : 0u; mine = (j == x) ? c : mine; }
        if (sum == G) break;
        __builtin_amdgcn_s_sleep(1);
        if ((++sp & 255u) == 0u) { if (xb_ld(&bar[XB_TMO])) break; if (sp > XB_SPIN_CAP) { atomicAdd(&bar[XB_TMO], 1u); break; } }
    }
    nloc = mine > 0u ? mine : 1u; nx = cnt > 0u ? cnt : 1u;
}

__device__ __forceinline__ void xcd_barrier(const XcdBarrier& b, int wave) {
    asm volatile("s_waitcnt vmcnt(0)" ::: "memory");
    __syncthreads();
    if (xb_first_thread(wave)) {
        unsigned* bar = b.bar; const unsigned x = xb_xcc_id();
        __builtin_amdgcn_s_waitcnt(0);
        unsigned nloc = b.st[0], nx = b.st[1];
        if (nloc == 0u) { xcd_barrier_complete(bar, x, nloc, nx); b.st[0] = nloc; b.st[1] = nx; }
        const unsigned old = xb_add(&bar[XB_XSUB(x)], 1u);
        const unsigned gen = old / nloc;
        if (old + 1u == (gen + 1u) * nloc) {
            __builtin_amdgcn_fence(__ATOMIC_RELEASE, "agent");
            asm volatile("s_waitcnt vmcnt(0)" ::: "memory");
            const unsigned og = xb_add(&bar[XB_TOP], 1u);
            const unsigned tg = og / nx;
            if (og + 1u == (tg + 1u) * nx) xb_add(&bar[XB_TOPGEN], 1u);
            else XB_SPIN(xb_ld(&bar[XB_TOPGEN]) == tg, bar);
            __builtin_amdgcn_fence(__ATOMIC_ACQUIRE, "agent");
            xb_add(&bar[XB_XGEN(x)], 1u);
            asm volatile("s_waitcnt vmcnt(0)" ::: "memory");
        } else {
            XB_SPIN(xb_ld(&bar[XB_XGEN(x)]) == gen, bar);
            __builtin_amdgcn_fence(__ATOMIC_ACQUIRE, "agent");
            asm volatile("s_waitcnt vmcnt(0)" ::: "memory");
        }
    }
    __syncthreads();
}

__device__ __forceinline__ int cmap_in(int n)  {
    if (n < 416) return n; if (n < 512) return -1; if (n < 1024) return n - 96;
    const int t = (n - 1024) >> 8, p = n & 255, bj = p >> 7, wc = (p >> 5) & 3, q = p & 31; return 928 + 64 * (4 * t + wc) + 32 * bj + q; }
__device__ __forceinline__ int cmap_qup(int n) { const int t = n >> 8, p = n & 255, bj = p >> 7, wc = (p >> 5) & 3, q = p & 31;
    if (t < 2) return (4 * t + wc) * 96 + 32 * bj + q;
    return (2 * wc + bj) * 96 + 64 + 16 * ((q >> 2) & 1) + 4 * (q >> 3) + (q & 3); }
__device__ __forceinline__ int cmap_kv(int n)  { const int t = n >> 8, p = n & 255, bj = p >> 7, wc = (p >> 5) & 3, q = p & 31;
    return (t < 2) ? (4 * t + wc) * 128 + 32 * bj + q : (4 * (t - 2) + wc) * 128 + 64 + 32 * bj + q; }

template <int WHICH  , bool GAIN>
__device__ __forceinline__ void transpose_item(const float* W, const float* W2, int K, int Nsrc, const float* gain, bf16* WT, LAS float* scr, int item, int nblk, int lane) {
    (void)scr;
    const int kb = item / nblk, nb = item % nblk, k0 = 64 * kb + 8 * (lane >> 3), n0 = 32 * nb, n = n0 + 4 * (lane & 7);
    int colq; const float* srcq = W;
    if (WHICH == 0) colq = cmap_in(n); else if (WHICH == 1) colq = cmap_qup(n); else if (WHICH == 2) colq = cmap_kv(n); else if (WHICH == 3) colq = n;
    else { const int t = n >> 8, p = n & 255; if (p < 128) colq = 128 * t + p; else { colq = 128 * t + p - 128; srcq = W2; } }
    f32x4 v[8];
#pragma unroll
    for (int j = 0; j < 8; ++j) v[j] = (f32x4){0.f, 0.f, 0.f, 0.f};
    if (colq >= 0) {
#pragma unroll
        for (int j = 0; j < 8; ++j) v[j] = *(const f32x4*)(srcq + (size_t)(k0 + j) * Nsrc + colq);
        if (GAIN) { const f32x4 g0 = *(const f32x4*)(gain + k0), g1 = *(const f32x4*)(gain + k0 + 4);
#pragma unroll
            for (int j = 0; j < 4; ++j) { v[j] = v[j] * g0[j]; v[4 + j] = v[4 + j] * g1[j]; } }
    }
#pragma unroll
    for (int e = 0; e < 4; ++e) { u32x4 o; o.x = pk2(v[0][e], v[1][e]); o.y = pk2(v[2][e], v[3][e]); o.z = pk2(v[4][e], v[5][e]); o.w = pk2(v[6][e], v[7][e]);
        *(u32x4*)(WT + (size_t)(n + e) * K + k0) = o; }
}

template <int KTOT>
__device__ __forceinline__ void sample_res_gemm(const bf16* A, int lda, const bf16* Bt, float* out, bf16* XB, float* ssq, int final_f32, int task, LAS char* lds, int lane, int wave) {
    const int r32 = lane & 31, hi = lane >> 5, t0 = 64 * (task >> 5), n0 = 32 * (task & 31);
    constexpr int KW = KTOT / 8, NS = KW / 16;
    const bf16* ap = Bt + (size_t)(n0 + r32) * KTOT + wave * KW + 8 * hi;
    const bf16* b0p = A + (size_t)(MP + t0 + r32) * lda + wave * KW + 8 * hi;
    const bf16* b1p = b0p + (size_t)32 * lda;
    f32x16 acc0 = {}, acc1 = {};
#pragma unroll 11
    for (int s = 0; s < NS; ++s) {
        const bf16x8 a = *(const bf16x8*)(ap + 16 * s), b0 = *(const bf16x8*)(b0p + 16 * s), b1 = *(const bf16x8*)(b1p + 16 * s);
        acc0 = __builtin_amdgcn_mfma_f32_32x32x16_bf16(a, b0, acc0, 0, 0, 0);
        acc1 = __builtin_amdgcn_mfma_f32_32x32x16_bf16(a, b1, acc1, 0, 0, 0);
    }
    LAS float* ps = (LAS float*)lds + wave * 2048 + lane;
#pragma unroll
    for (int r = 0; r < 16; ++r) { ps[r * 64] = acc0[r]; ps[(16 + r) * 64] = acc1[r]; }
    __syncthreads();
    { const int tb = wave >> 2, ng = wave & 3; f32x4 sum = {0.f, 0.f, 0.f, 0.f};
      const LAS float* rp = (const LAS float*)lds + (tb * 16 + 4 * ng) * 64 + lane;
#pragma unroll
      for (int p = 0; p < 8; ++p)
#pragma unroll
          for (int e = 0; e < 4; ++e) sum[e] += rp[p * 2048 + e * 64];
      const size_t rs = (size_t)t0 + 32 * tb + r32;
      const int col = n0 + 8 * ng + 4 * hi;
      bf16* xp = XB + ((size_t)MP + rs) * 1024 + col; const u32x2 xw = *(const u32x2*)xp;
      const f32x4 o = (f32x4){bflo(xw.x), bfhi(xw.x), bflo(xw.y), bfhi(xw.y)} + sum;
      if (final_f32) *(f32x4*)(out + ((size_t)MP + rs) * 1024 + col) = o;
      else { u32x2 w; w.x = pk2(o[0], o[1]); w.y = pk2(o[2], o[3]); *(u32x2*)xp = w; atomicAdd(ssq + MP + rs, dot4v(o)); } }
    __syncthreads();
}

struct Args { const float* in[25]; float* out; unsigned char* ws; };
enum { I_XP = 0, I_XS, I_CCKV, I_CKR, I_GMIX, I_WIN, I_GQL, I_WQUP, I_GQN, I_GQR, I_GKVL, I_GKR, I_WKV, I_GKN, I_LNG, I_LNB, I_WS, I_BS, I_GOA, I_GOG, I_WO, I_GFFN, I_WG, I_WU, I_WD };

constexpr int I_IN = 16 * 48, I_QU = 4 * 24, I_KV = 2 * 32, I_KVG = 2 * 32, I_O = 16 * 32, I_GU = 16 * 176, I_D = 44 * 32, I_LAYER = I_IN + I_QU + I_KV + I_KVG + I_O + I_GU + I_D, I_EARLY = I_IN + I_QU + I_KV + I_KVG;
__device__ __forceinline__ void convert_items(const Args& A, unsigned char* ws, LAS float* scr, int first, int last, int widx, int nw, int lane) {
    for (int it = first + widx; it < last; it += nw) {
        const int l = it / I_LAYER; int r = it % I_LAYER; unsigned char* wb = ws + WS_W + (size_t)l * LW;
        if (r < I_IN) { transpose_item<0, true>(A.in[I_WIN] + (size_t)l * 1024 * 1440, nullptr, 1024, 1440, A.in[I_GMIX] + l * 1024, (bf16*)(wb + W_IN), scr, r, 48, lane); continue; } r -= I_IN;
        if (r < I_QU) { transpose_item<1, true>(A.in[I_WQUP] + (size_t)l * 256 * 768, nullptr, 256, 768, A.in[I_GQL] + l * 256, (bf16*)(wb + W_QUP), scr, r, 24, lane); continue; } r -= I_QU;
        if (r < I_KV) { transpose_item<2, false>(A.in[I_WKV] + (size_t)l * 128 * 1024, nullptr, 128, 1024, nullptr, (bf16*)(wb + W_KV), scr, r, 32, lane); continue; } r -= I_KV;
        if (r < I_KVG) { transpose_item<2, true>(A.in[I_WKV] + (size_t)l * 128 * 1024, nullptr, 128, 1024, A.in[I_GKVL] + l * 128, (bf16*)(ws + WS_WKVG + (size_t)l * 262144), scr, r, 32, lane); continue; } r -= I_KVG;
        if (r < I_O) { transpose_item<3, false>(A.in[I_WO] + (size_t)l * 1024 * 1024, nullptr, 1024, 1024, nullptr, (bf16*)(wb + W_O), scr, r, 32, lane); continue; } r -= I_O;
        if (r < I_GU) { transpose_item<4, true>(A.in[I_WG] + (size_t)l * 1024 * DFF, A.in[I_WU] + (size_t)l * 1024 * DFF, 1024, DFF, A.in[I_GFFN] + l * 1024, (bf16*)(wb + W_GU), scr, r, 176, lane); continue; } r -= I_GU;
        transpose_item<3, false>(A.in[I_WD] + (size_t)l * DFF * 1024, nullptr, DFF, 1024, nullptr, (bf16*)(wb + W_D), scr, r, 32, lane);
    }
}
__device__ __forceinline__ void convert_cache(const Args& A, unsigned char* ws, int l, int tix, int ntx) {
    for (int i0 = tix; i0 < MC * 16; i0 += 4 * ntx) { f32x4 a[4], b[4];
#pragma unroll
        for (int u = 0; u < 4; ++u) { const int i = i0 + u * ntx; if (i < MC * 16) { const float* s = A.in[I_CCKV] + ((size_t)l * MC + (i >> 4)) * 128 + (i & 15) * 8; a[u] = *(const f32x4*)s; b[u] = *(const f32x4*)(s + 4); } }
#pragma unroll
        for (int u = 0; u < 4; ++u) { const int i = i0 + u * ntx; if (i < MC * 16) { u32x4 o; o.x = pk2(a[u][0], a[u][1]); o.y = pk2(a[u][2], a[u][3]); o.z = pk2(b[u][0], b[u][1]); o.w = pk2(b[u][2], b[u][3]);
            *(u32x4*)(ws + WS_CKVA + (size_t)l * L_CKVA + ((size_t)(MT + (i >> 4)) * 128 + (i & 15) * 8) * 2) = o; } } }
    for (int i = tix; i < MC * 4; i += ntx) { const int r = i >> 2, c0 = (i & 3) * 8;
        const float* s = A.in[I_CKR] + ((size_t)l * MC + r) * 32 + c0; const f32x4 a = *(const f32x4*)s, b = *(const f32x4*)(s + 4);
        u32x4 o; o.x = pk2(a[0], a[1]); o.y = pk2(a[2], a[3]); o.z = pk2(b[0], b[1]); o.w = pk2(b[2], b[3]);
        *(u32x4*)(ws + WS_KR + (size_t)l * L_KR + ((size_t)(MT + r) * 32 + c0) * 2) = o; }
}
__device__ __forceinline__ void p0_prologue(const Args& A, unsigned char* ws, LAS unsigned char* lds, int vcu, int G, int wave, int lane, int tid) {
    LAS float* scr = (LAS float*)(lds + wave * 16384);
    const int gw = vcu * 8 + wave, NGW = G * 8;
#ifdef NO_DEFER
    convert_items(A, ws, scr, 0, 2 * I_LAYER, gw, NGW, lane);
#else
    convert_items(A, ws, scr, 0, I_EARLY, gw, NGW, lane);
#endif
    const int gt = vcu * 512 + tid, NGT = G * 512;
    for (int i = gt; i < 2 * 8 * 128 * 16; i += NGT) { const int l = i >> 14, rem = i & 16383, gi = rem >> 4, j0 = (rem & 15) * 8, ii = gi & 127;
        const float* s = A.in[I_WS] + (size_t)l * 131072 + (size_t)gi * 128 + j0; const bool vis = (ii >> 6) >= (j0 >> 6);
        const f32x4 a = *(const f32x4*)s, b = *(const f32x4*)(s + 4);
        u32x4 o; o.x = pk2(a[0], a[1]); o.y = pk2(a[2], a[3]); o.z = pk2(b[0], b[1]); o.w = pk2(b[2], b[3]); if (!vis) o = (u32x4){0u, 0u, 0u, 0u};
        *(u32x4*)(ws + WS_W + (size_t)l * LW + W_S + ((size_t)gi * 128 + j0) * 2) = o; }
#ifdef NO_DEFER
    convert_cache(A, ws, 0, gt, NGT); convert_cache(A, ws, 1, gt, NGT);
#endif
    for (int i = gt; i < 2112 * 16; i += NGT) { const int pi = i >> 4, j = i & 15; const int pos = pi < 2048 ? pi : 4096 + (pi - 2048);
        const float inv = __builtin_amdgcn_exp2f(-(float)j * (13.287712379549449f / 16.0f)); const float ang = (float)pos * inv;
        const double t = (double)ang * 0.15915494309189535; const float fr = (float)(t - __builtin_rint(t));
        f32x2 cs; cs.x = __builtin_amdgcn_cosf(fr); cs.y = __builtin_amdgcn_sinf(fr);
        *(f32x2*)(ws + WS_ROPE + (size_t)i * 8) = cs; }
    bf16* XB = (bf16*)(ws + B_XB); float* ssq0 = (float*)(ws + WS_CTL + CTL_SSQ);
    for (int mp = gw; mp < MT / 2; mp += NGW) {
        f32x4 v[2][4];
#pragma unroll
        for (int u = 0; u < 2; ++u) { const int m = 2 * mp + u; const float* xr = (m < MP) ? A.in[I_XP] + (size_t)m * 1024 : A.in[I_XS] + (size_t)(m - MP) * 1024;
#pragma unroll
            for (int j = 0; j < 4; ++j) v[u][j] = *(const f32x4*)(xr + 256 * j + 4 * lane); }
#pragma unroll
        for (int u = 0; u < 2; ++u) { const int m = 2 * mp + u; float s = 0.f;
#pragma unroll
            for (int j = 0; j < 4; ++j) { s += dot4v(v[u][j]); u32x2 w; w.x = pk2(v[u][j][0], v[u][j][1]); w.y = pk2(v[u][j][2], v[u][j][3]); *(u32x2*)(XB + (size_t)m * 1024 + 256 * j + 4 * lane) = w; }
            s = wave_sum(s); if (lane == 0) ssq0[m] = s; } }
}

struct P2Ptrs { const bf16* Z; bf16* MRG; bf16* CKVA; bf16* KR; bf16* VN; const float* rope; float* out;
                const float* gql; const float* gkvl; const float* gkr; const float* lng; const float* lnb; };
__device__ __forceinline__ void p2_row(const P2Ptrs& P, int l, int m, int lane) {
    const bf16* z = P.Z + (size_t)m * NZ;
    const unsigned cw = *(const unsigned*)(z + 256 + 2 * lane);
    float k1 = 0.f, k2 = 0.f; if (lane < 16) { k1 = __uint_as_float((unsigned)z[384 + lane] << 16); k2 = __uint_as_float((unsigned)z[400 + lane] << 16); }
    const bool smp = m >= MP; const int ms = m - MP; const int posidx = smp ? 2048 + (ms & 63) : (m & 2047);
    { const float c0 = bflo(cw), c1 = bfhi(cw); const float ss = wave_sum(c0 * c0 + c1 * c1); const float rn = rsq(ss * (1.0f / 128.0f) + EPS);
      const f32x2 g = *(const f32x2*)(P.gkvl + 2 * lane); f32x2 y; y.x = c0 * rn * g.x; y.y = c1 * rn * g.y;
      float* o = smp ? P.out + O_CKVS + ((size_t)l * MS + ms) * 128 : P.out + O_CKVP + ((size_t)l * MP + m) * 128;
      *(f32x2*)(o + 2 * lane) = y; if (smp) *(unsigned*)(P.CKVA + (size_t)m * 128 + 2 * lane) = pk2(y.x, y.y); }
    { const float ss = wave_sum(k1 * k1 + k2 * k2); const float rn = rsq(ss * (1.0f / 32.0f) + EPS);
      if (lane < 16) { const float a = k1 * rn * P.gkr[lane], b = k2 * rn * P.gkr[16 + lane]; const f32x2 cs = *(const f32x2*)(P.rope + (size_t)(posidx * 16 + lane) * 2);
          const float o1 = a * cs.x - b * cs.y, o2 = a * cs.y + b * cs.x;
          float* o = smp ? P.out + O_KRS + ((size_t)l * MS + ms) * 32 : P.out + O_KRP + ((size_t)l * MP + m) * 32;
          o[lane] = o1; o[16 + lane] = o2;
          bf16* kb = P.KR + (size_t)m * 32; kb[lane] = (bf16)(pk2(o1, 0.f) & 0xffffu); kb[16 + lane] = (bf16)(pk2(o2, 0.f) & 0xffffu); } }
}

#ifndef REP_P0
#define REP_P0 1
#endif
#ifndef REP_P1
#define REP_P1 1
#endif
#ifndef REP_P2
#define REP_P2 1
#endif
#ifndef REP_P3
#define REP_P3 1
#endif
#ifndef REP_P4A
#define REP_P4A 1
#endif
#ifndef REP_P4B
#define REP_P4B 1
#endif
#ifndef REP_P6
#define REP_P6 1
#endif
#ifndef REP_BAR
#define REP_BAR 1
#endif
template <class T> __device__ __forceinline__ T* as_global(T* p) {
#if defined(__HIP_DEVICE_COMPILE__)
    __builtin_assume(!__builtin_amdgcn_is_shared((const __attribute__((address_space(0))) void*)p));
    __builtin_assume(!__builtin_amdgcn_is_private((const __attribute__((address_space(0))) void*)p));
#endif
    return p;
}
#define FRESH_TID() unsigned z_p = 0u; asm volatile("" : "+v"(z_p)); const int lane_p = (int)__builtin_amdgcn_mbcnt_hi(~0u, __builtin_amdgcn_mbcnt_lo(~0u, z_p)); const int tid_p = wave * 64 + lane_p
#define FRESH_PTRS() size_t zo_p = 0; asm volatile("" : "+s"(zo_p)); \
    unsigned char* ws = args.ws + zo_p; float* out = args.out + zo_p;     \
    int G = gridDim.x, bx = blockIdx.x; asm volatile("" : "+s"(G), "+s"(bx)); const int vcu = (G % 8 == 0) ? (bx % 8) * (G / 8) + bx / 8 : bx; (void)vcu; (void)out
#define GRID_BAR() for (int repb_ = 0; repb_ < REP_BAR; ++repb_) do { size_t zo_b = 0; asm volatile("" : "+s"(zo_b)); unsigned char* wsb = args.ws + zo_b; XcdBarrier bar_; bar_.bar = (unsigned*)(wsb + WS_CTL) + CW_BAR; bar_.x = 0; bar_.st = (volatile LAS unsigned*)(lds + MISC_OFF) + 8; xcd_barrier(bar_, wave); } while (0)
__global__ void __launch_bounds__(512, 2) hybrid_fwd(Args args) {
    extern __shared__ __attribute__((aligned(16))) unsigned char lds_raw[];
    LAS unsigned char* lds = (LAS unsigned char*)lds_raw;
    const int wave = __builtin_amdgcn_readfirstlane(threadIdx.x >> 6);
    { FRESH_TID(); for (int u = tid_p; u < (LDS_BYTES - RING_BYTES) / 4; u += 512) ((LAS unsigned*)(lds + RING_BYTES))[u] = 0u; }
    __syncthreads();
    { FRESH_PTRS(); (void)xcd_barrier_post((unsigned*)(ws + WS_CTL) + CW_BAR, (volatile LAS unsigned*)(lds + MISC_OFF) + 8, wave); }

#ifndef NO_P0
    asm volatile("; MARK_P0");
    for (int rep_ = 0; rep_ < REP_P0; ++rep_) { FRESH_TID(); FRESH_PTRS(); p0_prologue(args, ws, lds, vcu, G, wave, lane_p, tid_p); }
#endif
    GRID_BAR();

    for (int l = 0; l < NLAYER; ++l) {
#ifndef NO_P1
        asm volatile("; MARK_P1");
        for (int rep_ = 0; rep_ < REP_P1; ++rep_) { FRESH_PTRS(); unsigned char* wb = ws + WS_W + (size_t)l * LW;
          pg8::Gemm g{(const bf16*)(ws + B_XB), (const bf16*)(wb + W_IN), MT, NZ, 1024, 1024}; pg8::StaticOrder S; S.init(MT, NZ, G, bx);
          pg8::EpiZ E{(bf16*)(ws + B_Z), (const float*)(ws + WS_CTL + CTL_SSQ) + (size_t)(2 * l) * MT, (bf16*)(ws + B_MRG), (bf16*)(ws + B_VN), out + O_GVS + (size_t)l * MS * 512, args.in[I_LNG] + l * 512, args.in[I_LNB] + l * 512,
                      (float*)(ws + WS_CTL + CTL_SSQQ) + (size_t)l * MT, (float*)(ws + WS_CTL + CTL_SSQC) + (size_t)l * MT};
          pg8::gemm_phase<pg8::EpiZ, pg8::StaticOrder, true, true>(lds, g, S, E, wave);
          if (l == 1 && bx >= 140) {
              pg8::Gemm g3{(const bf16*)(ws + WS_CKVA + (size_t)l * L_CKVA) + (size_t)MT * 128, (const bf16*)(wb + W_KV), MC, 512, 128, 128}; pg8::StaticOrder S3; S3.init(MC, 512, G - 140, bx - 140);
              pg8::EpiKV E3{(bf16*)(ws + B_KN) + (size_t)MT * 512, (bf16*)(ws + B_VV) + (size_t)MT * 512, args.in[I_GKN] + l * 64, nullptr};
              pg8::gemm_phase<pg8::EpiKV, pg8::StaticOrder, true, true>(lds, g3, S3, E3, wave); }
#ifndef NO_DEFER
          if (l == 0 && bx >= 140) { FRESH_TID(); convert_items(args, ws, (LAS float*)(lds + wave * 16384), I_EARLY, I_LAYER, (bx - 140) * 8 + wave, (G - 140) * 8, lane_p);
                                     convert_cache(args, ws, 0, (bx - 140) * 512 + tid_p, (G - 140) * 512); }
#endif
          }
#endif
        GRID_BAR();
#ifndef NO_P3
        asm volatile("; MARK_P3");
        { FRESH_TID(); FRESH_PTRS();
          P2Ptrs P{(const bf16*)(ws + B_Z), (bf16*)(ws + B_MRG), (bf16*)(ws + WS_CKVA + (size_t)l * L_CKVA), (bf16*)(ws + WS_KR + (size_t)l * L_KR), (bf16*)(ws + B_VN), (const float*)(ws + WS_ROPE), out,
                   args.in[I_GQL] + l * 256, args.in[I_GKVL] + l * 128, args.in[I_GKR] + l * 32, args.in[I_LNG] + l * 512, args.in[I_LNB] + l * 512};
          const int gw = vcu * 8 + wave, NGW = G * 8;
          for (int mp = gw; mp < MT / 2; mp += NGW) { p2_row(P, l, 2 * mp, lane_p); p2_row(P, l, 2 * mp + 1, lane_p); } }
        { FRESH_PTRS(); unsigned char* wb = ws + WS_W + (size_t)l * LW;
          pg8::Gemm g{(const bf16*)(ws + B_Z), (const bf16*)(wb + W_QUP), MT, 768, 256, NZ}; pg8::StaticOrder S; S.init(MT, 768, G, bx);
          pg8::EpiQ E{(bf16*)(ws + B_QNP), (bf16*)(ws + B_QRP), args.in[I_GQN] + l * 64, args.in[I_GQR] + l * 32, (const float*)(ws + WS_ROPE), (const float*)(ws + WS_CTL + CTL_SSQQ) + (size_t)l * MT};
          pg8::gemm_phase<pg8::EpiQ, pg8::StaticOrder, true, true>(lds, g, S, E, wave); }
        asm volatile("; MARK_P3B");
        { FRESH_PTRS();
          pg8::Gemm g{(const bf16*)(ws + B_Z) + 256, (const bf16*)(ws + WS_WKVG + (size_t)l * 262144), MT, 1024, 128, NZ}; pg8::StaticOrder S; S.init(MT, 1024, G, (bx + 58) % G);
          pg8::EpiKV E{(bf16*)(ws + B_KN), (bf16*)(ws + B_VV), args.in[I_GKN] + l * 64, (const float*)(ws + WS_CTL + CTL_SSQC) + (size_t)l * MT};
          pg8::gemm_phase<pg8::EpiKV, pg8::StaticOrder, true, true>(lds, g, S, E, wave); }
        if (l == 0) { FRESH_PTRS(); unsigned char* wb = ws + WS_W + (size_t)l * LW;
          pg8::Gemm g{(const bf16*)(ws + WS_CKVA + (size_t)l * L_CKVA) + (size_t)MT * 128, (const bf16*)(wb + W_KV), MC, 512, 128, 128}; pg8::StaticOrder S; S.init(MC, 512, G, bx);
          pg8::EpiKV E{(bf16*)(ws + B_KN) + (size_t)MT * 512, (bf16*)(ws + B_VV) + (size_t)MT * 512, args.in[I_GKN] + l * 64, nullptr};
          pg8::gemm_phase<pg8::EpiKV, pg8::StaticOrder, true, true>(lds, g, S, E, wave); }
#endif
        GRID_BAR();
#ifndef NO_P4
        asm volatile("; MARK_P4");
        { FRESH_TID(); FRESH_PTRS();
          att::Ptrs P{(const bf16*)(ws + B_QNP), (const bf16*)(ws + B_QRP), (const bf16*)(ws + B_KN), (const bf16*)(ws + B_VV), (const bf16*)(ws + WS_KR + (size_t)l * L_KR), (bf16*)(ws + B_MRG), args.in[I_GOA] + l * 512};
          const int bh = vcu >> 2, s = vcu & 3;
          const int par = bh & 1;
          if (par) att::sample_unit(P, (const bf16*)(ws + WS_CKVA + (size_t)l * L_CKVA), (const bf16*)(ws + WS_W + (size_t)l * LW + W_KV), vcu >> 5, (vcu >> 2) & 7, vcu & 3, (float*)(ws + WS_PART), (unsigned*)(ws + WS_CTL + CTL_SCNT) + l * 64, (LAS char*)lds, tid_p, lane_p, wave);
          att::prompt_unit(P, bh >> 3, bh & 7, 7 - s, (LAS char*)lds, tid_p, lane_p, wave);
          att::prompt_unit(P, bh >> 3, bh & 7, s, (LAS char*)lds, tid_p, lane_p, wave);
          if (!par) att::sample_unit(P, (const bf16*)(ws + WS_CKVA + (size_t)l * L_CKVA), (const bf16*)(ws + WS_W + (size_t)l * LW + W_KV), vcu >> 5, (vcu >> 2) & 7, vcu & 3, (float*)(ws + WS_PART), (unsigned*)(ws + WS_CTL + CTL_SCNT) + l * 64, (LAS char*)lds, tid_p, lane_p, wave);
#ifndef NO_P4C
          asm volatile("; MARK_P4C");
          { att::GmPtrs Gm{(const bf16*)(ws + B_VN), (bf16*)(ws + B_MRG), (const bf16*)(ws + WS_W + (size_t)l * LW + W_S), args.in[I_BS] + l * 1024, args.in[I_GOG] + l * 512};
                 att::gmlp_wg(Gm, vcu, (LAS char*)lds, tid_p, lane_p, wave); }
#endif
        }
#endif
        GRID_BAR();
#ifndef NO_P5
        asm volatile("; MARK_P5");
        { FRESH_PTRS(); unsigned char* wb = ws + WS_W + (size_t)l * LW;
          pg8::Gemm g{(const bf16*)(ws + B_MRG), (const bf16*)(wb + W_O), MP, 1024, 1024, 1024}; pg8::StaticOrder S; S.init(MP, 1024, G, bx);
          pg8::EpiRes E{out, (bf16*)(ws + B_XB), (float*)(ws + WS_CTL + CTL_SSQ) + (size_t)(2 * l + 1) * MT, 0};
          pg8::gemm_phase<pg8::EpiRes, pg8::StaticOrder, true, true>(lds, g, S, E, wave);
          { FRESH_TID(); if (vcu < 256) sample_res_gemm<1024>((const bf16*)(ws + B_MRG), 1024, (const bf16*)(wb + W_O), out, E.XB, E.ssq, 0, vcu, (LAS char*)lds, lane_p, wave); } }
#endif
        GRID_BAR();
#ifndef NO_P6
        asm volatile("; MARK_P6");
        for (int rep_ = 0; rep_ < REP_P6; ++rep_) { FRESH_PTRS(); unsigned char* wb = ws + WS_W + (size_t)l * LW;
          pg8::Gemm g{(const bf16*)(ws + B_XB), (const bf16*)(wb + W_GU), MT, NGU, 1024, 1024}; pg8::StaticOrder S; S.init(MT, NGU, G, bx);
          pg8::EpiGU E{(bf16*)(ws + B_H), (const float*)(ws + WS_CTL + CTL_SSQ) + (size_t)(2 * l + 1) * MT};
#ifdef PROBE_SPLIT6
          S.i1 = 3; pg8::gemm_phase<pg8::EpiGU, pg8::StaticOrder, true, true>(lds, g, S, E, wave); GRID_BAR(); S.i0 = 3; S.i1 = 1 << 20;
#endif
          pg8::gemm_phase<pg8::EpiGU, pg8::StaticOrder, true, true>(lds, g, S, E, wave);
#ifndef NO_DEFER
          if (l == 0 && bx >= 172) { FRESH_TID(); convert_items(args, ws, (LAS float*)(lds + wave * 16384), I_LAYER, 2 * I_LAYER, (bx - 172) * 8 + wave, (G - 172) * 8, lane_p);
                                     convert_cache(args, ws, 1, (bx - 172) * 512 + tid_p, (G - 172) * 512); }
#endif
          }
#endif
        GRID_BAR();
#ifndef NO_P7
        asm volatile("; MARK_P7");
        { FRESH_PTRS(); unsigned char* wb = ws + WS_W + (size_t)l * LW;
          pg8::Gemm g{(const bf16*)(ws + B_H), (const bf16*)(wb + W_D), MP, 1024, DFF, DFF}; pg8::StaticOrder S; S.init(MP, 1024, G, bx);
          pg8::EpiRes E{out, (bf16*)(ws + B_XB), (float*)(ws + WS_CTL + CTL_SSQ) + (size_t)(2 * l + 2) * MT, l == NLAYER - 1 ? 1 : 0};
          pg8::gemm_phase<pg8::EpiRes, pg8::StaticOrder, true, true>(lds, g, S, E, wave);
          { FRESH_TID(); if (vcu < 256) sample_res_gemm<DFF>((const bf16*)(ws + B_H), DFF, (const bf16*)(wb + W_D), out, E.XB, E.ssq, E.final_f32, vcu, (LAS char*)lds, lane_p, wave); } }
#endif
        if (l + 1 < NLAYER) GRID_BAR();
    }
}

extern "C" void kernel_launch(void* const* d_in, const int* in_sizes, int n_in, void* d_out, int out_size, void* d_ws, size_t ws_size, hipStream_t stream) {
    static int grid = 0;
    if (grid == 0) {
        #ifdef PROBE_WSMIN
        if (ws_size < (size_t)PROBE_WSMIN * MiB) { grid = -1; return; }
#endif
        if (n_in != 25 || (size_t)out_size != O_END || ws_size < WS_END) { fprintf(stderr, "kernel_launch: unexpected shapes (n_in %d, out %d, ws %zu); nothing launched\n", n_in, out_size, ws_size); grid = -1; return; }
        int dev = 0, cus = 0, per_cu = 0;
        if (hipGetDevice(&dev) != hipSuccess || hipDeviceGetAttribute(&cus, hipDeviceAttributeMultiprocessorCount, dev) != hipSuccess) { grid = -1; return; }
        if (hipFuncSetAttribute((const void*)hybrid_fwd, hipFuncAttributeMaxDynamicSharedMemorySize, LDS_BYTES) != hipSuccess) { fprintf(stderr, "kernel_launch: hipFuncSetAttribute failed\n"); grid = -1; return; }
        if (hipOccupancyMaxActiveBlocksPerMultiprocessor(&per_cu, (const void*)hybrid_fwd, 512, LDS_BYTES) != hipSuccess || per_cu < 1) { fprintf(stderr, "kernel_launch: occupancy query reports %d blocks per CU\n", per_cu); (void)hipGetLastError(); grid = -1; return; }
        if (cus < 256) { fprintf(stderr, "kernel_launch: built for a 256-CU device (found %d CUs); nothing launched\n", cus); grid = -1; return; }
        grid = 256;
    }
    if (grid < 0) return;
    if (hipMemsetAsync((char*)d_ws + WS_CTL, 0, CTL_ZERO_BYTES, stream) != hipSuccess) return;
    Args a{};
    for (int i = 0; i < 25; ++i) a.in[i] = (const float*)d_in[i];
    a.out = (float*)d_out; a.ws = (unsigned char*)d_ws;
    hipLaunchKernelGGL(hybrid_fwd, dim3(grid), dim3(512), LDS_BYTES, stream, a);
}
```

```cpp
#include <hip/hip_runtime.h>
#include <cstdio>
#include <cstdint>

#define LAS __attribute__((address_space(3)))
#define GAS __attribute__((address_space(1)))
typedef unsigned short bf16;
typedef short bf16x8 __attribute__((ext_vector_type(8)));
typedef short s16x4 __attribute__((ext_vector_type(4)));
typedef float f32x4 __attribute__((ext_vector_type(4)));
typedef float f32x2 __attribute__((ext_vector_type(2)));
typedef float f32x16 __attribute__((ext_vector_type(16)));
typedef unsigned u32x4 __attribute__((ext_vector_type(4)));
typedef unsigned u32x2 __attribute__((ext_vector_type(2)));
typedef __bf16 bf16x2_t __attribute__((ext_vector_type(2)));

constexpr int DM = 1024, MP = 16384, MS = 512, MT = MP + MS  , MC = 32768  , MA = MT + MC;
constexpr int NZ = 1536, DFF = 2816, NGU = 5632;
constexpr int NLAYER = 2;
constexpr float EPS = 1e-6f;
constexpr float QSCALE = 0.10206207261596577f * 1.4426950408889634f;

constexpr size_t O_Y = 0, O_CKVP = (size_t)MT * 1024, O_KRP = O_CKVP + (size_t)2 * MP * 128, O_CKVS = O_KRP + (size_t)2 * MP * 32,
                 O_KRS = O_CKVS + (size_t)2 * MS * 128, O_GVS = O_KRS + (size_t)2 * MS * 32, O_END = O_GVS + (size_t)2 * MS * 512;

constexpr size_t MiB = 1u << 20;
constexpr size_t WS_CTL = 0, CTL_ZERO_BYTES = 1 * MiB;
constexpr int CW_BAR = 4096;
constexpr size_t CTL_SSQ = 65536;
constexpr size_t WS_W = 1 * MiB, LW = 23461888;
constexpr size_t W_IN = 0, W_QUP = 3145728, W_KV = W_QUP + 393216, W_O = W_KV + 262144, W_GU = W_O + 2097152, W_D = W_GU + 11534336, W_S = W_D + 5767168;
static_assert(W_S + 262144 == LW, "weight block");
constexpr size_t WS_CKVA = WS_W + 2 * LW, L_CKVA = (size_t)MA * 128 * 2;
constexpr size_t WS_KR = WS_CKVA + 2 * L_CKVA, L_KR = (size_t)MA * 32 * 2;
constexpr size_t WS_ROPE = WS_KR + 2 * L_KR;
constexpr size_t WS_PART = 153 * MiB / 2, PART_BYTES = (size_t)64 * 4 * 2 * 34 * 64 * 4;
constexpr size_t WS_BIG = 324 * MiB / 4 - MiB / 4;
constexpr size_t CTL_SCNT = 32768;
constexpr size_t CTL_SSQQ = 524288, CTL_SSQC = CTL_SSQQ + 2 * (size_t)MT * 4;
constexpr size_t B_KN = WS_BIG, B_VV = B_KN + (size_t)MA * 512 * 2, B_QNP = B_VV + (size_t)MA * 512 * 2, B_QRP = B_QNP + (size_t)MT * 512 * 2,
                 B_VN = B_QRP + (size_t)MT * 256 * 2, B_MRG = B_VN + (size_t)MT * 512 * 2, B_MRG_END = B_MRG + (size_t)MT * 1024 * 2;
constexpr size_t B_H = WS_BIG + (size_t)MT * NZ * 2 + (size_t)MT * 1024 * 2, B_H_END = B_H + (size_t)MT * DFF * 2;
constexpr size_t B_XB = 256 * MiB;
constexpr size_t WS_WKVG = B_XB + (size_t)MT * 2048;
constexpr size_t B_Z = WS_WKVG + 2 * 262144;
constexpr size_t WS_END = B_Z + (size_t)MT * NZ * 2;
static_assert(WS_ROPE + 2112 * 16 * 8 <= WS_PART && WS_PART + PART_BYTES <= WS_BIG && WS_BIG % 65536 == 0 && WS_PART % 65536 == 0, "ws map 1");
static_assert(B_MRG_END <= B_XB && B_H_END <= B_XB && B_XB + (size_t)MT * 2048 <= WS_END, "ws map 2");
static_assert(B_Z >= B_XB + (size_t)MT * 2048, "Z above XB");
static_assert(CTL_SSQ + 5 * (size_t)MT * 4 <= CTL_SSQQ && CTL_SSQC + 2 * (size_t)MT * 4 <= CTL_ZERO_BYTES, "ssq arrays inside the memset region");

constexpr int RING_BYTES = 131072, LDS_BYTES = 147456, MISC_OFF = LDS_BYTES - 256;

__device__ __forceinline__ unsigned pk2(float lo, float hi) { f32x2 v = {lo, hi}; bf16x2_t b = __builtin_convertvector(v, bf16x2_t); return __builtin_bit_cast(unsigned, b); }
__device__ __forceinline__ float bflo(unsigned w) { return __uint_as_float(w << 16); }
__device__ __forceinline__ float bfhi(unsigned w) { return __uint_as_float(w & 0xffff0000u); }
#define SWZ_XOR(v, m) __int_as_float(__builtin_amdgcn_ds_swizzle(__float_as_int(v), ((m) << 10) | 0x1f))
__device__ __forceinline__ float sum16(float v) { return v + __int_as_float(__builtin_amdgcn_ds_swizzle(__float_as_int(v), 0x401F)); }
__device__ __forceinline__ float sum32(float v) { auto r = __builtin_amdgcn_permlane32_swap(__float_as_uint(v), __float_as_uint(v), false, false); return __uint_as_float(r[0]) + __uint_as_float(r[1]); }
__device__ __forceinline__ float max32(float v) { auto r = __builtin_amdgcn_permlane32_swap(__float_as_uint(v), __float_as_uint(v), false, false); return fmaxf(__uint_as_float(r[0]), __uint_as_float(r[1])); }
__device__ __forceinline__ float sum8(float v) { v += SWZ_XOR(v, 1); v += SWZ_XOR(v, 2); v += SWZ_XOR(v, 4); return v; }
__device__ __forceinline__ float wave_sum(float v) { v = sum8(v); v += SWZ_XOR(v, 8); v += SWZ_XOR(v, 16); return sum32(v); }
__device__ __forceinline__ float dot4v(const f32x4 a) { return (a[0] * a[0] + a[1] * a[1]) + (a[2] * a[2] + a[3] * a[3]); }
__device__ __forceinline__ float rsq(float x) { return __builtin_amdgcn_rsqf(x); }
__device__ __forceinline__ float gelu_tanh(float x) {
    const float u2 = 1.5957691216057308f * (x + 0.044715f * x * x * x);
    return x * __builtin_amdgcn_rcpf(1.0f + __builtin_amdgcn_exp2f(-1.4426950408889634f * u2));
}
__device__ __forceinline__ float silu_f(float x) { return x * __builtin_amdgcn_rcpf(1.0f + __builtin_amdgcn_exp2f(-1.4426950408889634f * x)); }
namespace pg8 {
#define PG8_LAS __attribute__((address_space(3)))
typedef unsigned short bf16_t;
constexpr int BM = 256, BK = 64, HALF = 128, HTB = HALF * BK * 2  , STAGE_BYTES = 8 * HTB, NXCD = 8, WGM = 8;

__host__ __device__ __forceinline__ int lds_byte(int r, int c) { const int st = (r >> 4) * 2 + (c >> 5), rr = r & 15, cc = c & 31, ob = rr * 64 + cc * 2; return st * 1024 + (ob ^ (((ob >> 9) & 1) << 5)); }
__host__ __device__ __forceinline__ void stage_rc(int b, int& R, int& C) { const int st = b / 1024, sb = b % 1024, swz = sb ^ (((sb >> 9) & 1) << 5); R = (st >> 1) * 16 + swz / 64; C = (st & 1) * 32 + (swz % 64) / 2; }
__host__ __device__ __forceinline__ int perm32(int rho) { const int n = rho >> 4, i = rho & 15; return 8 * (i >> 2) + 4 * n + (i & 3); }

struct Unit { int pm, pn; };
struct Gemm { const bf16_t* A; const bf16_t* Bt; int M, N, K, lda; };

struct StaticOrder {
    int nM, nN, nwg, G, c, i0 = 0, i1 = 1 << 20;
    __host__ __device__ void init(int M, int N, int G_, int c_) { nM = M / BM; nN = N / BM; nwg = nM * nN; G = G_; c = c_; }
    __host__ __device__ bool next(int i_, Unit& u) const {
        const int i = i_ + i0; if (i >= i1) return false;
        const long L = (long)i * G + c; if (L >= nwg) return false;
        int wgid = (int)L; { const int q = nwg / NXCD, r = nwg % NXCD, xcd = wgid % NXCD, off = wgid / NXCD; wgid = (xcd < r ? xcd * (q + 1) : r * (q + 1) + (xcd - r) * q) + off; }
        const int nig = WGM * nN, gid = wgid / nig, fm = gid * WGM, gsz = (nM - fm) < WGM ? (nM - fm) : WGM;
        u.pm = fm + ((wgid % nig) % gsz); u.pn = (wgid % nig) / gsz; return true;
    }
    __device__ __forceinline__ void a_ready(const Unit&) const {}
    __device__ __forceinline__ void done(const Unit&) const {}
};
__device__ __forceinline__ float dot4(const f32x4 a) { return (a[0] * a[0] + a[1] * a[1]) + (a[2] * a[2] + a[3] * a[3]); }

struct EpiZ {
    static constexpr bool PERM = true, AFTER_DRAIN = false;
    bf16_t* Z; const float* ssq; bf16_t* MRG; bf16_t* VN; float* gvs; const float* lng; const float* lnb; float* ssqQ; float* ssqC;
    __device__ __forceinline__ void operator()(const f32x4 (&acc)[2][2][4][2], const Unit& u, int wr, int wc, int fr_, int fq_) const {
        unsigned z_e = 0u; asm volatile("" : "+v"(z_e)); const int lane_e = (int)__builtin_amdgcn_mbcnt_hi(~0u, __builtin_amdgcn_mbcnt_lo(~0u, z_e)), fr = lane_e & 15, fq = lane_e >> 4; (void)fr_; (void)fq_;
        const int row0 = u.pm * BM + wr * 64 + fr;
        float rs[2][4];
#pragma unroll
        for (int ai = 0; ai < 2; ++ai)
#pragma unroll
            for (int m = 0; m < 4; ++m) rs[ai][m] = ssq[row0 + ai * HALF + m * 16];
        if (u.pn < 4) {
            bf16_t* dst; int ld;
            if (u.pn < 2) { dst = Z + u.pn * BM + wc * 32 + 8 * fq; ld = NZ; } else { dst = MRG + 512 + (u.pn - 2) * BM + wc * 32 + 8 * fq; ld = 1024; }
            const bool act = u.pn >= 2;
#pragma unroll
            for (int ai = 0; ai < 2; ++ai)
#pragma unroll
                for (int m = 0; m < 4; ++m) { const int row = row0 + ai * HALF + m * 16; const float r = rsq(rs[ai][m] * (1.0f / 1024.0f) + EPS); float sq = 0.f;
                    bf16_t* rowp = dst + (size_t)row * ld;
#pragma unroll
                    for (int bj = 0; bj < 2; ++bj) { f32x4 v0 = acc[ai][bj][m][0] * r, v1 = acc[ai][bj][m][1] * r;
                        if (act) {
#pragma unroll
                            for (int e = 0; e < 4; ++e) { v0[e] = gelu_tanh(v0[e]); v1[e] = gelu_tanh(v1[e]); } }
                        u32x4 w; w.x = pk2(v0[0], v0[1]); w.y = pk2(v0[2], v0[3]); w.z = pk2(v1[0], v1[1]); w.w = pk2(v1[2], v1[3]);
                        *(u32x4*)(rowp + bj * HALF) = w;
                        if (!act && (u.pn == 0 || bj == 0)) sq += dot4(v0) + dot4(v1); }
                    if (!act) { sq = sum32(sum16(sq)); if (fq == 0) atomicAdd((u.pn == 0 ? ssqQ : ssqC) + row, sq); }
                    __builtin_amdgcn_sched_barrier(0); }
        } else {
            const int grp = 4 * (u.pn - 4) + wc;
            f32x4 gg[2][2], gb[2][2];
#pragma unroll
            for (int bj = 0; bj < 2; ++bj)
#pragma unroll
                for (int n = 0; n < 2; ++n) { gg[bj][n] = *(const f32x4*)(lng + grp * 64 + 32 * bj + 8 * fq + 4 * n); gb[bj][n] = *(const f32x4*)(lnb + grp * 64 + 32 * bj + 8 * fq + 4 * n); }
#pragma unroll
            for (int ai = 0; ai < 2; ++ai)
#pragma unroll
                for (int m = 0; m < 4; ++m) { const int row = row0 + ai * HALF + m * 16; const float r = rsq(rs[ai][m] * (1.0f / 1024.0f) + EPS);
                    f32x4 y[2][2]; float s = 0.f;
#pragma unroll
                    for (int bj = 0; bj < 2; ++bj)
#pragma unroll
                        for (int n = 0; n < 2; ++n) { const f32x4 a = acc[ai][bj][m][n] * r;
#pragma unroll
                            for (int e = 0; e < 4; ++e) { y[bj][n][e] = gelu_tanh(a[e]); s += y[bj][n][e]; } }
                    s = sum32(sum16(s)); const float mean = s * (1.0f / 64.0f); float s2 = 0.f;
#pragma unroll
                    for (int bj = 0; bj < 2; ++bj)
#pragma unroll
                        for (int n = 0; n < 2; ++n) { y[bj][n] = y[bj][n] - mean; s2 += dot4(y[bj][n]); }
                    s2 = sum32(sum16(s2)); const float rstd = rsq(s2 * (1.0f / 64.0f) + EPS);
#pragma unroll
                    for (int bj = 0; bj < 2; ++bj) { const f32x4 o0 = y[bj][0] * rstd * gg[bj][0] + gb[bj][0], o1 = y[bj][1] * rstd * gg[bj][1] + gb[bj][1];
                        u32x4 w; w.x = pk2(o0[0], o0[1]); w.y = pk2(o0[2], o0[3]); w.z = pk2(o1[0], o1[1]); w.w = pk2(o1[2], o1[3]);
                        *(u32x4*)(VN + (size_t)row * 512 + grp * 64 + 32 * bj + 8 * fq) = w;
                        if (row >= MP) { float* op = gvs + (size_t)(row - MP) * 512 + grp * 64 + 32 * bj + 8 * fq; *(f32x4*)op = o0; *(f32x4*)(op + 4) = o1; } }
                    __builtin_amdgcn_sched_barrier(0); }
        }
    }
};

struct EpiGU {
    static constexpr bool PERM = true, AFTER_DRAIN = false;
    bf16_t* H; const float* ssq;
    __device__ __forceinline__ void operator()(const f32x4 (&acc)[2][2][4][2], const Unit& u, int wr, int wc, int fr_, int fq_) const {
        unsigned z_e = 0u; asm volatile("" : "+v"(z_e)); const int lane_e = (int)__builtin_amdgcn_mbcnt_hi(~0u, __builtin_amdgcn_mbcnt_lo(~0u, z_e)), fr = lane_e & 15, fq = lane_e >> 4; (void)fr_; (void)fq_;
        const int row0 = u.pm * BM + wr * 64 + fr, colh = u.pn * HALF + wc * 32 + 8 * fq;
        float rs[2][4];
#pragma unroll
        for (int ai = 0; ai < 2; ++ai)
#pragma unroll
            for (int m = 0; m < 4; ++m) rs[ai][m] = ssq[row0 + ai * HALF + m * 16];
#pragma unroll
        for (int ai = 0; ai < 2; ++ai)
#pragma unroll
            for (int m = 0; m < 4; ++m) { const int row = row0 + ai * HALF + m * 16; const float r = rsq(rs[ai][m] * (1.0f / 1024.0f) + EPS);
                const f32x4 g0 = acc[ai][0][m][0] * r, g1 = acc[ai][0][m][1] * r, u0 = acc[ai][1][m][0] * r, u1 = acc[ai][1][m][1] * r;
                f32x4 h0, h1;
#pragma unroll
                for (int e = 0; e < 4; ++e) { h0[e] = silu_f(g0[e]) * u0[e]; h1[e] = silu_f(g1[e]) * u1[e]; }
                u32x4 w; w.x = pk2(h0[0], h0[1]); w.y = pk2(h0[2], h0[3]); w.z = pk2(h1[0], h1[1]); w.w = pk2(h1[2], h1[3]);
                *(u32x4*)(H + (size_t)row * DFF + colh) = w; }
    }
};

struct EpiRes {
    static constexpr bool PERM = true, AFTER_DRAIN = false;
    float* out; bf16_t* XB; float* ssq; int final_f32;
    __device__ __forceinline__ void operator()(const f32x4 (&acc)[2][2][4][2], const Unit& u, int wr, int wc, int fr_, int fq_) const {
        unsigned z_e = 0u; asm volatile("" : "+v"(z_e)); const int lane_e = (int)__builtin_amdgcn_mbcnt_hi(~0u, __builtin_amdgcn_mbcnt_lo(~0u, z_e)), fr = lane_e & 15, fq = lane_e >> 4; (void)fr_; (void)fq_;
        const int col0 = u.pn * BM + wc * 32 + 8 * fq;
#pragma unroll
        for (int ai = 0; ai < 2; ++ai)
#pragma unroll
            for (int m = 0; m < 4; ++m) { const size_t row = (size_t)u.pm * BM + ai * HALF + wr * 64 + m * 16 + fr; float ss = 0.f;
#pragma unroll
                for (int bj = 0; bj < 2; ++bj) { bf16_t* xp = XB + row * 1024 + col0 + bj * HALF;
                    const u32x4 xw = *(const u32x4*)xp;
                    const f32x4 o0 = (f32x4){bflo(xw.x), bfhi(xw.x), bflo(xw.y), bfhi(xw.y)} + acc[ai][bj][m][0], o1 = (f32x4){bflo(xw.z), bfhi(xw.z), bflo(xw.w), bfhi(xw.w)} + acc[ai][bj][m][1];
                    if (final_f32) { float* op = out + row * 1024 + col0 + bj * HALF; *(f32x4*)op = o0; *(f32x4*)(op + 4) = o1; }
                    else { u32x4 w; w.x = pk2(o0[0], o0[1]); w.y = pk2(o0[2], o0[3]); w.z = pk2(o1[0], o1[1]); w.w = pk2(o1[2], o1[3]); *(u32x4*)xp = w; ss += dot4(o0) + dot4(o1); } }
                if (!final_f32) { ss = sum32(sum16(ss)); if (fq == 0) atomicAdd(ssq + row, ss); }
                if (m & 1) asm volatile("" ::: "memory"); }
    }
};

struct EpiQ {
    static constexpr bool PERM = true, AFTER_DRAIN = false;
    bf16_t* QNP; bf16_t* QRP; const float* gqn; const float* gqr; const float* rope; const float* ssqQ;
    __device__ __forceinline__ void operator()(const f32x4 (&acc)[2][2][4][2], const Unit& u, int wr, int wc, int fr_, int fq_) const {
        unsigned z_e = 0u; asm volatile("" : "+v"(z_e)); const int lane_e = (int)__builtin_amdgcn_mbcnt_hi(~0u, __builtin_amdgcn_mbcnt_lo(~0u, z_e)), fr = lane_e & 15, fq = lane_e >> 4; (void)fr_; (void)fq_;
        const int row0 = u.pm * BM + wr * 64 + fr;
        float rq[2][4];
#pragma unroll
        for (int ai = 0; ai < 2; ++ai)
#pragma unroll
            for (int m = 0; m < 4; ++m) rq[ai][m] = ssqQ[row0 + ai * HALF + m * 16];
#pragma unroll
        for (int ai = 0; ai < 2; ++ai)
#pragma unroll
            for (int m = 0; m < 4; ++m) rq[ai][m] = rsq(rq[ai][m] * (1.0f / 256.0f) + EPS);
        if (u.pn < 2) {
            const int head = 4 * u.pn + wc;
            f32x4 gv[2][2];
#pragma unroll
            for (int bj = 0; bj < 2; ++bj)
#pragma unroll
                for (int n = 0; n < 2; ++n) gv[bj][n] = *(const f32x4*)(gqn + 32 * bj + 8 * fq + 4 * n) * QSCALE;
#pragma unroll
            for (int ai = 0; ai < 2; ++ai)
#pragma unroll
                for (int m = 0; m < 4; ++m) { const int row = row0 + ai * HALF + m * 16;
                    float ss = (dot4(acc[ai][0][m][0]) + dot4(acc[ai][0][m][1])) + (dot4(acc[ai][1][m][0]) + dot4(acc[ai][1][m][1]));
                    ss = sum32(sum16(ss)) * (rq[ai][m] * rq[ai][m]);
                    const float rn = rsq(ss * (1.0f / 64.0f) + EPS) * rq[ai][m];
#pragma unroll
                    for (int bj = 0; bj < 2; ++bj) { const f32x4 v0 = acc[ai][bj][m][0] * gv[bj][0] * rn, v1 = acc[ai][bj][m][1] * gv[bj][1] * rn;
                        u32x4 w; w.x = pk2(v0[0], v0[1]); w.y = pk2(v0[2], v0[3]); w.z = pk2(v1[0], v1[1]); w.w = pk2(v1[2], v1[3]);
                        *(u32x4*)(QNP + (size_t)row * 512 + head * 64 + 32 * bj + 8 * fq) = w; }  __builtin_amdgcn_sched_barrier(0); }
        } else {
            const f32x4 g1 = *(const f32x4*)(gqr + 4 * fq) * QSCALE, g2 = *(const f32x4*)(gqr + 16 + 4 * fq) * QSCALE;
#pragma unroll
            for (int ai = 0; ai < 2; ++ai)
#pragma unroll
                for (int m = 0; m < 4; ++m) { const int row = row0 + ai * HALF + m * 16;
                    const int posidx = row < MP ? (row & 2047) : 2048 + ((row - MP) & 63);
                    const float* rp = rope + (size_t)(posidx * 16 + 4 * fq) * 2;
                    const f32x4 cs0 = *(const f32x4*)rp, cs1 = *(const f32x4*)(rp + 4);
                    const f32x4 cc = {cs0[0], cs0[2], cs1[0], cs1[2]}, sn = {cs0[1], cs0[3], cs1[1], cs1[3]};
#pragma unroll
                    for (int bj = 0; bj < 2; ++bj) { const f32x4 x1 = acc[ai][bj][m][0], x2 = acc[ai][bj][m][1];
                        float ss = dot4(x1) + dot4(x2); ss = sum32(sum16(ss)) * (rq[ai][m] * rq[ai][m]);
                        const float rn = rsq(ss * (1.0f / 32.0f) + EPS) * rq[ai][m];
                        const f32x4 a = x1 * g1 * rn, b = x2 * g2 * rn;
                        const f32x4 o1 = a * cc - b * sn, o2 = a * sn + b * cc;
                        const int head = 2 * wc + bj;
                        u32x2 w1, w2; w1.x = pk2(o1[0], o1[1]); w1.y = pk2(o1[2], o1[3]); w2.x = pk2(o2[0], o2[1]); w2.y = pk2(o2[2], o2[3]);
                        bf16_t* qp = QRP + (size_t)row * 256 + head * 32 + 4 * fq;
                        *(u32x2*)qp = w1; *(u32x2*)(qp + 16) = w2; }  __builtin_amdgcn_sched_barrier(0); }
        }
    }
};

struct EpiKV {
    static constexpr bool PERM = true, AFTER_DRAIN = false;
    bf16_t* KN; bf16_t* VV; const float* gkn; const float* ssqC;
    __device__ __forceinline__ void operator()(const f32x4 (&acc)[2][2][4][2], const Unit& u, int wr, int wc, int fr_, int fq_) const {
        unsigned z_e = 0u; asm volatile("" : "+v"(z_e)); const int lane_e = (int)__builtin_amdgcn_mbcnt_hi(~0u, __builtin_amdgcn_mbcnt_lo(~0u, z_e)), fr = lane_e & 15, fq = lane_e >> 4; (void)fr_; (void)fq_;
        const int row0 = u.pm * BM + wr * 64 + fr;
        float rc[2][4];
#pragma unroll
        for (int ai = 0; ai < 2; ++ai)
#pragma unroll
            for (int m = 0; m < 4; ++m) rc[ai][m] = ssqC ? ssqC[row0 + ai * HALF + m * 16] : 0.f;
#pragma unroll
        for (int ai = 0; ai < 2; ++ai)
#pragma unroll
            for (int m = 0; m < 4; ++m) rc[ai][m] = ssqC ? rsq(rc[ai][m] * (1.0f / 128.0f) + EPS) : 1.0f;
        if (u.pn < 2) {
            const int head = 4 * u.pn + wc;
            f32x4 gv[2][2];
#pragma unroll
            for (int bj = 0; bj < 2; ++bj)
#pragma unroll
                for (int n = 0; n < 2; ++n) gv[bj][n] = *(const f32x4*)(gkn + 32 * bj + 8 * fq + 4 * n);
#pragma unroll
            for (int ai = 0; ai < 2; ++ai)
#pragma unroll
                for (int m = 0; m < 4; ++m) { const int row = row0 + ai * HALF + m * 16;
                    float ss = (dot4(acc[ai][0][m][0]) + dot4(acc[ai][0][m][1])) + (dot4(acc[ai][1][m][0]) + dot4(acc[ai][1][m][1]));
                    ss = sum32(sum16(ss)) * (rc[ai][m] * rc[ai][m]);
                    const float rn = rsq(ss * (1.0f / 64.0f) + EPS) * rc[ai][m];
#pragma unroll
                    for (int bj = 0; bj < 2; ++bj) { const f32x4 v0 = acc[ai][bj][m][0] * gv[bj][0] * rn, v1 = acc[ai][bj][m][1] * gv[bj][1] * rn;
                        u32x4 w; w.x = pk2(v0[0], v0[1]); w.y = pk2(v0[2], v0[3]); w.z = pk2(v1[0], v1[1]); w.w = pk2(v1[2], v1[3]);
                        *(u32x4*)(KN + (size_t)row * 512 + head * 64 + 32 * bj + 8 * fq) = w; }  __builtin_amdgcn_sched_barrier(0); }
        } else {
            const int head = 4 * (u.pn - 2) + wc;
#pragma unroll
            for (int ai = 0; ai < 2; ++ai)
#pragma unroll
                for (int m = 0; m < 4; ++m) { const int row = row0 + ai * HALF + m * 16;
#pragma unroll
                    for (int bj = 0; bj < 2; ++bj) { const f32x4 v0 = acc[ai][bj][m][0] * rc[ai][m], v1 = acc[ai][bj][m][1] * rc[ai][m];
                        u32x4 w; w.x = pk2(v0[0], v0[1]); w.y = pk2(v0[2], v0[3]); w.z = pk2(v1[0], v1[1]); w.w = pk2(v1[2], v1[3]);
                        *(u32x4*)(VV + (size_t)row * 512 + head * 64 + 32 * bj + 8 * fq) = w; }  __builtin_amdgcn_sched_barrier(0); }
        }
    }
};

template <class Epi, class Sched, bool ALIGN_EPI = false, bool SP2 = false>
__device__ __forceinline__ void gemm_phase(PG8_LAS unsigned char* lds, const Gemm g, const Sched& S, const Epi& E, const int wid_in) {
    int wid = wid_in; asm volatile("" : "+s"(wid));
    unsigned z_ = 0u; asm volatile("" : "+v"(z_)); const int lane_ = (int)__builtin_amdgcn_mbcnt_hi(~0u, __builtin_amdgcn_mbcnt_lo(~0u, z_));
    const int lane = lane_, tid = wid * 64 + lane, wr = wid >> 2, wc = wid & 3, fr = lane & 15, fq = lane >> 4;
    const int K = g.K, nt = K / BK;
    unsigned voffA[2], voffB[2];
#pragma unroll
    for (int i = 0; i < 2; ++i) { int R, C; stage_rc(tid * 16 + i * 8192, R, C); const int Rb = Epi::PERM ? ((R & ~31) + perm32(R & 31)) : R;
        voffA[i] = (unsigned)(R * g.lda + C) * 2u; voffB[i] = (unsigned)(Rb * K + C) * 2u; }
    const size_t kstep = (size_t)(BK * 2);
    const size_t hstepA = (size_t)HALF * g.lda * 2, hstepB = (size_t)HALF * K * 2;
    const size_t tstepA = 2 * hstepA, tstepB = 2 * hstepB;
    const unsigned ldsw = (unsigned)wid * 1024u;
    const int aoff = lds_byte(wr * 64 + fr, fq * 8), boff = lds_byte(wc * 32 + fr, fq * 8);
#define PG8_SA(b, h) (((b) * 2 + (h)) * HTB)
#define PG8_SB(b, h) ((4 + (b) * 2 + (h)) * HTB)
#define PG8_STAGE(bufoff, gbase, voff) do { _Pragma("unroll") for (int _i = 0; _i < 2; ++_i) \
        __builtin_amdgcn_global_load_lds((const unsigned*)((const char*)(gbase) + (voff)[_i]), (PG8_LAS unsigned*)(lds + (bufoff) + ldsw + _i * 8192), 16, 0, 0); } while (0)
#define PG8_LDA(dst, b, h) do { _Pragma("unroll") for (int m = 0; m < 4; ++m) _Pragma("unroll") for (int k = 0; k < 2; ++k) dst[m][k] = *(const PG8_LAS bf16x8*)(lds + PG8_SA(b, h) + aoff + m * 2048 + k * 1024); } while (0)
#define PG8_LDB(dst, b, h) do { _Pragma("unroll") for (int n = 0; n < 2; ++n) _Pragma("unroll") for (int k = 0; k < 2; ++k) dst[n][k] = *(const PG8_LAS bf16x8*)(lds + PG8_SB(b, h) + boff + n * 2048 + k * 1024); } while (0)
#define PG8_MMA(ai, bj, At, Bt) do { __builtin_amdgcn_s_setprio(1); _Pragma("unroll") for (int m = 0; m < 4; ++m) _Pragma("unroll") for (int n = 0; n < 2; ++n) _Pragma("unroll") for (int k = 0; k < 2; ++k) \
        acc[ai][bj][m][n] = __builtin_amdgcn_mfma_f32_16x16x32_bf16(Bt[n][k], At[m][k], acc[ai][bj][m][n], 0, 0, 0); __builtin_amdgcn_s_setprio(0); } while (0)
#define PG8_WAIT_V(n) asm volatile("s_waitcnt vmcnt(" #n ")" ::: "memory")
#define PG8_WAIT_L(n) asm volatile("s_waitcnt lgkmcnt(" #n ")" ::: "memory")
#define PG8_BAR __builtin_amdgcn_s_barrier()
#define PG8_SCHED __builtin_amdgcn_sched_barrier(0)
    Unit cur, nxt; int ui = 0;
    if (!S.next(0, cur)) return;
    f32x4 acc[2][2][4][2];
#pragma unroll
    for (int a = 0; a < 2; ++a)
#pragma unroll
        for (int b = 0; b < 2; ++b)
#pragma unroll
            for (int m = 0; m < 4; ++m)
#pragma unroll
                for (int n = 0; n < 2; ++n) acc[a][b][m][n] = (f32x4){0.f, 0.f, 0.f, 0.f};
    bf16x8 At[4][2], B0[2][2], B1[2][2];
    const char* cA = (const char*)g.A + (size_t)cur.pm * tstepA; const char* cB = (const char*)g.Bt + (size_t)cur.pn * tstepB;
    S.a_ready(cur);
    if constexpr (SP2) {
        PG8_STAGE(PG8_SB(0, 0), cB, voffB); PG8_STAGE(PG8_SB(0, 1), cB + hstepB, voffB); PG8_STAGE(PG8_SA(0, 0), cA, voffA); PG8_STAGE(PG8_SA(0, 1), cA + hstepA, voffA);
        if (wr == 1) PG8_BAR;
        PG8_WAIT_V(2); PG8_BAR;
        PG8_STAGE(PG8_SB(1, 0), cB + kstep, voffB); PG8_STAGE(PG8_SA(1, 0), cA + kstep, voffA); PG8_STAGE(PG8_SB(1, 1), cB + hstepB + kstep, voffB);
        PG8_WAIT_V(6); PG8_BAR;
    } else {
        PG8_STAGE(PG8_SB(0, 0), cB, voffB); PG8_STAGE(PG8_SA(0, 0), cA, voffA); PG8_STAGE(PG8_SB(0, 1), cB + hstepB, voffB); PG8_STAGE(PG8_SA(0, 1), cA + hstepA, voffA);
        if (wr == 1) PG8_BAR;
        PG8_WAIT_V(4); PG8_BAR;
        PG8_STAGE(PG8_SB(1, 0), cB + kstep, voffB); PG8_STAGE(PG8_SA(1, 0), cA + kstep, voffA); PG8_STAGE(PG8_SB(1, 1), cB + hstepB + kstep, voffB);
        PG8_WAIT_V(6); PG8_BAR;
    }
    for (;;) {
        const bool has_next = S.next(ui + 1, nxt);
        const char* nA = has_next ? (const char*)g.A + (size_t)nxt.pm * tstepA : cA; const char* nB = has_next ? (const char*)g.Bt + (size_t)nxt.pn * tstepB : cB;
        for (int t = 0; t < nt; t += 2) {
            const bool last = (t == nt - 2);
            const char* a1 = cA + (size_t)(t + 1) * kstep;
            const char* a2 = last ? nA : cA + (size_t)(t + 2) * kstep; const char* b2 = last ? nB : cB + (size_t)(t + 2) * kstep;
            const char* a3 = a2 + kstep; const char* b3 = b2 + kstep;
            if (last && has_next) S.a_ready(nxt);
            if constexpr (SP2) {
            PG8_LDB(B0, 0, 0); PG8_LDB(B1, 0, 1); PG8_SCHED; PG8_LDA(At, 0, 0); PG8_STAGE(PG8_SA(1, 1), a1 + hstepA, voffA);
            PG8_WAIT_V(8); PG8_WAIT_L(0); PG8_BAR; PG8_MMA(0, 0, At, B0); PG8_MMA(0, 1, At, B1); PG8_BAR; PG8_SCHED;
            PG8_LDA(At, 0, 1); PG8_STAGE(PG8_SB(0, 0), b2, voffB); PG8_STAGE(PG8_SB(0, 1), b2 + hstepB, voffB); PG8_STAGE(PG8_SA(0, 0), a2, voffA);
            PG8_WAIT_V(8); PG8_WAIT_L(0); PG8_BAR; PG8_MMA(1, 0, At, B0); PG8_MMA(1, 1, At, B1); PG8_BAR; PG8_SCHED;
            PG8_LDB(B0, 1, 0); PG8_LDB(B1, 1, 1); PG8_SCHED; PG8_LDA(At, 1, 0); PG8_STAGE(PG8_SA(0, 1), a2 + hstepA, voffA);
            PG8_WAIT_V(8); PG8_WAIT_L(0); PG8_BAR; PG8_MMA(0, 0, At, B0); PG8_MMA(0, 1, At, B1); PG8_BAR; PG8_SCHED;
            PG8_LDA(At, 1, 1); PG8_STAGE(PG8_SB(1, 0), b3, voffB); PG8_STAGE(PG8_SB(1, 1), b3 + hstepB, voffB); PG8_STAGE(PG8_SA(1, 0), a3, voffA);
            PG8_WAIT_V(8); PG8_WAIT_L(0); PG8_BAR; PG8_MMA(1, 0, At, B0); PG8_MMA(1, 1, At, B1); PG8_BAR; PG8_SCHED;
            } else {
            PG8_LDB(B0, 0, 0); PG8_SCHED; PG8_LDA(At, 0, 0); PG8_STAGE(PG8_SA(1, 1), a1 + hstepA, voffA);
            PG8_WAIT_L(8); PG8_BAR; PG8_WAIT_L(0); PG8_MMA(0, 0, At, B0); PG8_BAR; PG8_SCHED;
            PG8_LDB(B1, 0, 1); PG8_STAGE(PG8_SB(0, 0), b2, voffB);
            PG8_BAR; PG8_WAIT_L(0); PG8_MMA(0, 1, At, B1); PG8_BAR;
            PG8_LDA(At, 0, 1); PG8_STAGE(PG8_SA(0, 0), a2, voffA);
            PG8_BAR; PG8_WAIT_L(0); PG8_MMA(1, 0, At, B0); PG8_BAR; PG8_SCHED;
            PG8_STAGE(PG8_SB(0, 1), b2 + hstepB, voffB);
            PG8_WAIT_V(6); PG8_BAR; PG8_MMA(1, 1, At, B1); PG8_BAR;
            PG8_LDB(B0, 1, 0); PG8_SCHED; PG8_LDA(At, 1, 0); PG8_STAGE(PG8_SA(0, 1), a2 + hstepA, voffA);
            PG8_WAIT_L(8); PG8_BAR; PG8_WAIT_L(0); PG8_MMA(0, 0, At, B0); PG8_BAR; PG8_SCHED;
            PG8_LDB(B1, 1, 1); PG8_STAGE(PG8_SB(1, 0), b3, voffB);
            PG8_BAR; PG8_WAIT_L(0); PG8_MMA(0, 1, At, B1); PG8_BAR;
            PG8_LDA(At, 1, 1); PG8_STAGE(PG8_SA(1, 0), a3, voffA);
            PG8_BAR; PG8_WAIT_L(0); PG8_MMA(1, 0, At, B0); PG8_BAR; PG8_SCHED;
            PG8_STAGE(PG8_SB(1, 1), b3 + hstepB, voffB);
            PG8_WAIT_V(6); PG8_BAR; PG8_MMA(1, 1, At, B1); PG8_BAR;
            }
        }
        if constexpr (ALIGN_EPI) { if (wr == 0) PG8_BAR; }
        if constexpr (!Epi::AFTER_DRAIN) { E(acc, cur, wr, wc, fr, fq); S.done(cur); }
        if (!has_next) break;
#pragma unroll
        for (int a = 0; a < 2; ++a)
#pragma unroll
            for (int b = 0; b < 2; ++b)
#pragma unroll
                for (int m = 0; m < 4; ++m)
#pragma unroll
                    for (int n = 0; n < 2; ++n) acc[a][b][m][n] = (f32x4){0.f, 0.f, 0.f, 0.f};
        cur = nxt; cA = nA; cB = nB; ++ui;
        if constexpr (ALIGN_EPI) { if (wr == 1) PG8_BAR; }
    }
    PG8_WAIT_V(0);
    if constexpr (!ALIGN_EPI) { if (wr == 0) PG8_BAR; }
    PG8_BAR;
    if constexpr (Epi::AFTER_DRAIN) { E.fused(acc, cur, wr, wc, fr, fq, lds, wid, lane); S.done(cur); }
#undef PG8_SA
#undef PG8_SB
#undef PG8_STAGE
#undef PG8_LDA
#undef PG8_LDB
#undef PG8_MMA
#undef PG8_WAIT_V
#undef PG8_WAIT_L
#undef PG8_BAR
#undef PG8_SCHED
}
}
namespace att {
constexpr int KSTR = 208, VSTR = 192, KB_BYTES = 64 * KSTR, VB_BYTES = 64 * VSTR, TILE_BYTES = KB_BYTES + VB_BYTES;
typedef short v4i16_t __attribute__((ext_vector_type(4)));
__device__ __forceinline__ s16x4 vtr(const LAS char* p) { return __builtin_bit_cast(s16x4, __builtin_amdgcn_ds_read_tr16_b64_v4i16((LAS v4i16_t*)p)); }
__device__ __forceinline__ bf16x8 cat8(s16x4 lo, s16x4 hi) { return (bf16x8){lo[0], lo[1], lo[2], lo[3], hi[0], hi[1], hi[2], hi[3]}; }

struct Ptrs { const bf16* QNP; const bf16* QRP; const bf16* KN; const bf16* VV; const bf16* KR; bf16* MRG; const float* gout; };
struct Stage { u32x4 kn, kr, vv; };

__device__ __forceinline__ void stage_load(Stage& s, const Ptrs& P, size_t krow0, int h, int tid) {
    const int row = tid >> 3, ch = tid & 7;
    s.kn = *(const u32x4*)(P.KN + (krow0 + row) * 512 + h * 64 + ch * 8);
    s.vv = *(const u32x4*)(P.VV + (krow0 + row) * 512 + h * 64 + ch * 8);
    if (tid < 256) { const int r2 = tid >> 2, c2 = tid & 3; s.kr = *(const u32x4*)(P.KR + (krow0 + r2) * 32 + c2 * 8); }
}
__device__ __forceinline__ void stage_store(const Stage& s, LAS char* buf, int tid) {
    const int row = tid >> 3, ch = tid & 7;
    *(LAS u32x4*)(buf + row * KSTR + ch * 16) = s.kn;
    *(LAS u32x4*)(buf + KB_BYTES + row * VSTR + ch * 16) = s.vv;
    if (tid < 256) { const int r2 = tid >> 2, c2 = tid & 3; *(LAS u32x4*)(buf + r2 * KSTR + 128 + c2 * 16) = s.kr; }
}
__device__ __forceinline__ void load_q(bf16x8 (&qf)[6], const Ptrs& P, size_t qrow, int h, int hi) {
#pragma unroll
    for (int s = 0; s < 4; ++s) qf[s] = *(const bf16x8*)(P.QNP + qrow * 512 + h * 64 + 16 * s + 8 * hi);
#pragma unroll
    for (int s = 0; s < 2; ++s) qf[4 + s] = *(const bf16x8*)(P.QRP + qrow * 256 + h * 32 + 16 * s + 8 * hi);
}

template <bool FIRST>
__device__ __forceinline__ void attn_tile(const LAS char* buf, const bf16x8 (&qf)[6], float& mrun, float& lrun, f32x16& o0, f32x16& o1, f32x16& negm, int lane) {
    const int r32 = lane & 31, hi = lane >> 5;
    const LAS char* kp = buf + r32 * KSTR + hi * 16;
    f32x16 p0, p1;
    { const bf16x8 a0 = *(const LAS bf16x8*)(kp), a1 = *(const LAS bf16x8*)(kp + 32 * KSTR);
      if (FIRST) { const f32x16 z = {}; p0 = __builtin_amdgcn_mfma_f32_32x32x16_bf16(a0, qf[0], z, 0, 0, 0); p1 = __builtin_amdgcn_mfma_f32_32x32x16_bf16(a1, qf[0], z, 0, 0, 0); }
      else { p0 = __builtin_amdgcn_mfma_f32_32x32x16_bf16(a0, qf[0], negm, 0, 0, 0); p1 = __builtin_amdgcn_mfma_f32_32x32x16_bf16(a1, qf[0], negm, 0, 0, 0); } }
#pragma unroll
    for (int s = 1; s < 6; ++s) {
        const bf16x8 a0 = *(const LAS bf16x8*)(kp + s * 32), a1 = *(const LAS bf16x8*)(kp + 32 * KSTR + s * 32);
        p0 = __builtin_amdgcn_mfma_f32_32x32x16_bf16(a0, qf[s], p0, 0, 0, 0);
        p1 = __builtin_amdgcn_mfma_f32_32x32x16_bf16(a1, qf[s], p1, 0, 0, 0);
    }
    float mx = fmaxf(p0[0], p1[0]);
#pragma unroll
    for (int r = 1; r < 16; ++r) mx = fmaxf(mx, fmaxf(p0[r], p1[r]));
    mx = max32(mx);
    if (FIRST) {
        mrun = mx;
#pragma unroll
        for (int r = 0; r < 16; ++r) { p0[r] -= mx; p1[r] -= mx; negm[r] = -mx; }
    } else if (__any(mx > 6.0f)) {
        const float dl = fmaxf(mx, 0.f), alpha = __builtin_amdgcn_exp2f(-dl);
        mrun += dl; lrun *= alpha;
#pragma unroll
        for (int r = 0; r < 16; ++r) { p0[r] -= dl; p1[r] -= dl; negm[r] = -mrun; }
        o0 *= alpha; o1 *= alpha;
    }
    float sum = 0.f;
#pragma unroll
    for (int r = 0; r < 16; ++r) { p0[r] = __builtin_amdgcn_exp2f(p0[r]); p1[r] = __builtin_amdgcn_exp2f(p1[r]); sum += p0[r] + p1[r]; }
    lrun += sum;
    u32x4 pw[4];
#pragma unroll
    for (int j = 0; j < 4; ++j) { pw[0][j] = pk2(p0[2 * j], p0[2 * j + 1]); pw[1][j] = pk2(p0[8 + 2 * j], p0[8 + 2 * j + 1]); pw[2][j] = pk2(p1[2 * j], p1[2 * j + 1]); pw[3][j] = pk2(p1[8 + 2 * j], p1[8 + 2 * j + 1]); }
    const LAS char* vp = buf + KB_BYTES + (4 * hi + ((lane & 15) >> 2)) * VSTR + (16 * ((lane >> 4) & 1) + 4 * (lane & 3)) * 2;
#pragma unroll
    for (int ks = 0; ks < 4; ++ks) {
        const bf16x8 pf = __builtin_bit_cast(bf16x8, pw[ks]);
        const bf16x8 v0 = cat8(vtr(vp + ks * 16 * VSTR), vtr(vp + (ks * 16 + 8) * VSTR));
        const bf16x8 v1 = cat8(vtr(vp + ks * 16 * VSTR + 64), vtr(vp + (ks * 16 + 8) * VSTR + 64));
        o0 = __builtin_amdgcn_mfma_f32_32x32x16_bf16(v0, pf, o0, 0, 0, 0);
        o1 = __builtin_amdgcn_mfma_f32_32x32x16_bf16(v1, pf, o1, 0, 0, 0);
    }
}

__device__ __forceinline__ void finalize(const Ptrs& P, size_t qrow, int h, float lrun, f32x16& o0, f32x16& o1, int lane) {
    const int hi = lane >> 5;
    const float l = sum32(lrun), inv = 1.0f / l;
    o0 *= inv; o1 *= inv;
    float ss = 0.f;
#pragma unroll
    for (int r = 0; r < 16; ++r) ss += o0[r] * o0[r] + o1[r] * o1[r];
    ss = sum32(ss);
    const float rn = rsq(ss * (1.0f / 64.0f) + EPS);
    const float* g = P.gout + h * 64; bf16* op = P.MRG + qrow * 1024 + h * 64;
#pragma unroll
    for (int rg = 0; rg < 4; ++rg) { const int d0 = 8 * rg + 4 * hi;
        const f32x4 g0 = *(const f32x4*)(g + d0), g1 = *(const f32x4*)(g + 32 + d0);
        u32x2 w0, w1;
        w0.x = pk2(o0[4 * rg] * rn * g0[0], o0[4 * rg + 1] * rn * g0[1]); w0.y = pk2(o0[4 * rg + 2] * rn * g0[2], o0[4 * rg + 3] * rn * g0[3]);
        w1.x = pk2(o1[4 * rg] * rn * g1[0], o1[4 * rg + 1] * rn * g1[1]); w1.y = pk2(o1[4 * rg + 2] * rn * g1[2], o1[4 * rg + 3] * rn * g1[3]);
        *(u32x2*)(op + d0) = w0; *(u32x2*)(op + 32 + d0) = w1; }
}

__device__ __forceinline__ float max3f(float a, float b, float c) { float r; asm("v_max3_f32 %0, %1, %2, %3" : "=v"(r) : "v"(a), "v"(b), "v"(c)); return r; }
template <bool FIRST>
__device__ __forceinline__ void attn_tile2(const LAS char* bufA, const LAS char* bufB, int nv, const bf16x8 (&qf)[6], float& mrun, float& lrun, f32x16& o0, f32x16& o1, f32x16& negm, int lane) {
    const int r32 = lane & 31, hi = lane >> 5;
    const LAS char* kpa = bufA + r32 * KSTR + hi * 16; const LAS char* kpb = bufB + r32 * KSTR + hi * 16;
    f32x16 p0, p1, p2, p3;
    { const bf16x8 a0 = *(const LAS bf16x8*)(kpa), a1 = *(const LAS bf16x8*)(kpa + 32 * KSTR), a2 = *(const LAS bf16x8*)(kpb), a3 = *(const LAS bf16x8*)(kpb + 32 * KSTR);
      if (FIRST) { const f32x16 z = {}; p0 = __builtin_amdgcn_mfma_f32_32x32x16_bf16(a0, qf[0], z, 0, 0, 0); p1 = __builtin_amdgcn_mfma_f32_32x32x16_bf16(a1, qf[0], z, 0, 0, 0);
                   p2 = __builtin_amdgcn_mfma_f32_32x32x16_bf16(a2, qf[0], z, 0, 0, 0); p3 = __builtin_amdgcn_mfma_f32_32x32x16_bf16(a3, qf[0], z, 0, 0, 0); }
      else { p0 = __builtin_amdgcn_mfma_f32_32x32x16_bf16(a0, qf[0], negm, 0, 0, 0); p1 = __builtin_amdgcn_mfma_f32_32x32x16_bf16(a1, qf[0], negm, 0, 0, 0);
             p2 = __builtin_amdgcn_mfma_f32_32x32x16_bf16(a2, qf[0], negm, 0, 0, 0); p3 = __builtin_amdgcn_mfma_f32_32x32x16_bf16(a3, qf[0], negm, 0, 0, 0); } }
#pragma unroll
    for (int s = 1; s < 6; ++s) {
        const bf16x8 a0 = *(const LAS bf16x8*)(kpa + s * 32), a1 = *(const LAS bf16x8*)(kpa + 32 * KSTR + s * 32), a2 = *(const LAS bf16x8*)(kpb + s * 32), a3 = *(const LAS bf16x8*)(kpb + 32 * KSTR + s * 32);
        p0 = __builtin_amdgcn_mfma_f32_32x32x16_bf16(a0, qf[s], p0, 0, 0, 0); p1 = __builtin_amdgcn_mfma_f32_32x32x16_bf16(a1, qf[s], p1, 0, 0, 0);
        p2 = __builtin_amdgcn_mfma_f32_32x32x16_bf16(a2, qf[s], p2, 0, 0, 0); p3 = __builtin_amdgcn_mfma_f32_32x32x16_bf16(a3, qf[s], p3, 0, 0, 0);
    }
    if (__builtin_expect(nv < 2, 0)) {
        asm volatile("" ::: "memory");
#pragma unroll
        for (int r = 0; r < 16; ++r) { p2[r] = -1e30f; p3[r] = -1e30f; } }
    asm volatile("s_nop 15\n\ts_nop 7" : "+v"(p0), "+v"(p1), "+v"(p2), "+v"(p3));
    float ma = max3f(p0[0], p1[0], p2[0]), mb = max3f(p3[0], p0[1], p1[1]);
    ma = max3f(ma, p2[1], p3[1]);
#pragma unroll
    for (int r = 2; r < 16; r += 2) { ma = max3f(ma, p0[r], p1[r]); mb = max3f(mb, p2[r], p3[r]); ma = max3f(ma, p0[r + 1], p1[r + 1]); mb = max3f(mb, p2[r + 1], p3[r + 1]); }
    float mx = fmaxf(ma, mb);
    mx = max32(mx);
    if (FIRST) {
        mrun = mx;
#pragma unroll
        for (int r = 0; r < 16; ++r) { p0[r] -= mx; p1[r] -= mx; p2[r] -= mx; p3[r] -= mx; negm[r] = -mx; }
    } else if (__any(mx > 6.0f)) {
        const float dl = fmaxf(mx, 0.f), alpha = __builtin_amdgcn_exp2f(-dl);
        mrun += dl; lrun *= alpha;
#pragma unroll
        for (int r = 0; r < 16; ++r) { p0[r] -= dl; p1[r] -= dl; p2[r] -= dl; p3[r] -= dl; negm[r] = -mrun; }
        o0 *= alpha; o1 *= alpha;
    }
    float sa = 0.f, sb = 0.f;
#pragma unroll
    for (int r = 0; r < 16; ++r) { p0[r] = __builtin_amdgcn_exp2f(p0[r]); p1[r] = __builtin_amdgcn_exp2f(p1[r]); p2[r] = __builtin_amdgcn_exp2f(p2[r]); p3[r] = __builtin_amdgcn_exp2f(p3[r]); sa += p0[r] + p1[r]; sb += p2[r] + p3[r]; }
    lrun += sa + sb;
    u32x4 pw[8];
#pragma unroll
    for (int j = 0; j < 4; ++j) { pw[0][j] = pk2(p0[2 * j], p0[2 * j + 1]); pw[1][j] = pk2(p0[8 + 2 * j], p0[8 + 2 * j + 1]); pw[2][j] = pk2(p1[2 * j], p1[2 * j + 1]); pw[3][j] = pk2(p1[8 + 2 * j], p1[8 + 2 * j + 1]);
                                  pw[4][j] = pk2(p2[2 * j], p2[2 * j + 1]); pw[5][j] = pk2(p2[8 + 2 * j], p2[8 + 2 * j + 1]); pw[6][j] = pk2(p3[2 * j], p3[2 * j + 1]); pw[7][j] = pk2(p3[8 + 2 * j], p3[8 + 2 * j + 1]); }
    const int voff = (4 * hi + ((lane & 15) >> 2)) * VSTR + (16 * ((lane >> 4) & 1) + 4 * (lane & 3)) * 2;
#pragma unroll
    for (int ks = 0; ks < 8; ++ks) {
        if (ks >= 4 && nv < 2) break;
        const LAS char* vp = (ks < 4 ? bufA : bufB) + KB_BYTES + voff;
        const int kk = ks & 3;
        const bf16x8 pf = __builtin_bit_cast(bf16x8, pw[ks]);
        const bf16x8 v0 = cat8(vtr(vp + kk * 16 * VSTR), vtr(vp + (kk * 16 + 8) * VSTR));
        const bf16x8 v1 = cat8(vtr(vp + kk * 16 * VSTR + 64), vtr(vp + (kk * 16 + 8) * VSTR + 64));
        o0 = __builtin_amdgcn_mfma_f32_32x32x16_bf16(v0, pf, o0, 0, 0, 0);
        o1 = __builtin_amdgcn_mfma_f32_32x32x16_bf16(v1, pf, o1, 0, 0, 0);
    }
}

__device__ __forceinline__ void prompt_unit(const Ptrs& P, int b, int h, int qb, LAS char* lds, int tid_in, int lane_in, int wid) {
    int tid = tid_in, lane = lane_in; asm volatile("" : "+v"(tid), "+v"(lane));
    const size_t rowbase = (size_t)b * 2048; const int r32 = lane & 31, hi = lane >> 5;
    const size_t qrow = rowbase + qb * 256 + wid * 32 + r32;
    bf16x8 qf[6]; load_q(qf, P, qrow, h, hi);
    const int NT = 4 * qb + 4, myNT = 4 * qb + (wid >> 1) + 1, NP = NT >> 1;
    float mrun = 0.f, lrun = 0.f; f32x16 o0 = {}, o1 = {}, negm = {};
    Stage sa, sb; stage_load(sa, P, rowbase, h, tid); stage_load(sb, P, rowbase + 64, h, tid);
    stage_store(sa, lds, tid); stage_store(sb, lds + TILE_BYTES, tid); __syncthreads();
    stage_load(sa, P, rowbase + 128, h, tid); stage_load(sb, P, rowbase + 192, h, tid);
    for (int i = 0; i < NP; ++i) {
        LAS char* cur = lds + (i & 1) * (2 * TILE_BYTES); LAS char* nxt = lds + ((i + 1) & 1) * (2 * TILE_BYTES);
        const int nv = myNT - 2 * i;
        if (i == 0) attn_tile2<true>(cur, cur + TILE_BYTES, nv, qf, mrun, lrun, o0, o1, negm, lane);
        else if (nv >= 1) attn_tile2<false>(cur, cur + TILE_BYTES, nv, qf, mrun, lrun, o0, o1, negm, lane);
        if (i + 1 < NP) { stage_store(sa, nxt, tid); stage_store(sb, nxt + TILE_BYTES, tid); }
        __syncthreads();
        if (i + 2 < NP) { stage_load(sa, P, rowbase + (size_t)(2 * i + 4) * 64, h, tid); stage_load(sb, P, rowbase + (size_t)(2 * i + 5) * 64, h, tid); }
    }
    finalize(P, qrow, h, lrun, o0, o1, lane);
}

constexpr int LSTR = 320, STILE_BYTES = KB_BYTES + 64 * LSTR;
struct SStage { u32x4 kn, kr, c0, c1; };
__device__ __forceinline__ void sstage_load(SStage& s, const Ptrs& P, const bf16* CL, size_t krow0, int h, int tid) {
    const int row = tid >> 3, ch = tid & 7;
    s.kn = *(const u32x4*)(P.KN + (krow0 + row) * 512 + h * 64 + ch * 8);
    if (tid < 256) { const int r2 = tid >> 2, c2 = tid & 3; s.kr = *(const u32x4*)(P.KR + (krow0 + r2) * 32 + c2 * 8); }
    const int lr = tid >> 4, lc = tid & 15;
    s.c0 = *(const u32x4*)(CL + (krow0 + lr) * 128 + lc * 8);
    s.c1 = *(const u32x4*)(CL + (krow0 + 32 + lr) * 128 + lc * 8);
}
__device__ __forceinline__ void sstage_store(const SStage& s, LAS char* buf, int tid) {
    const int row = tid >> 3, ch = tid & 7;
    *(LAS u32x4*)(buf + row * KSTR + ch * 16) = s.kn;
    if (tid < 256) { const int r2 = tid >> 2, c2 = tid & 3; *(LAS u32x4*)(buf + r2 * KSTR + 128 + c2 * 16) = s.kr; }
    const int lr = tid >> 4, lc = tid & 15;
    *(LAS u32x4*)(buf + KB_BYTES + lr * LSTR + lc * 16) = s.c0;
    *(LAS u32x4*)(buf + KB_BYTES + (32 + lr) * LSTR + lc * 16) = s.c1;
}
template <bool FIRST>
__device__ __forceinline__ void attn_tile_lat(const LAS char* buf, const bf16x8 (&qf)[6], float& mrun, float& lrun, f32x16 (&ol)[4], int lane) {
    const int r32 = lane & 31, hi = lane >> 5;
    const LAS char* kp = buf + r32 * KSTR + hi * 16;
    f32x16 p0 = {}, p1 = {};
#pragma unroll
    for (int s = 0; s < 6; ++s) {
        const bf16x8 a0 = *(const LAS bf16x8*)(kp + s * 32), a1 = *(const LAS bf16x8*)(kp + 32 * KSTR + s * 32);
        p0 = __builtin_amdgcn_mfma_f32_32x32x16_bf16(a0, qf[s], p0, 0, 0, 0);
        p1 = __builtin_amdgcn_mfma_f32_32x32x16_bf16(a1, qf[s], p1, 0, 0, 0);
    }
    float mx = fmaxf(p0[0], p1[0]);
#pragma unroll
    for (int r = 1; r < 16; ++r) mx = fmaxf(mx, fmaxf(p0[r], p1[r]));
    mx = max32(mx);
    const float mnew = FIRST ? mx : fmaxf(mrun, mx);
    if (!FIRST && __any(mnew > mrun)) { const float alpha = __builtin_amdgcn_exp2f(mrun - mnew); lrun *= alpha;
#pragma unroll
        for (int cb = 0; cb < 4; ++cb) ol[cb] *= alpha; }
    mrun = mnew;
    float sum = 0.f;
#pragma unroll
    for (int r = 0; r < 16; ++r) { p0[r] = __builtin_amdgcn_exp2f(p0[r] - mnew); p1[r] = __builtin_amdgcn_exp2f(p1[r] - mnew); sum += p0[r] + p1[r]; }
    lrun += sum;
    u32x4 pw[4];
#pragma unroll
    for (int j = 0; j < 4; ++j) { pw[0][j] = pk2(p0[2 * j], p0[2 * j + 1]); pw[1][j] = pk2(p0[8 + 2 * j], p0[8 + 2 * j + 1]); pw[2][j] = pk2(p1[2 * j], p1[2 * j + 1]); pw[3][j] = pk2(p1[8 + 2 * j], p1[8 + 2 * j + 1]); }
    const LAS char* vp = buf + KB_BYTES + (4 * hi + ((lane & 15) >> 2)) * LSTR + (16 * ((lane >> 4) & 1) + 4 * (lane & 3)) * 2;
#pragma unroll
    for (int ks = 0; ks < 4; ++ks) {
        const bf16x8 pf = __builtin_bit_cast(bf16x8, pw[ks]);
#pragma unroll
        for (int cb = 0; cb < 4; ++cb) {
            const bf16x8 v = cat8(vtr(vp + ks * 16 * LSTR + cb * 64), vtr(vp + (ks * 16 + 8) * LSTR + cb * 64));
            ol[cb] = __builtin_amdgcn_mfma_f32_32x32x16_bf16(v, pf, ol[cb], 0, 0, 0);
        }
    }
}
__device__ __forceinline__ void project_v(const bf16* WkvT, int h, const f32x16 (&ol)[4], f32x16& o0, f32x16& o1, int lane) {
    const int d_lo = lane & 31, hi = lane >> 5;
    const bf16* w0 = WkvT + (size_t)(256 * (2 + (h >> 2)) + 32 * (h & 3) + d_lo) * 128 + 4 * hi;
    const bf16* w1 = w0 + (size_t)128 * 128;
    o0 = f32x16{}; o1 = f32x16{};
#pragma unroll
    for (int s = 0; s < 8; ++s) {
        const int cb = s >> 1, rb = 8 * (s & 1), c0 = 32 * cb + 16 * (s & 1);
        u32x4 bw; bw.x = pk2(ol[cb][rb], ol[cb][rb + 1]); bw.y = pk2(ol[cb][rb + 2], ol[cb][rb + 3]); bw.z = pk2(ol[cb][rb + 4], ol[cb][rb + 5]); bw.w = pk2(ol[cb][rb + 6], ol[cb][rb + 7]);
        const bf16x8 bfr = __builtin_bit_cast(bf16x8, bw);
        const u32x2 a00 = *(const u32x2*)(w0 + c0), a01 = *(const u32x2*)(w0 + c0 + 8), a10 = *(const u32x2*)(w1 + c0), a11 = *(const u32x2*)(w1 + c0 + 8);
        const bf16x8 af0 = __builtin_bit_cast(bf16x8, (u32x4){a00.x, a00.y, a01.x, a01.y}), af1 = __builtin_bit_cast(bf16x8, (u32x4){a10.x, a10.y, a11.x, a11.y});
        o0 = __builtin_amdgcn_mfma_f32_32x32x16_bf16(af0, bfr, o0, 0, 0, 0);
        o1 = __builtin_amdgcn_mfma_f32_32x32x16_bf16(af1, bfr, o1, 0, 0, 0);
    }
}

__device__ __forceinline__ void sample_unit(const Ptrs& P, const bf16* CL  , const bf16* WkvT, int b, int h, int qk, float* part, unsigned* cnt, LAS char* lds, int tid_in, int lane_in, int wid) {
    int tid = tid_in, lane = lane_in; asm volatile("" : "+v"(tid), "+v"(lane));
    const int r32 = lane & 31, hi = lane >> 5, qblk = wid & 1, ks = wid >> 1;
    const size_t qrow = (size_t)MP + b * 64 + qblk * 32 + r32;
    bf16x8 qf[6]; load_q(qf, P, qrow, h, hi);
    float mrun = 0.f, lrun = 0.f; f32x16 ol[4] = {f32x16{}, f32x16{}, f32x16{}, f32x16{}};
    const size_t cbase = (size_t)MT + (size_t)b * 4096, nbase = (size_t)MP + b * 64;
    const int t0 = 16 * qk, ntile = (qk == 3) ? 17 : 16, nit = (ntile + 3) >> 2;
    SStage st[4];
#pragma unroll
    for (int j = 0; j < 4; ++j) { sstage_load(st[j], P, CL, cbase + (size_t)(t0 + j) * 64, h, tid); }
#pragma unroll
    for (int j = 0; j < 4; ++j) { sstage_store(st[j], lds + j * STILE_BYTES, tid); }
    __syncthreads();
    for (int it = 0; it < nit; ++it) {
        const int tn = 4 * (it + 1);
#pragma unroll
        for (int j = 0; j < 4; ++j) if (tn + j < ntile) sstage_load(st[j], P, CL, (t0 + tn + j < 64) ? cbase + (size_t)(t0 + tn + j) * 64 : nbase, h, tid);
        if (it == 0) attn_tile_lat<true>(lds + ks * STILE_BYTES, qf, mrun, lrun, ol, lane);
        else if (4 * it + ks < ntile) attn_tile_lat<false>(lds + ks * STILE_BYTES, qf, mrun, lrun, ol, lane);
        __syncthreads();
#pragma unroll
        for (int j = 0; j < 4; ++j) if (tn + j < ntile) sstage_store(st[j], lds + j * STILE_BYTES, tid);
        __syncthreads();
    }
    f32x16 o0, o1; project_v(WkvT, h, ol, o0, o1, lane);
    LAS float* xs = (LAS float*)lds;
    if (ks > 0) { LAS float* s = xs + ((ks - 1) * 2 + qblk) * (34 * 64) + lane; s[0] = mrun; s[64] = lrun;
#pragma unroll
        for (int r = 0; r < 16; ++r) { s[(2 + r) * 64] = o0[r]; s[(18 + r) * 64] = o1[r]; } }
    __syncthreads();
    float* mypart = part + ((size_t)((b * 8 + h) * 4 + qk) * 2 + qblk) * (34 * 64) + lane;
    if (ks == 0) {
        float mt = mrun, mo[3];
#pragma unroll
        for (int s = 0; s < 3; ++s) { mo[s] = xs[(s * 2 + qblk) * (34 * 64) + lane]; mt = fmaxf(mt, mo[s]); }
        const float a0 = __builtin_amdgcn_exp2f(mrun - mt); lrun *= a0; o0 *= a0; o1 *= a0; mrun = mt;
#pragma unroll
        for (int s = 0; s < 3; ++s) { const LAS float* sp = xs + (s * 2 + qblk) * (34 * 64) + lane; const float as = __builtin_amdgcn_exp2f(mo[s] - mt);
            lrun += sp[64] * as;
#pragma unroll
            for (int r = 0; r < 16; ++r) { o0[r] += sp[(2 + r) * 64] * as; o1[r] += sp[(18 + r) * 64] * as; } }
        mypart[0] = mrun; mypart[64] = lrun;
#pragma unroll
        for (int r = 0; r < 16; ++r) { mypart[(2 + r) * 64] = o0[r]; mypart[(18 + r) * 64] = o1[r]; }
    }
    asm volatile("s_waitcnt vmcnt(0)" ::: "memory");
    __syncthreads();
    LAS unsigned* flag = (LAS unsigned*)(lds + 6 * 34 * 64 * 4);
    if (tid == 0) {
        __builtin_amdgcn_fence(__ATOMIC_RELEASE, "agent");
        asm volatile("s_waitcnt vmcnt(0)" ::: "memory");
        const unsigned old = __hip_atomic_fetch_add(cnt + (b * 8 + h), 1u, __ATOMIC_RELAXED, __HIP_MEMORY_SCOPE_AGENT);
        if (old == 3u) { __builtin_amdgcn_fence(__ATOMIC_ACQUIRE, "agent"); asm volatile("s_waitcnt vmcnt(0)" ::: "memory"); }
        flag[0] = (old == 3u) ? 1u : 0u;
    }
    __syncthreads();
    if (flag[0] != 0u && ks == 0) {
        float mt = mrun, mo[3]; const float* op[3];
#pragma unroll
        for (int s = 0; s < 3; ++s) { const int q2 = (qk + 1 + s) & 3; op[s] = part + ((size_t)((b * 8 + h) * 4 + q2) * 2 + qblk) * (34 * 64) + lane; mo[s] = op[s][0]; mt = fmaxf(mt, mo[s]); }
        const float a0 = __builtin_amdgcn_exp2f(mrun - mt); lrun *= a0; o0 *= a0; o1 *= a0;
#pragma unroll
        for (int s = 0; s < 3; ++s) { const float as = __builtin_amdgcn_exp2f(mo[s] - mt);
            lrun += op[s][64] * as;
#pragma unroll
            for (int r = 0; r < 16; ++r) { o0[r] += op[s][(2 + r) * 64] * as; o1[r] += op[s][(18 + r) * 64] * as; } }
        finalize(P, qrow, h, lrun, o0, o1, lane);
    }
    __syncthreads();
}

struct GmPtrs { const bf16* VN; bf16* MRG; const bf16* WsB; const float* bs; const float* gog; };
constexpr int WSTR = 272, WS_LDS = 128 * WSTR;
__device__ __forceinline__ void gmlp_wg(const GmPtrs& G, int vcu, LAS char* lds, int tid_in, int lane_in, int wave) {
    int tid = tid_in, lane = lane_in; asm volatile("" : "+v"(tid), "+v"(lane));
    const int g = vcu & 7, cs = vcu >> 3;
    { const bf16* Wg = G.WsB + (size_t)g * 128 * 128;
#pragma unroll
      for (int k = 0; k < 4; ++k) { const int idx = k * 512 + tid, r = idx >> 4, ch = idx & 15;
          const u32x4 v = *(const u32x4*)(Wg + r * 128 + ch * 8); *(LAS u32x4*)(lds + r * WSTR + ch * 16) = v; } }
    __syncthreads();
    if (wave < 4 || (wave == 4 && cs < 8)) {
        int L; size_t row0;
        if (wave < 4) { const int cidx = 4 * cs + wave; row0 = (size_t)(cidx >> 4) * 2048 + (cidx & 15) * 128; L = 128; }
        else { row0 = (size_t)MP + cs * 64; L = 64; }
        LAS char* wl = lds + WS_LDS + wave * 12288;
        const int r32 = lane & 31, hi = lane >> 5, nib = L >> 5;
        f32x16 acc[4][2];
#pragma unroll
        for (int ib = 0; ib < 4; ++ib) { acc[ib][0] = f32x16{}; acc[ib][1] = f32x16{}; }
        const LAS char* vp = wl + (8 * hi + ((lane & 15) >> 2)) * VSTR + (16 * ((lane >> 4) & 1) + 4 * (lane & 3)) * 2;
        const LAS char* wp = lds + r32 * WSTR + hi * 16;
#pragma unroll
        for (int hj = 0; hj < 2; ++hj) {
            if (hj * 64 < L) {
#pragma unroll
                for (int k = 0; k < 8; ++k) { const int idx = k * 64 + lane, r = idx >> 3, ch = idx & 7;
                    const u32x4 v = *(const u32x4*)(G.VN + (row0 + 64 * hj + r) * 512 + g * 64 + ch * 8);
                    *(LAS u32x4*)(wl + r * VSTR + ch * 16) = v; }
#pragma unroll
                for (int ib = 0; ib < 4; ++ib) {
                    if (ib < nib && (hj == 0 || ib >= 2)) {
#pragma unroll
                        for (int ks = 0; ks < 4; ++ks) {
                            const bf16x8 bfr = *(const LAS bf16x8*)(wp + 32 * ib * WSTR + (64 * hj + 16 * ks) * 2);
                            const bf16x8 a0 = cat8(vtr(vp + ks * 16 * VSTR), vtr(vp + (ks * 16 + 4) * VSTR));
                            const bf16x8 a1 = cat8(vtr(vp + ks * 16 * VSTR + 64), vtr(vp + (ks * 16 + 4) * VSTR + 64));
                            acc[ib][0] = __builtin_amdgcn_mfma_f32_32x32x16_bf16(a0, bfr, acc[ib][0], 0, 0, 0);
                            acc[ib][1] = __builtin_amdgcn_mfma_f32_32x32x16_bf16(a1, bfr, acc[ib][1], 0, 0, 0);
                        }
                    }
                }
            }
        }
#pragma unroll
        for (int ib = 0; ib < 4; ++ib) {
            if (ib < nib) {
                const int i = 32 * ib + r32; const size_t row = row0 + i; const float bsv = G.bs[g * 128 + i];
                bf16* up = G.MRG + row * 1024 + 512 + g * 64; const float* gg = G.gog + g * 64;
                u32x2 ur[4][2];
#pragma unroll
                for (int rg = 0; rg < 4; ++rg) { const int d0 = 8 * rg + 4 * hi; ur[rg][0] = *(const u32x2*)(up + d0); ur[rg][1] = *(const u32x2*)(up + 32 + d0); }
                float ss = 0.f;
#pragma unroll
                for (int rg = 0; rg < 4; ++rg) {
                    const u32x2 u0 = ur[rg][0], u1 = ur[rg][1];
                    const float ua[4] = {bflo(u0.x), bfhi(u0.x), bflo(u0.y), bfhi(u0.y)}, ub[4] = {bflo(u1.x), bfhi(u1.x), bflo(u1.y), bfhi(u1.y)};
#pragma unroll
                    for (int e = 0; e < 4; ++e) { const float x0 = ua[e] * (acc[ib][0][4 * rg + e] + bsv), x1 = ub[e] * (acc[ib][1][4 * rg + e] + bsv);
                        acc[ib][0][4 * rg + e] = x0; acc[ib][1][4 * rg + e] = x1; ss += x0 * x0 + x1 * x1; } }
                ss = sum32(ss);
                const float rn = rsq(ss * (1.0f / 64.0f) + EPS);
#pragma unroll
                for (int rg = 0; rg < 4; ++rg) { const int d0 = 8 * rg + 4 * hi;
                    const f32x4 g0 = *(const f32x4*)(gg + d0), g1 = *(const f32x4*)(gg + 32 + d0);
                    u32x2 w0, w1;
                    w0.x = pk2(acc[ib][0][4 * rg] * rn * g0[0], acc[ib][0][4 * rg + 1] * rn * g0[1]); w0.y = pk2(acc[ib][0][4 * rg + 2] * rn * g0[2], acc[ib][0][4 * rg + 3] * rn * g0[3]);
                    w1.x = pk2(acc[ib][1][4 * rg] * rn * g1[0], acc[ib][1][4 * rg + 1] * rn * g1[1]); w1.y = pk2(acc[ib][1][4 * rg + 2] * rn * g1[2], acc[ib][1][4 * rg + 3] * rn * g1[3]);
                    *(u32x2*)(up + d0) = w0; *(u32x2*)(up + 32 + d0) = w1; }
            }
        }
    }
    __syncthreads();
}
}
typedef GAS unsigned gu32;
#define RLX_AGENT __ATOMIC_RELAXED, __HIP_MEMORY_SCOPE_AGENT
#define LDS_WAIT() asm volatile("s_waitcnt lgkmcnt(0)" ::: "memory")
#define VM_WAIT() asm volatile("s_waitcnt vmcnt(0)" ::: "memory")
#define XB_TMO      128
#define XB_XCNT(j)  (256  + 64 * (j))
#define XB_XSUB(j)  (1280 + 64 * (j))
#define XB_XGEN(j)  (2304 + 64 * (j))
#define XB_TOP      3328
#define XB_TOPGEN   3392
#define XCD_BAR_WORDS 3456
#define XB_SPIN_CAP (1u << 22)

__device__ __forceinline__ unsigned xb_ld(unsigned* p)              { return __hip_atomic_load(p, __ATOMIC_RELAXED, __HIP_MEMORY_SCOPE_AGENT); }
__device__ __forceinline__ unsigned xb_add(unsigned* p, unsigned v) { return __hip_atomic_fetch_add(p, v, __ATOMIC_RELAXED, __HIP_MEMORY_SCOPE_AGENT); }
__device__ __forceinline__ unsigned xb_xcc_id() { return (unsigned)__builtin_amdgcn_s_getreg((3 << 11) | 20) & 0xFu; }
#define XB_SPIN(cond, bar) do { unsigned _sp = 0; while (cond) { __builtin_amdgcn_s_sleep(1); \
    if ((++_sp & 255u) == 0u) { if (xb_ld(&(bar)[XB_TMO])) break; if (_sp > XB_SPIN_CAP) { atomicAdd(&(bar)[XB_TMO], 1u); break; } } } } while (0)

struct XcdBarrier {
    unsigned* bar; unsigned x;
    volatile LAS unsigned* st;
};

__device__ __forceinline__ bool xb_first_thread(int wave) { unsigned z = 0u; asm volatile("" : "+v"(z)); return wave == 0 && __builtin_amdgcn_mbcnt_hi(~0u, __builtin_amdgcn_mbcnt_lo(~0u, z)) == 0u; }
__device__ __forceinline__ XcdBarrier xcd_barrier_post(unsigned* bar, volatile LAS unsigned* st, int wave) {
    XcdBarrier b; b.bar = bar; b.x = xb_xcc_id(); b.st = st;
    if (xb_first_thread(wave)) (void)xb_add(&bar[XB_XCNT(b.x)], 1u);
    return b;
}
__device__ __forceinline__ void xcd_barrier_complete(unsigned* bar, unsigned x, unsigned& nloc, unsigned& nx) {
    const unsigned G = gridDim.x * gridDim.y * gridDim.z;
    unsigned sum, cnt, mine, sp = 0u;
    for (;;) {
        sum = 0u; cnt = 0u; mine = 0u;
#pragma unroll
        for (unsigned j = 0; j < 16; ++j) { const unsigned c = xb_ld(&bar[XB_XCNT(j)]); sum += c; cnt += (c > 0u) ? 1u : 0u; mine = (j == x) ? c : mine; }
        if (sum == G) break;
        __builtin_amdgcn_s_sleep(1);
        if ((++sp & 255u) == 0u) { if (xb_ld(&bar[XB_TMO])) break; if (sp > XB_SPIN_CAP) { atomicAdd(&bar[XB_TMO], 1u); break; } }
    }
    nloc = mine > 0u ? mine : 1u; nx = cnt > 0u ? cnt : 1u;
}

__device__ __forceinline__ void xcd_barrier(const XcdBarrier& b, int wave) {
    asm volatile("s_waitcnt vmcnt(0)" ::: "memory");
    __syncthreads();
    if (xb_first_thread(wave)) {
        unsigned* bar = b.bar; const unsigned x = xb_xcc_id();
        __builtin_amdgcn_s_waitcnt(0);
        unsigned nloc = b.st[0], nx = b.st[1];
        if (nloc == 0u) { xcd_barrier_complete(bar, x, nloc, nx); b.st[0] = nloc; b.st[1] = nx; }
        const unsigned old = xb_add(&bar[XB_XSUB(x)], 1u);
        const unsigned gen = old / nloc;
        if (old + 1u == (gen + 1u) * nloc) {
            __builtin_amdgcn_fence(__ATOMIC_RELEASE, "agent");
            asm volatile("s_waitcnt vmcnt(0)" ::: "memory");
            const unsigned og = xb_add(&bar[XB_TOP], 1u);
            const unsigned tg = og / nx;
            if (og + 1u == (tg + 1u) * nx) xb_add(&bar[XB_TOPGEN], 1u);
            else XB_SPIN(xb_ld(&bar[XB_TOPGEN]) == tg, bar);
            __builtin_amdgcn_fence(__ATOMIC_ACQUIRE, "agent");
            xb_add(&bar[XB_XGEN(x)], 1u);
            asm volatile("s_waitcnt vmcnt(0)" ::: "memory");
        } else {
            XB_SPIN(xb_ld(&bar[XB_XGEN(x)]) == gen, bar);
            __builtin_amdgcn_fence(__ATOMIC_ACQUIRE, "agent");
            asm volatile("s_waitcnt vmcnt(0)" ::: "memory");
        }
    }
    __syncthreads();
}

__device__ __forceinline__ int cmap_in(int n)  {
    if (n < 416) return n; if (n < 512) return -1; if (n < 1024) return n - 96;
    const int t = (n - 1024) >> 8, p = n & 255, bj = p >> 7, wc = (p >> 5) & 3, q = p & 31; return 928 + 64 * (4 * t + wc) + 32 * bj + q; }
__device__ __forceinline__ int cmap_qup(int n) { const int t = n >> 8, p = n & 255, bj = p >> 7, wc = (p >> 5) & 3, q = p & 31;
    if (t < 2) return (4 * t + wc) * 96 + 32 * bj + q;
    return (2 * wc + bj) * 96 + 64 + 16 * ((q >> 2) & 1) + 4 * (q >> 3) + (q & 3); }
__device__ __forceinline__ int cmap_kv(int n)  { const int t = n >> 8, p = n & 255, bj = p >> 7, wc = (p >> 5) & 3, q = p & 31;
    return (t < 2) ? (4 * t + wc) * 128 + 32 * bj + q : (4 * (t - 2) + wc) * 128 + 64 + 32 * bj + q; }

template <int WHICH  , bool GAIN>
__device__ __forceinline__ void transpose_item(const float* W, const float* W2, int K, int Nsrc, const float* gain, bf16* WT, LAS float* scr, int item, int nblk, int lane) {
    (void)scr;
    const int kb = item / nblk, nb = item % nblk, k0 = 64 * kb + 8 * (lane >> 3), n0 = 32 * nb, n = n0 + 4 * (lane & 7);
    int colq; const float* srcq = W;
    if (WHICH == 0) colq = cmap_in(n); else if (WHICH == 1) colq = cmap_qup(n); else if (WHICH == 2) colq = cmap_kv(n); else if (WHICH == 3) colq = n;
    else { const int t = n >> 8, p = n & 255; if (p < 128) colq = 128 * t + p; else { colq = 128 * t + p - 128; srcq = W2; } }
    f32x4 v[8];
#pragma unroll
    for (int j = 0; j < 8; ++j) v[j] = (f32x4){0.f, 0.f, 0.f, 0.f};
    if (colq >= 0) {
#pragma unroll
        for (int j = 0; j < 8; ++j) v[j] = *(const f32x4*)(srcq + (size_t)(k0 + j) * Nsrc + colq);
        if (GAIN) { const f32x4 g0 = *(const f32x4*)(gain + k0), g1 = *(const f32x4*)(gain + k0 + 4);
#pragma unroll
            for (int j = 0; j < 4; ++j) { v[j] = v[j] * g0[j]; v[4 + j] = v[4 + j] * g1[j]; } }
    }
#pragma unroll
    for (int e = 0; e < 4; ++e) { u32x4 o; o.x = pk2(v[0][e], v[1][e]); o.y = pk2(v[2][e], v[3][e]); o.z = pk2(v[4][e], v[5][e]); o.w = pk2(v[6][e], v[7][e]);
        *(u32x4*)(WT + (size_t)(n + e) * K + k0) = o; }
}

template <int KTOT>
__device__ __forceinline__ void sample_res_gemm(const bf16* A, int lda, const bf16* Bt, float* out, bf16* XB, float* ssq, int final_f32, int task, LAS char* lds, int lane, int wave) {
    const int r32 = lane & 31, hi = lane >> 5, t0 = 64 * (task >> 5), n0 = 32 * (task & 31);
    constexpr int KW = KTOT / 8, NS = KW / 16;
    const bf16* ap = Bt + (size_t)(n0 + r32) * KTOT + wave * KW + 8 * hi;
    const bf16* b0p = A + (size_t)(MP + t0 + r32) * lda + wave * KW + 8 * hi;
    const bf16* b1p = b0p + (size_t)32 * lda;
    f32x16 acc0 = {}, acc1 = {};
#pragma unroll 11
    for (int s = 0; s < NS; ++s) {
        const bf16x8 a = *(const bf16x8*)(ap + 16 * s), b0 = *(const bf16x8*)(b0p + 16 * s), b1 = *(const bf16x8*)(b1p + 16 * s);
        acc0 = __builtin_amdgcn_mfma_f32_32x32x16_bf16(a, b0, acc0, 0, 0, 0);
        acc1 = __builtin_amdgcn_mfma_f32_32x32x16_bf16(a, b1, acc1, 0, 0, 0);
    }
    LAS float* ps = (LAS float*)lds + wave * 2048 + lane;
#pragma unroll
    for (int r = 0; r < 16; ++r) { ps[r * 64] = acc0[r]; ps[(16 + r) * 64] = acc1[r]; }
    __syncthreads();
    { const int tb = wave >> 2, ng = wave & 3; f32x4 sum = {0.f, 0.f, 0.f, 0.f};
      const LAS float* rp = (const LAS float*)lds + (tb * 16 + 4 * ng) * 64 + lane;
#pragma unroll
      for (int p = 0; p < 8; ++p)
#pragma unroll
          for (int e = 0; e < 4; ++e) sum[e] += rp[p * 2048 + e * 64];
      const size_t rs = (size_t)t0 + 32 * tb + r32;
      const int col = n0 + 8 * ng + 4 * hi;
      bf16* xp = XB + ((size_t)MP + rs) * 1024 + col; const u32x2 xw = *(const u32x2*)xp;
      const f32x4 o = (f32x4){bflo(xw.x), bfhi(xw.x), bflo(xw.y), bfhi(xw.y)} + sum;
      if (final_f32) *(f32x4*)(out + ((size_t)MP + rs) * 1024 + col) = o;
      else { u32x2 w; w.x = pk2(o[0], o[1]); w.y = pk2(o[2], o[3]); *(u32x2*)xp = w; atomicAdd(ssq + MP + rs, dot4v(o)); } }
    __syncthreads();
}

struct Args { const float* in[25]; float* out; unsigned char* ws; };
enum { I_XP = 0, I_XS, I_CCKV, I_CKR, I_GMIX, I_WIN, I_GQL, I_WQUP, I_GQN, I_GQR, I_GKVL, I_GKR, I_WKV, I_GKN, I_LNG, I_LNB, I_WS, I_BS, I_GOA, I_GOG, I_WO, I_GFFN, I_WG, I_WU, I_WD };

constexpr int I_IN = 16 * 48, I_QU = 4 * 24, I_KV = 2 * 32, I_KVG = 2 * 32, I_O = 16 * 32, I_GU = 16 * 176, I_D = 44 * 32, I_LAYER = I_IN + I_QU + I_KV + I_KVG + I_O + I_GU + I_D, I_EARLY = I_IN + I_QU + I_KV + I_KVG;
__device__ __forceinline__ void convert_items(const Args& A, unsigned char* ws, LAS float* scr, int first, int last, int widx, int nw, int lane) {
    for (int it = first + widx; it < last; it += nw) {
        const int l = it / I_LAYER; int r = it % I_LAYER; unsigned char* wb = ws + WS_W + (size_t)l * LW;
        if (r < I_IN) { transpose_item<0, true>(A.in[I_WIN] + (size_t)l * 1024 * 1440, nullptr, 1024, 1440, A.in[I_GMIX] + l * 1024, (bf16*)(wb + W_IN), scr, r, 48, lane); continue; } r -= I_IN;
        if (r < I_QU) { transpose_item<1, true>(A.in[I_WQUP] + (size_t)l * 256 * 768, nullptr, 256, 768, A.in[I_GQL] + l * 256, (bf16*)(wb + W_QUP), scr, r, 24, lane); continue; } r -= I_QU;
        if (r < I_KV) { transpose_item<2, false>(A.in[I_WKV] + (size_t)l * 128 * 1024, nullptr, 128, 1024, nullptr, (bf16*)(wb + W_KV), scr, r, 32, lane); continue; } r -= I_KV;
        if (r < I_KVG) { transpose_item<2, true>(A.in[I_WKV] + (size_t)l * 128 * 1024, nullptr, 128, 1024, A.in[I_GKVL] + l * 128, (bf16*)(ws + WS_WKVG + (size_t)l * 262144), scr, r, 32, lane); continue; } r -= I_KVG;
        if (r < I_O) { transpose_item<3, false>(A.in[I_WO] + (size_t)l * 1024 * 1024, nullptr, 1024, 1024, nullptr, (bf16*)(wb + W_O), scr, r, 32, lane); continue; } r -= I_O;
        if (r < I_GU) { transpose_item<4, true>(A.in[I_WG] + (size_t)l * 1024 * DFF, A.in[I_WU] + (size_t)l * 1024 * DFF, 1024, DFF, A.in[I_GFFN] + l * 1024, (bf16*)(wb + W_GU), scr, r, 176, lane); continue; } r -= I_GU;
        transpose_item<3, false>(A.in[I_WD] + (size_t)l * DFF * 1024, nullptr, DFF, 1024, nullptr, (bf16*)(wb + W_D), scr, r, 32, lane);
    }
}
__device__ __forceinline__ void convert_cache(const Args& A, unsigned char* ws, int l, int tix, int ntx) {
    for (int i0 = tix; i0 < MC * 16; i0 += 4 * ntx) { f32x4 a[4], b[4];
#pragma unroll
        for (int u = 0; u < 4; ++u) { const int i = i0 + u * ntx; if (i < MC * 16) { const float* s = A.in[I_CCKV] + ((size_t)l * MC + (i >> 4)) * 128 + (i & 15) * 8; a[u] = *(const f32x4*)s; b[u] = *(const f32x4*)(s + 4); } }
#pragma unroll
        for (int u = 0; u < 4; ++u) { const int i = i0 + u * ntx; if (i < MC * 16) { u32x4 o; o.x = pk2(a[u][0], a[u][1]); o.y = pk2(a[u][2], a[u][3]); o.z = pk2(b[u][0], b[u][1]); o.w = pk2(b[u][2], b[u][3]);
            *(u32x4*)(ws + WS_CKVA + (size_t)l * L_CKVA + ((size_t)(MT + (i >> 4)) * 128 + (i & 15) * 8) * 2) = o; } } }
    for (int i = tix; i < MC * 4; i += ntx) { const int r = i >> 2, c0 = (i & 3) * 8;
        const float* s = A.in[I_CKR] + ((size_t)l * MC + r) * 32 + c0; const f32x4 a = *(const f32x4*)s, b = *(const f32x4*)(s + 4);
        u32x4 o; o.x = pk2(a[0], a[1]); o.y = pk2(a[2], a[3]); o.z = pk2(b[0], b[1]); o.w = pk2(b[2], b[3]);
        *(u32x4*)(ws + WS_KR + (size_t)l * L_KR + ((size_t)(MT + r) * 32 + c0) * 2) = o; }
}
__device__ __forceinline__ void p0_prologue(const Args& A, unsigned char* ws, LAS unsigned char* lds, int vcu, int G, int wave, int lane, int tid) {
    LAS float* scr = (LAS float*)(lds + wave * 16384);
    const int gw = vcu * 8 + wave, NGW = G * 8;
#ifdef NO_DEFER
    convert_items(A, ws, scr, 0, 2 * I_LAYER, gw, NGW, lane);
#else
    convert_items(A, ws, scr, 0, I_EARLY, gw, NGW, lane);
#endif
    const int gt = vcu * 512 + tid, NGT = G * 512;
    for (int i = gt; i < 2 * 8 * 128 * 16; i += NGT) { const int l = i >> 14, rem = i & 16383, gi = rem >> 4, j0 = (rem & 15) * 8, ii = gi & 127;
        const float* s = A.in[I_WS] + (size_t)l * 131072 + (size_t)gi * 128 + j0; const bool vis = (ii >> 6) >= (j0 >> 6);
        const f32x4 a = *(const f32x4*)s, b = *(const f32x4*)(s + 4);
        u32x4 o; o.x = pk2(a[0], a[1]); o.y = pk2(a[2], a[3]); o.z = pk2(b[0], b[1]); o.w = pk2(b[2], b[3]); if (!vis) o = (u32x4){0u, 0u, 0u, 0u};
        *(u32x4*)(ws + WS_W + (size_t)l * LW + W_S + ((size_t)gi * 128 + j0) * 2) = o; }
#ifdef NO_DEFER
    convert_cache(A, ws, 0, gt, NGT); convert_cache(A, ws, 1, gt, NGT);
#endif
    for (int i = gt; i < 2112 * 16; i += NGT) { const int pi = i >> 4, j = i & 15; const int pos = pi < 2048 ? pi : 4096 + (pi - 2048);
        const float inv = __builtin_amdgcn_exp2f(-(float)j * (13.287712379549449f / 16.0f)); const float ang = (float)pos * inv;
        const double t = (double)ang * 0.15915494309189535; const float fr = (float)(t - __builtin_rint(t));
        f32x2 cs; cs.x = __builtin_amdgcn_cosf(fr); cs.y = __builtin_amdgcn_sinf(fr);
        *(f32x2*)(ws + WS_ROPE + (size_t)i * 8) = cs; }
    bf16* XB = (bf16*)(ws + B_XB); float* ssq0 = (float*)(ws + WS_CTL + CTL_SSQ);
    for (int mp = gw; mp < MT / 2; mp += NGW) {
        f32x4 v[2][4];
#pragma unroll
        for (int u = 0; u < 2; ++u) { const int m = 2 * mp + u; const float* xr = (m < MP) ? A.in[I_XP] + (size_t)m * 1024 : A.in[I_XS] + (size_t)(m - MP) * 1024;
#pragma unroll
            for (int j = 0; j < 4; ++j) v[u][j] = *(const f32x4*)(xr + 256 * j + 4 * lane); }
#pragma unroll
        for (int u = 0; u < 2; ++u) { const int m = 2 * mp + u; float s = 0.f;
#pragma unroll
            for (int j = 0; j < 4; ++j) { s += dot4v(v[u][j]); u32x2 w; w.x = pk2(v[u][j][0], v[u][j][1]); w.y = pk2(v[u][j][2], v[u][j][3]); *(u32x2*)(XB + (size_t)m * 1024 + 256 * j + 4 * lane) = w; }
            s = wave_sum(s); if (lane == 0) ssq0[m] = s; } }
}

struct P2Ptrs { const bf16* Z; bf16* MRG; bf16* CKVA; bf16* KR; bf16* VN; const float* rope; float* out;
                const float* gql; const float* gkvl; const float* gkr; const float* lng; const float* lnb; };
__device__ __forceinline__ void p2_row(const P2Ptrs& P, int l, int m, int lane) {
    const bf16* z = P.Z + (size_t)m * NZ;
    const unsigned cw = *(const unsigned*)(z + 256 + 2 * lane);
    float k1 = 0.f, k2 = 0.f; if (lane < 16) { k1 = __uint_as_float((unsigned)z[384 + lane] << 16); k2 = __uint_as_float((unsigned)z[400 + lane] << 16); }
    const bool smp = m >= MP; const int ms = m - MP; const int posidx = smp ? 2048 + (ms & 63) : (m & 2047);
    { const float c0 = bflo(cw), c1 = bfhi(cw); const float ss = wave_sum(c0 * c0 + c1 * c1); const float rn = rsq(ss * (1.0f / 128.0f) + EPS);
      const f32x2 g = *(const f32x2*)(P.gkvl + 2 * lane); f32x2 y; y.x = c0 * rn * g.x; y.y = c1 * rn * g.y;
      float* o = smp ? P.out + O_CKVS + ((size_t)l * MS + ms) * 128 : P.out + O_CKVP + ((size_t)l * MP + m) * 128;
      *(f32x2*)(o + 2 * lane) = y; if (smp) *(unsigned*)(P.CKVA + (size_t)m * 128 + 2 * lane) = pk2(y.x, y.y); }
    { const float ss = wave_sum(k1 * k1 + k2 * k2); const float rn = rsq(ss * (1.0f / 32.0f) + EPS);
      if (lane < 16) { const float a = k1 * rn * P.gkr[lane], b = k2 * rn * P.gkr[16 + lane]; const f32x2 cs = *(const f32x2*)(P.rope + (size_t)(posidx * 16 + lane) * 2);
          const float o1 = a * cs.x - b * cs.y, o2 = a * cs.y + b * cs.x;
          float* o = smp ? P.out + O_KRS + ((size_t)l * MS + ms) * 32 : P.out + O_KRP + ((size_t)l * MP + m) * 32;
          o[lane] = o1; o[16 + lane] = o2;
          bf16* kb = P.KR + (size_t)m * 32; kb[lane] = (bf16)(pk2(o1, 0.f) & 0xffffu); kb[16 + lane] = (bf16)(pk2(o2, 0.f) & 0xffffu); } }
}

#ifndef REP_P0
#define REP_P0 1
#endif
#ifndef REP_P1
#define REP_P1 1
#endif
#ifndef REP_P2
#define REP_P2 1
#endif
#ifndef REP_P3
#define REP_P3 1
#endif
#ifndef REP_P4A
#define REP_P4A 1
#endif
#ifndef REP_P4B
#define REP_P4B 1
#endif
#ifndef REP_P6
#define REP_P6 1
#endif
#ifndef REP_BAR
#define REP_BAR 1
#endif
template <class T> __device__ __forceinline__ T* as_global(T* p) {
#if defined(__HIP_DEVICE_COMPILE__)
    __builtin_assume(!__builtin_amdgcn_is_shared((const __attribute__((address_space(0))) void*)p));
    __builtin_assume(!__builtin_amdgcn_is_private((const __attribute__((address_space(0))) void*)p));
#endif
    return p;
}
#define FRESH_TID() unsigned z_p = 0u; asm volatile("" : "+v"(z_p)); const int lane_p = (int)__builtin_amdgcn_mbcnt_hi(~0u, __builtin_amdgcn_mbcnt_lo(~0u, z_p)); const int tid_p = wave * 64 + lane_p
#define FRESH_PTRS() size_t zo_p = 0; asm volatile("" : "+s"(zo_p)); \
    unsigned char* ws = args.ws + zo_p; float* out = args.out + zo_p;     \
    int G = gridDim.x, bx = blockIdx.x; asm volatile("" : "+s"(G), "+s"(bx)); const int vcu = (G % 8 == 0) ? (bx % 8) * (G / 8) + bx / 8 : bx; (void)vcu; (void)out
#define GRID_BAR() for (int repb_ = 0; repb_ < REP_BAR; ++repb_) do { size_t zo_b = 0; asm volatile("" : "+s"(zo_b)); unsigned char* wsb = args.ws + zo_b; XcdBarrier bar_; bar_.bar = (unsigned*)(wsb + WS_CTL) + CW_BAR; bar_.x = 0; bar_.st = (volatile LAS unsigned*)(lds + MISC_OFF) + 8; xcd_barrier(bar_, wave); } while (0)
__global__ void __launch_bounds__(512, 2) hybrid_fwd(Args args) {
    extern __shared__ __attribute__((aligned(16))) unsigned char lds_raw[];
    LAS unsigned char* lds = (LAS unsigned char*)lds_raw;
    const int wave = __builtin_amdgcn_readfirstlane(threadIdx.x >> 6);
    { FRESH_TID(); for (int u = tid_p; u < (LDS_BYTES - RING_BYTES) / 4; u += 512) ((LAS unsigned*)(lds + RING_BYTES))[u] = 0u; }
    __syncthreads();
    { FRESH_PTRS(); (void)xcd_barrier_post((unsigned*)(ws + WS_CTL) + CW_BAR, (volatile LAS unsigned*)(lds + MISC_OFF) + 8, wave); }

#ifndef NO_P0
    asm volatile("; MARK_P0");
    for (int rep_ = 0; rep_ < REP_P0; ++rep_) { FRESH_TID(); FRESH_PTRS(); p0_prologue(args, ws, lds, vcu, G, wave, lane_p, tid_p); }
#endif
    GRID_BAR();

    for (int l = 0; l < NLAYER; ++l) {
#ifndef NO_P1
        asm volatile("; MARK_P1");
        for (int rep_ = 0; rep_ < REP_P1; ++rep_) { FRESH_PTRS(); unsigned char* wb = ws + WS_W + (size_t)l * LW;
          pg8::Gemm g{(const bf16*)(ws + B_XB), (const bf16*)(wb + W_IN), MT, NZ, 1024, 1024}; pg8::StaticOrder S; S.init(MT, NZ, G, bx);
          pg8::EpiZ E{(bf16*)(ws + B_Z), (const float*)(ws + WS_CTL + CTL_SSQ) + (size_t)(2 * l) * MT, (bf16*)(ws + B_MRG), (bf16*)(ws + B_VN), out + O_GVS + (size_t)l * MS * 512, args.in[I_LNG] + l * 512, args.in[I_LNB] + l * 512,
                      (float*)(ws + WS_CTL + CTL_SSQQ) + (size_t)l * MT, (float*)(ws + WS_CTL + CTL_SSQC) + (size_t)l * MT};
          pg8::gemm_phase<pg8::EpiZ, pg8::StaticOrder, true, true>(lds, g, S, E, wave);
          if (l == 1 && bx >= 140) {
              pg8::Gemm g3{(const bf16*)(ws + WS_CKVA + (size_t)l * L_CKVA) + (size_t)MT * 128, (const bf16*)(wb + W_KV), MC, 512, 128, 128}; pg8::StaticOrder S3; S3.init(MC, 512, G - 140, bx - 140);
              pg8::EpiKV E3{(bf16*)(ws + B_KN) + (size_t)MT * 512, (bf16*)(ws + B_VV) + (size_t)MT * 512, args.in[I_GKN] + l * 64, nullptr};
              pg8::gemm_phase<pg8::EpiKV, pg8::StaticOrder, true, true>(lds, g3, S3, E3, wave); }
#ifndef NO_DEFER
          if (l == 0 && bx >= 140) { FRESH_TID(); convert_items(args, ws, (LAS float*)(lds + wave * 16384), I_EARLY, I_LAYER, (bx - 140) * 8 + wave, (G - 140) * 8, lane_p);
                                     convert_cache(args, ws, 0, (bx - 140) * 512 + tid_p, (G - 140) * 512); }
#endif
          }
#endif
        GRID_BAR();
#ifndef NO_P3
        asm volatile("; MARK_P3");
        { FRESH_TID(); FRESH_PTRS();
          P2Ptrs P{(const bf16*)(ws + B_Z), (bf16*)(ws + B_MRG), (bf16*)(ws + WS_CKVA + (size_t)l * L_CKVA), (bf16*)(ws + WS_KR + (size_t)l * L_KR), (bf16*)(ws + B_VN), (const float*)(ws + WS_ROPE), out,
                   args.in[I_GQL] + l * 256, args.in[I_GKVL] + l * 128, args.in[I_GKR] + l * 32, args.in[I_LNG] + l * 512, args.in[I_LNB] + l * 512};
          const int gw = vcu * 8 + wave, NGW = G * 8;
          for (int mp = gw; mp < MT / 2; mp += NGW) { p2_row(P, l, 2 * mp, lane_p); p2_row(P, l, 2 * mp + 1, lane_p); } }
        { FRESH_PTRS(); unsigned char* wb = ws + WS_W + (size_t)l * LW;
          pg8::Gemm g{(const bf16*)(ws + B_Z), (const bf16*)(wb + W_QUP), MT, 768, 256, NZ}; pg8::StaticOrder S; S.init(MT, 768, G, bx);
          pg8::EpiQ E{(bf16*)(ws + B_QNP), (bf16*)(ws + B_QRP), args.in[I_GQN] + l * 64, args.in[I_GQR] + l * 32, (const float*)(ws + WS_ROPE), (const float*)(ws + WS_CTL + CTL_SSQQ) + (size_t)l * MT};
          pg8::gemm_phase<pg8::EpiQ, pg8::StaticOrder, true, true>(lds, g, S, E, wave); }
        asm volatile("; MARK_P3B");
        { FRESH_PTRS();
          pg8::Gemm g{(const bf16*)(ws + B_Z) + 256, (const bf16*)(ws + WS_WKVG + (size_t)l * 262144), MT, 1024, 128, NZ}; pg8::StaticOrder S; S.init(MT, 1024, G, (bx + 58) % G);
          pg8::EpiKV E{(bf16*)(ws + B_KN), (bf16*)(ws + B_VV), args.in[I_GKN] + l * 64, (const float*)(ws + WS_CTL + CTL_SSQC) + (size_t)l * MT};
          pg8::gemm_phase<pg8::EpiKV, pg8::StaticOrder, true, true>(lds, g, S, E, wave); }
        if (l == 0) { FRESH_PTRS(); unsigned char* wb = ws + WS_W + (size_t)l * LW;
          pg8::Gemm g{(const bf16*)(ws + WS_CKVA + (size_t)l * L_CKVA) + (size_t)MT * 128, (const bf16*)(wb + W_KV), MC, 512, 128, 128}; pg8::StaticOrder S; S.init(MC, 512, G, bx);
          pg8::EpiKV E{(bf16*)(ws + B_KN) + (size_t)MT * 512, (bf16*)(ws + B_VV) + (size_t)MT * 512, args.in[I_GKN] + l * 64, nullptr};
          pg8::gemm_phase<pg8::EpiKV, pg8::StaticOrder, true, true>(lds, g, S, E, wave); }
#endif
        GRID_BAR();
#ifndef NO_P4
        asm volatile("; MARK_P4");
        { FRESH_TID(); FRESH_PTRS();
          att::Ptrs P{(const bf16*)(ws + B_QNP), (const bf16*)(ws + B_QRP), (const bf16*)(ws + B_KN), (const bf16*)(ws + B_VV), (const bf16*)(ws + WS_KR + (size_t)l * L_KR), (bf16*)(ws + B_MRG), args.in[I_GOA] + l * 512};
          const int bh = vcu >> 2, s = vcu & 3;
          const int par = bh & 1;
          if (par) att::sample_unit(P, (const bf16*)(ws + WS_CKVA + (size_t)l * L_CKVA), (const bf16*)(ws + WS_W + (size_t)l * LW + W_KV), vcu >> 5, (vcu >> 2) & 7, vcu & 3, (float*)(ws + WS_PART), (unsigned*)(ws + WS_CTL + CTL_SCNT) + l * 64, (LAS char*)lds, tid_p, lane_p, wave);
          att::prompt_unit(P, bh >> 3, bh & 7, 7 - s, (LAS char*)lds, tid_p, lane_p, wave);
          att::prompt_unit(P, bh >> 3, bh & 7, s, (LAS char*)lds, tid_p, lane_p, wave);
          if (!par) att::sample_unit(P, (const bf16*)(ws + WS_CKVA + (size_t)l * L_CKVA), (const bf16*)(ws + WS_W + (size_t)l * LW + W_KV), vcu >> 5, (vcu >> 2) & 7, vcu & 3, (float*)(ws + WS_PART), (unsigned*)(ws + WS_CTL + CTL_SCNT) + l * 64, (LAS char*)lds, tid_p, lane_p, wave);
#ifndef NO_P4C
          asm volatile("; MARK_P4C");
          { att::GmPtrs Gm{(const bf16*)(ws + B_VN), (bf16*)(ws + B_MRG), (const bf16*)(ws + WS_W + (size_t)l * LW + W_S), args.in[I_BS] + l * 1024, args.in[I_GOG] + l * 512};
                 att::gmlp_wg(Gm, vcu, (LAS char*)lds, tid_p, lane_p, wave); }
#endif
        }
#endif
        GRID_BAR();
#ifndef NO_P5
        asm volatile("; MARK_P5");
        { FRESH_PTRS(); unsigned char* wb = ws + WS_W + (size_t)l * LW;
          pg8::Gemm g{(const bf16*)(ws + B_MRG), (const bf16*)(wb + W_O), MP, 1024, 1024, 1024}; pg8::StaticOrder S; S.init(MP, 1024, G, bx);
          pg8::EpiRes E{out, (bf16*)(ws + B_XB), (float*)(ws + WS_CTL + CTL_SSQ) + (size_t)(2 * l + 1) * MT, 0};
          pg8::gemm_phase<pg8::EpiRes, pg8::StaticOrder, true, true>(lds, g, S, E, wave);
          { FRESH_TID(); if (vcu < 256) sample_res_gemm<1024>((const bf16*)(ws + B_MRG), 1024, (const bf16*)(wb + W_O), out, E.XB, E.ssq, 0, vcu, (LAS char*)lds, lane_p, wave); } }
#endif
        GRID_BAR();
#ifndef NO_P6
        asm volatile("; MARK_P6");
        for (int rep_ = 0; rep_ < REP_P6; ++rep_) { FRESH_PTRS(); unsigned char* wb = ws + WS_W + (size_t)l * LW;
          pg8::Gemm g{(const bf16*)(ws + B_XB), (const bf16*)(wb + W_GU), MT, NGU, 1024, 1024}; pg8::StaticOrder S; S.init(MT, NGU, G, bx);
          pg8::EpiGU E{(bf16*)(ws + B_H), (const float*)(ws + WS_CTL + CTL_SSQ) + (size_t)(2 * l + 1) * MT};
#ifdef PROBE_SPLIT6
          S.i1 = 3; pg8::gemm_phase<pg8::EpiGU, pg8::StaticOrder, true, true>(lds, g, S, E, wave); GRID_BAR(); S.i0 = 3; S.i1 = 1 << 20;
#endif
          pg8::gemm_phase<pg8::EpiGU, pg8::StaticOrder, true, true>(lds, g, S, E, wave);
#ifndef NO_DEFER
          if (l == 0 && bx >= 172) { FRESH_TID(); convert_items(args, ws, (LAS float*)(lds + wave * 16384), I_LAYER, 2 * I_LAYER, (bx - 172) * 8 + wave, (G - 172) * 8, lane_p);
                                     convert_cache(args, ws, 1, (bx - 172) * 512 + tid_p, (G - 172) * 512); }
#endif
          }
#endif
        GRID_BAR();
#ifndef NO_P7
        asm volatile("; MARK_P7");
        { FRESH_PTRS(); unsigned char* wb = ws + WS_W + (size_t)l * LW;
          pg8::Gemm g{(const bf16*)(ws + B_H), (const bf16*)(wb + W_D), MP, 1024, DFF, DFF}; pg8::StaticOrder S; S.init(MP, 1024, G, bx);
          pg8::EpiRes E{out, (bf16*)(ws + B_XB), (float*)(ws + WS_CTL + CTL_SSQ) + (size_t)(2 * l + 2) * MT, l == NLAYER - 1 ? 1 : 0};
          pg8::gemm_phase<pg8::EpiRes, pg8::StaticOrder, true, true>(lds, g, S, E, wave);
          { FRESH_TID(); if (vcu < 256) sample_res_gemm<DFF>((const bf16*)(ws + B_H), DFF, (const bf16*)(wb + W_D), out, E.XB, E.ssq, E.final_f32, vcu, (LAS char*)lds, lane_p, wave); } }
#endif
        if (l + 1 < NLAYER) GRID_BAR();
    }
}

extern "C" void kernel_launch(void* const* d_in, const int* in_sizes, int n_in, void* d_out, int out_size, void* d_ws, size_t ws_size, hipStream_t stream) {
    static int grid = 0;
    if (grid == 0) {
        #ifdef PROBE_WSMIN
        if (ws_size < (size_t)PROBE_WSMIN * MiB) { grid = -1; return; }
#endif
        if (n_in != 25 || (size_t)out_size != O_END || ws_size < WS_END) { fprintf(stderr, "kernel_launch: unexpected shapes (n_in %d, out %d, ws %zu); nothing launched\n", n_in, out_size, ws_size); grid = -1; return; }
        int dev = 0, cus = 0, per_cu = 0;
        if (hipGetDevice(&dev) != hipSuccess || hipDeviceGetAttribute(&cus, hipDeviceAttributeMultiprocessorCount, dev) != hipSuccess) { grid = -1; return; }
        if (hipFuncSetAttribute((const void*)hybrid_fwd, hipFuncAttributeMaxDynamicSharedMemorySize, LDS_BYTES) != hipSuccess) { fprintf(stderr, "kernel_launch: hipFuncSetAttribute failed\n"); grid = -1; return; }
        if (hipOccupancyMaxActiveBlocksPerMultiprocessor(&per_cu, (const void*)hybrid_fwd, 512, LDS_BYTES) != hipSuccess || per_cu < 1) { fprintf(stderr, "kernel_launch: occupancy query reports %d blocks per CU\n", per_cu); (void)hipGetLastError(); grid = -1; return; }
        if (cus < 256) { fprintf(stderr, "kernel_launch: built for a 256-CU device (found %d CUs); nothing launched\n", cus); grid = -1; return; }
        grid = 256;
    }
    if (grid < 0) return;
    if (hipMemsetAsync((char*)d_ws + WS_CTL, 0, CTL_ZERO_BYTES, stream) != hipSuccess) return;
    Args a{};
    for (int i = 0; i < 25; ++i) a.in[i] = (const float*)d_in[i];
    a.out = (float*)d_out; a.ws = (unsigned char*)d_ws;
    hipLaunchKernelGGL(hybrid_fwd, dim3(grid), dim3(512), LDS_BYTES, stream, a);
}
```

```cpp
#include <hip/hip_runtime.h>
#include <cstdio>
#include <cstdint>

#define LAS __attribute__((address_space(3)))
#define GAS __attribute__((address_space(1)))
typedef unsigned short bf16;
typedef short bf16x8 __attribute__((ext_vector_type(8)));
typedef short s16x4 __attribute__((ext_vector_type(4)));
typedef float f32x4 __attribute__((ext_vector_type(4)));
typedef float f32x2 __attribute__((ext_vector_type(2)));
typedef float f32x16 __attribute__((ext_vector_type(16)));
typedef unsigned u32x4 __attribute__((ext_vector_type(4)));
typedef unsigned u32x2 __attribute__((ext_vector_type(2)));
typedef __bf16 bf16x2_t __attribute__((ext_vector_type(2)));

constexpr int DM = 1024, MP = 16384, MS = 512, MT = MP + MS  , MC = 32768  , MA = MT + MC;
constexpr int NZ = 1536, DFF = 2816, NGU = 5632;
constexpr int NLAYER = 2;
constexpr float EPS = 1e-6f;
constexpr float QSCALE = 0.10206207261596577f * 1.4426950408889634f;

constexpr size_t O_Y = 0, O_CKVP = (size_t)MT * 1024, O_KRP = O_CKVP + (size_t)2 * MP * 128, O_CKVS = O_KRP + (size_t)2 * MP * 32,
                 O_KRS = O_CKVS + (size_t)2 * MS * 128, O_GVS = O_KRS + (size_t)2 * MS * 32, O_END = O_GVS + (size_t)2 * MS * 512;

constexpr size_t MiB = 1u << 20;
constexpr size_t WS_CTL = 0, CTL_ZERO_BYTES = 1 * MiB;
constexpr int CW_BAR = 4096;
constexpr size_t CTL_SSQ = 65536;
constexpr size_t WS_W = 1 * MiB, LW = 23461888;
constexpr size_t W_IN = 0, W_QUP = 3145728, W_KV = W_QUP + 393216, W_O = W_KV + 262144, W_GU = W_O + 2097152, W_D = W_GU + 11534336, W_S = W_D + 5767168;
static_assert(W_S + 262144 == LW, "weight block");
constexpr size_t WS_CKVA = WS_W + 2 * LW, L_CKVA = (size_t)MA * 128 * 2;
constexpr size_t WS_KR = WS_CKVA + 2 * L_CKVA, L_KR = (size_t)MA * 32 * 2;
constexpr size_t WS_ROPE = WS_KR + 2 * L_KR;
constexpr size_t WS_PART = 153 * MiB / 2, PART_BYTES = (size_t)64 * 4 * 2 * 34 * 64 * 4;
constexpr size_t WS_BIG = 324 * MiB / 4 - MiB / 4;
constexpr size_t CTL_SCNT = 32768;
constexpr size_t CTL_CNT5 = 49152;
constexpr size_t CTL_CNT1 = 57600;
constexpr size_t CTL_CNT6 = 36864;
constexpr size_t CTL_SSQQ = 524288, CTL_SSQC = CTL_SSQQ + 2 * (size_t)MT * 4;
constexpr size_t B_KN = WS_BIG, B_VV = B_KN + (size_t)MA * 512 * 2, B_QNP = B_VV + (size_t)MA * 512 * 2, B_QRP = B_QNP + (size_t)MT * 512 * 2,
                 B_VN = B_QRP + (size_t)MT * 256 * 2, B_MRG = B_VN + (size_t)MT * 512 * 2, B_MRG_END = B_MRG + (size_t)MT * 1024 * 2;
constexpr size_t B_H = WS_BIG, B_H_END = B_H + (size_t)MT * DFF * 2;
static_assert(B_H_END <= B_VN, "H must end below VN / MRG");
constexpr size_t B_XB = 256 * MiB;
constexpr size_t WS_WKVG = B_XB + (size_t)MT * 2048;
constexpr size_t B_Z = WS_WKVG + 2 * 262144;
constexpr size_t WS_END = B_Z + (size_t)MT * NZ * 2;
static_assert(WS_ROPE + 2112 * 16 * 8 <= WS_PART && WS_PART + PART_BYTES <= WS_BIG && WS_BIG % 65536 == 0 && WS_PART % 65536 == 0, "ws map 1");
static_assert(B_MRG_END <= B_XB && B_H_END <= B_XB && B_XB + (size_t)MT * 2048 <= WS_END, "ws map 2");
static_assert(B_Z >= B_XB + (size_t)MT * 2048, "Z above XB");
static_assert(CTL_SSQ + 5 * (size_t)MT * 4 <= CTL_SSQQ && CTL_SSQC + 2 * (size_t)MT * 4 <= CTL_ZERO_BYTES, "ssq arrays inside the memset region");

constexpr int RING_BYTES = 131072, LDS_BYTES = 147456, MISC_OFF = LDS_BYTES - 256;

__device__ __forceinline__ unsigned pk2(float lo, float hi) { f32x2 v = {lo, hi}; bf16x2_t b = __builtin_convertvector(v, bf16x2_t); return __builtin_bit_cast(unsigned, b); }
__device__ __forceinline__ float bflo(unsigned w) { return __uint_as_float(w << 16); }
__device__ __forceinline__ float bfhi(unsigned w) { return __uint_as_float(w & 0xffff0000u); }
#define SWZ_XOR(v, m) __int_as_float(__builtin_amdgcn_ds_swizzle(__float_as_int(v), ((m) << 10) | 0x1f))
__device__ __forceinline__ float sum16(float v) { return v + __int_as_float(__builtin_amdgcn_ds_swizzle(__float_as_int(v), 0x401F)); }
__device__ __forceinline__ float sum32(float v) { auto r = __builtin_amdgcn_permlane32_swap(__float_as_uint(v), __float_as_uint(v), false, false); return __uint_as_float(r[0]) + __uint_as_float(r[1]); }
__device__ __forceinline__ float max32(float v) { auto r = __builtin_amdgcn_permlane32_swap(__float_as_uint(v), __float_as_uint(v), false, false); return fmaxf(__uint_as_float(r[0]), __uint_as_float(r[1])); }
__device__ __forceinline__ float sum8(float v) { v += SWZ_XOR(v, 1); v += SWZ_XOR(v, 2); v += SWZ_XOR(v, 4); return v; }
__device__ __forceinline__ float wave_sum(float v) { v = sum8(v); v += SWZ_XOR(v, 8); v += SWZ_XOR(v, 16); return sum32(v); }
__device__ __forceinline__ float dot4v(const f32x4 a) { return (a[0] * a[0] + a[1] * a[1]) + (a[2] * a[2] + a[3] * a[3]); }
__device__ __forceinline__ float rsq(float x) { return __builtin_amdgcn_rsqf(x); }
__device__ __forceinline__ float gelu_tanh(float x) {
    const float u2 = 1.5957691216057308f * (x + 0.044715f * x * x * x);
    return x * __builtin_amdgcn_rcpf(1.0f + __builtin_amdgcn_exp2f(-1.4426950408889634f * u2));
}
__device__ __forceinline__ float silu_f(float x) { return x * __builtin_amdgcn_rcpf(1.0f + __builtin_amdgcn_exp2f(-1.4426950408889634f * x)); }
#ifndef NO_WT
__device__ __forceinline__ void st16wt(const void* base, void* p, u32x4 v) {
    __builtin_amdgcn_raw_buffer_store_b128(v, __builtin_amdgcn_make_buffer_rsrc((void*)base, 0, 0x7fffffff, 0x00027000), (int)((const char*)p - (const char*)base), 0, 0x11);
}
__device__ __forceinline__ void st8wt(const void* base, void* p, f32x2 v) {
    __builtin_amdgcn_raw_buffer_store_b64(__builtin_bit_cast(u32x2, v), __builtin_amdgcn_make_buffer_rsrc((void*)base, 0, 0x7fffffff, 0x00027000), (int)((const char*)p - (const char*)base), 0, 0x11);
}
__device__ __forceinline__ void st8wtu(const void* base, void* p, u32x2 v) { st8wt(base, p, __builtin_bit_cast(f32x2, v)); }
#else
__device__ __forceinline__ void st8wtu(const void* base, void* p, u32x2 v) { (void)base; *(u32x2*)p = v; }
__device__ __forceinline__ void st16wt(const void* base, void* p, u32x4 v) { (void)base; *(u32x4*)p = v; }
__device__ __forceinline__ void st8wt(const void* base, void* p, f32x2 v) { (void)base; *(f32x2*)p = v; }
#endif
#ifdef WT_ALL
#define st16pl st16wt
#else
__device__ __forceinline__ void st16pl(const void* base, void* p, u32x4 v) { (void)base; *(u32x4*)p = v; }
#endif
namespace pg8 {
#define PG8_LAS __attribute__((address_space(3)))
typedef unsigned short bf16_t;
constexpr int BM = 256, BK = 64, HALF = 128, HTB = HALF * BK * 2  , STAGE_BYTES = 8 * HTB, NXCD = 8, WGM = 8;

__host__ __device__ __forceinline__ int lds_byte(int r, int c) { const int st = (r >> 4) * 2 + (c >> 5), rr = r & 15, cc = c & 31, ob = rr * 64 + cc * 2; return st * 1024 + (ob ^ (((ob >> 9) & 1) << 5)); }
__host__ __device__ __forceinline__ void stage_rc(int b, int& R, int& C) { const int st = b / 1024, sb = b % 1024, swz = sb ^ (((sb >> 9) & 1) << 5); R = (st >> 1) * 16 + swz / 64; C = (st & 1) * 32 + (swz % 64) / 2; }
__host__ __device__ __forceinline__ int perm32(int rho) { const int n = rho >> 4, i = rho & 15; return 8 * (i >> 2) + 4 * n + (i & 3); }

struct Unit { int pm, pn; };
struct Gemm { const bf16_t* A; const bf16_t* Bt; int M, N, K, lda; };

struct StaticOrder {
    int nM, nN, nwg, G, c, i0 = 0, i1 = 1 << 20;
    __host__ __device__ __forceinline__ void init(int M, int N, int G_, int c_) { nM = M / BM; nN = N / BM; nwg = nM * nN; G = G_; c = c_; }
    __host__ __device__ __forceinline__ bool next(int i_, Unit& u) const {
        const int i = i_ + i0; if (i >= i1) return false;
        const long L = (long)i * G + c; if (L >= nwg) return false;
        int wgid = (int)L; { const int q = nwg / NXCD, r = nwg % NXCD, xcd = wgid % NXCD, off = wgid / NXCD; wgid = (xcd < r ? xcd * (q + 1) : r * (q + 1) + (xcd - r) * q) + off; }
        const int nig = WGM * nN, gid = wgid / nig, fm = gid * WGM, gsz = (nM - fm) < WGM ? (nM - fm) : WGM;
        u.pm = fm + ((wgid % nig) % gsz); u.pn = (wgid % nig) / gsz; return true;
    }
    __device__ __forceinline__ void a_ready(const Unit&) const {}
    __device__ __forceinline__ void done(const Unit&) const {}
};
__device__ __forceinline__ float dot4(const f32x4 a) { return (a[0] * a[0] + a[1] * a[1]) + (a[2] * a[2] + a[3] * a[3]); }

struct EpiZ {
    static constexpr bool PERM = true, AFTER_DRAIN = false;
    bf16_t* Z; const float* ssq; bf16_t* MRG; bf16_t* VN; float* gvs; const float* lng; const float* lnb; float* ssqQ; float* ssqC; const unsigned char* wsb; int wtz;
    __device__ __forceinline__ void operator()(const f32x4 (&acc)[2][2][4][2], const Unit& u, int wr, int wc, int fr_, int fq_) const {
        unsigned z_e = 0u; asm volatile("" : "+v"(z_e)); const int lane_e = (int)__builtin_amdgcn_mbcnt_hi(~0u, __builtin_amdgcn_mbcnt_lo(~0u, z_e)), fr = lane_e & 15, fq = lane_e >> 4; (void)fr_; (void)fq_;
        const int row0 = u.pm * BM + wr * 64 + fr;
        float rs[2][4];
#pragma unroll
        for (int ai = 0; ai < 2; ++ai)
#pragma unroll
            for (int m = 0; m < 4; ++m) rs[ai][m] = ssq[row0 + ai * HALF + m * 16];
        if (u.pn < 4) {
            bf16_t* dst; int ld;
            if (u.pn < 2) { dst = Z + u.pn * BM + wc * 32 + 8 * fq; ld = NZ; } else { dst = MRG + 512 + (u.pn - 2) * BM + wc * 32 + 8 * fq; ld = 1024; }
            const bool act = u.pn >= 2;
#pragma unroll
            for (int ai = 0; ai < 2; ++ai)
#pragma unroll
                for (int m = 0; m < 4; ++m) { const int row = row0 + ai * HALF + m * 16; const float r = rsq(rs[ai][m] * (1.0f / 1024.0f) + EPS); float sq = 0.f;
                    bf16_t* rowp = dst + (size_t)row * ld;
#pragma unroll
                    for (int bj = 0; bj < 2; ++bj) { f32x4 v0 = acc[ai][bj][m][0] * r, v1 = acc[ai][bj][m][1] * r;
                        if (act) {
#pragma unroll
                            for (int e = 0; e < 4; ++e) { v0[e] = gelu_tanh(v0[e]); v1[e] = gelu_tanh(v1[e]); } }
                        u32x4 w; w.x = pk2(v0[0], v0[1]); w.y = pk2(v0[2], v0[3]); w.z = pk2(v1[0], v1[1]); w.w = pk2(v1[2], v1[3]);
                        if (wtz && u.pn < 2) st16wt(wsb, rowp + bj * HALF, w); else st16pl(wsb, rowp + bj * HALF, w);
                        if (!act && (u.pn == 0 || bj == 0)) sq += dot4(v0) + dot4(v1); }
                    if (!act) { sq = sum32(sum16(sq)); if (fq == 0) atomicAdd((u.pn == 0 ? ssqQ : ssqC) + row, sq); }
                    __builtin_amdgcn_sched_barrier(0); }
        } else {
            const int grp = 4 * (u.pn - 4) + wc;
            f32x4 gg[2][2], gb[2][2];
#pragma unroll
            for (int bj = 0; bj < 2; ++bj)
#pragma unroll
                for (int n = 0; n < 2; ++n) { gg[bj][n] = *(const f32x4*)(lng + grp * 64 + 32 * bj + 8 * fq + 4 * n); gb[bj][n] = *(const f32x4*)(lnb + grp * 64 + 32 * bj + 8 * fq + 4 * n); }
#pragma unroll
            for (int ai = 0; ai < 2; ++ai)
#pragma unroll
                for (int m = 0; m < 4; ++m) { const int row = row0 + ai * HALF + m * 16; const float r = rsq(rs[ai][m] * (1.0f / 1024.0f) + EPS);
                    f32x4 y[2][2]; float s = 0.f;
#pragma unroll
                    for (int bj = 0; bj < 2; ++bj)
#pragma unroll
                        for (int n = 0; n < 2; ++n) { const f32x4 a = acc[ai][bj][m][n] * r;
#pragma unroll
                            for (int e = 0; e < 4; ++e) { y[bj][n][e] = gelu_tanh(a[e]); s += y[bj][n][e]; } }
                    s = sum32(sum16(s)); const float mean = s * (1.0f / 64.0f); float s2 = 0.f;
#pragma unroll
                    for (int bj = 0; bj < 2; ++bj)
#pragma unroll
                        for (int n = 0; n < 2; ++n) { y[bj][n] = y[bj][n] - mean; s2 += dot4(y[bj][n]); }
                    s2 = sum32(sum16(s2)); const float rstd = rsq(s2 * (1.0f / 64.0f) + EPS);
#pragma unroll
                    for (int bj = 0; bj < 2; ++bj) { const f32x4 o0 = y[bj][0] * rstd * gg[bj][0] + gb[bj][0], o1 = y[bj][1] * rstd * gg[bj][1] + gb[bj][1];
                        u32x4 w; w.x = pk2(o0[0], o0[1]); w.y = pk2(o0[2], o0[3]); w.z = pk2(o1[0], o1[1]); w.w = pk2(o1[2], o1[3]);
                        st16pl(wsb, VN + (size_t)row * 512 + grp * 64 + 32 * bj + 8 * fq, w);
                        if (row >= MP) { float* op = gvs + (size_t)(row - MP) * 512 + grp * 64 + 32 * bj + 8 * fq; *(f32x4*)op = o0; *(f32x4*)(op + 4) = o1; } }
                    __builtin_amdgcn_sched_barrier(0); }
        }
    }
};

struct EpiGU {
    static constexpr bool PERM = true, AFTER_DRAIN = false;
    bf16_t* H; const float* ssq; const unsigned char* wsb;
    __device__ __forceinline__ void operator()(const f32x4 (&acc)[2][2][4][2], const Unit& u, int wr, int wc, int fr_, int fq_) const {
        unsigned z_e = 0u; asm volatile("" : "+v"(z_e)); const int lane_e = (int)__builtin_amdgcn_mbcnt_hi(~0u, __builtin_amdgcn_mbcnt_lo(~0u, z_e)), fr = lane_e & 15, fq = lane_e >> 4; (void)fr_; (void)fq_;
        const int row0 = u.pm * BM + wr * 64 + fr, colh = u.pn * HALF + wc * 32 + 8 * fq;
        float rs[2][4];
#pragma unroll
        for (int ai = 0; ai < 2; ++ai)
#pragma unroll
            for (int m = 0; m < 4; ++m) rs[ai][m] = ssq[row0 + ai * HALF + m * 16];
#pragma unroll
        for (int ai = 0; ai < 2; ++ai)
#pragma unroll
            for (int m = 0; m < 4; ++m) { const int row = row0 + ai * HALF + m * 16; const float r = rsq(rs[ai][m] * (1.0f / 1024.0f) + EPS);
                const f32x4 g0 = acc[ai][0][m][0] * r, g1 = acc[ai][0][m][1] * r, u0 = acc[ai][1][m][0] * r, u1 = acc[ai][1][m][1] * r;
                f32x4 h0, h1;
#pragma unroll
                for (int e = 0; e < 4; ++e) { h0[e] = silu_f(g0[e]) * u0[e]; h1[e] = silu_f(g1[e]) * u1[e]; }
                u32x4 w; w.x = pk2(h0[0], h0[1]); w.y = pk2(h0[2], h0[3]); w.z = pk2(h1[0], h1[1]); w.w = pk2(h1[2], h1[3]);
                st16wt(wsb, H + (size_t)row * DFF + colh, w); }
    }
};

struct EpiRes {
    static constexpr bool PERM = true, AFTER_DRAIN = false;
    float* out; bf16_t* XB; float* ssq; int final_f32; const unsigned char* wsb; int wt;
    __device__ __forceinline__ void operator()(const f32x4 (&acc)[2][2][4][2], const Unit& u, int wr, int wc, int fr_, int fq_) const {
        unsigned z_e = 0u; asm volatile("" : "+v"(z_e)); const int lane_e = (int)__builtin_amdgcn_mbcnt_hi(~0u, __builtin_amdgcn_mbcnt_lo(~0u, z_e)), fr = lane_e & 15, fq = lane_e >> 4; (void)fr_; (void)fq_;
        const int col0 = u.pn * BM + wc * 32 + 8 * fq;
#pragma unroll
        for (int ai = 0; ai < 2; ++ai)
#pragma unroll
            for (int m = 0; m < 4; ++m) { const size_t row = (size_t)u.pm * BM + ai * HALF + wr * 64 + m * 16 + fr; float ss = 0.f;
#pragma unroll
                for (int bj = 0; bj < 2; ++bj) { bf16_t* xp = XB + row * 1024 + col0 + bj * HALF;
                    const u32x4 xw = *(const u32x4*)xp;
                    const f32x4 o0 = (f32x4){bflo(xw.x), bfhi(xw.x), bflo(xw.y), bfhi(xw.y)} + acc[ai][bj][m][0], o1 = (f32x4){bflo(xw.z), bfhi(xw.z), bflo(xw.w), bfhi(xw.w)} + acc[ai][bj][m][1];
                    if (final_f32) { float* op = out + row * 1024 + col0 + bj * HALF; *(f32x4*)op = o0; *(f32x4*)(op + 4) = o1; }
                    else { u32x4 w; w.x = pk2(o0[0], o0[1]); w.y = pk2(o0[2], o0[3]); w.z = pk2(o1[0], o1[1]); w.w = pk2(o1[2], o1[3]); if (wt) st16wt(wsb, xp, w); else st16pl(wsb, xp, w); ss += dot4(o0) + dot4(o1); } }
                if (!final_f32) { ss = sum32(sum16(ss)); if (fq == 0) atomicAdd(ssq + row, ss); }
                if (m & 1) asm volatile("" ::: "memory"); }
    }
};

struct EpiQ {
    static constexpr bool PERM = true, AFTER_DRAIN = false;
    bf16_t* QNP; bf16_t* QRP; const float* gqn; const float* gqr; const float* rope; const float* ssqQ; const unsigned char* wsb;
    __device__ __forceinline__ void operator()(const f32x4 (&acc)[2][2][4][2], const Unit& u, int wr, int wc, int fr_, int fq_) const {
        unsigned z_e = 0u; asm volatile("" : "+v"(z_e)); const int lane_e = (int)__builtin_amdgcn_mbcnt_hi(~0u, __builtin_amdgcn_mbcnt_lo(~0u, z_e)), fr = lane_e & 15, fq = lane_e >> 4; (void)fr_; (void)fq_;
        const int row0 = u.pm * BM + wr * 64 + fr;
        float rq[2][4];
#pragma unroll
        for (int ai = 0; ai < 2; ++ai)
#pragma unroll
            for (int m = 0; m < 4; ++m) rq[ai][m] = ssqQ[row0 + ai * HALF + m * 16];
#pragma unroll
        for (int ai = 0; ai < 2; ++ai)
#pragma unroll
            for (int m = 0; m < 4; ++m) rq[ai][m] = rsq(rq[ai][m] * (1.0f / 256.0f) + EPS);
        if (u.pn < 2) {
            const int head = 4 * u.pn + wc;
            f32x4 gv[2][2];
#pragma unroll
            for (int bj = 0; bj < 2; ++bj)
#pragma unroll
                for (int n = 0; n < 2; ++n) gv[bj][n] = *(const f32x4*)(gqn + 32 * bj + 8 * fq + 4 * n) * QSCALE;
#pragma unroll
            for (int ai = 0; ai < 2; ++ai)
#pragma unroll
                for (int m = 0; m < 4; ++m) { const int row = row0 + ai * HALF + m * 16;
                    float ss = (dot4(acc[ai][0][m][0]) + dot4(acc[ai][0][m][1])) + (dot4(acc[ai][1][m][0]) + dot4(acc[ai][1][m][1]));
                    ss = sum32(sum16(ss)) * (rq[ai][m] * rq[ai][m]);
                    const float rn = rsq(ss * (1.0f / 64.0f) + EPS) * rq[ai][m];
#pragma unroll
                    for (int bj = 0; bj < 2; ++bj) { const f32x4 v0 = acc[ai][bj][m][0] * gv[bj][0] * rn, v1 = acc[ai][bj][m][1] * gv[bj][1] * rn;
                        u32x4 w; w.x = pk2(v0[0], v0[1]); w.y = pk2(v0[2], v0[3]); w.z = pk2(v1[0], v1[1]); w.w = pk2(v1[2], v1[3]);
                        st16pl(wsb, QNP + (size_t)row * 512 + head * 64 + 32 * bj + 8 * fq, w); }  __builtin_amdgcn_sched_barrier(0); }
        } else {
            const f32x4 g1 = *(const f32x4*)(gqr + 4 * fq) * QSCALE, g2 = *(const f32x4*)(gqr + 16 + 4 * fq) * QSCALE;
#pragma unroll
            for (int ai = 0; ai < 2; ++ai)
#pragma unroll
                for (int m = 0; m < 4; ++m) { const int row = row0 + ai * HALF + m * 16;
                    const int posidx = row < MP ? (row & 2047) : 2048 + ((row - MP) & 63);
                    const float* rp = rope + (size_t)(posidx * 16 + 4 * fq) * 2;
                    const f32x4 cs0 = *(const f32x4*)rp, cs1 = *(const f32x4*)(rp + 4);
                    const f32x4 cc = {cs0[0], cs0[2], cs1[0], cs1[2]}, sn = {cs0[1], cs0[3], cs1[1], cs1[3]};
#pragma unroll
                    for (int bj = 0; bj < 2; ++bj) { const f32x4 x1 = acc[ai][bj][m][0], x2 = acc[ai][bj][m][1];
                        float ss = dot4(x1) + dot4(x2); ss = sum32(sum16(ss)) * (rq[ai][m] * rq[ai][m]);
                        const float rn = rsq(ss * (1.0f / 32.0f) + EPS) * rq[ai][m];
                        const f32x4 a = x1 * g1 * rn, b = x2 * g2 * rn;
                        const f32x4 o1 = a * cc - b * sn, o2 = a * sn + b * cc;
                        const int head = 2 * wc + bj;
                        u32x2 w1, w2; w1.x = pk2(o1[0], o1[1]); w1.y = pk2(o1[2], o1[3]); w2.x = pk2(o2[0], o2[1]); w2.y = pk2(o2[2], o2[3]);
                        bf16_t* qp = QRP + (size_t)row * 256 + head * 32 + 4 * fq;
                        *(u32x2*)qp = w1; *(u32x2*)(qp + 16) = w2; }  __builtin_amdgcn_sched_barrier(0); }
        }
    }
};

struct EpiKV {
    static constexpr bool PERM = true, AFTER_DRAIN = false;
    bf16_t* KN; bf16_t* VV; const float* gkn; const float* ssqC; const unsigned char* wsb;
    __device__ __forceinline__ void operator()(const f32x4 (&acc)[2][2][4][2], const Unit& u, int wr, int wc, int fr_, int fq_) const {
        unsigned z_e = 0u; asm volatile("" : "+v"(z_e)); const int lane_e = (int)__builtin_amdgcn_mbcnt_hi(~0u, __builtin_amdgcn_mbcnt_lo(~0u, z_e)), fr = lane_e & 15, fq = lane_e >> 4; (void)fr_; (void)fq_;
        const int row0 = u.pm * BM + wr * 64 + fr;
        float rc[2][4];
#pragma unroll
        for (int ai = 0; ai < 2; ++ai)
#pragma unroll
            for (int m = 0; m < 4; ++m) rc[ai][m] = ssqC ? ssqC[row0 + ai * HALF + m * 16] : 0.f;
#pragma unroll
        for (int ai = 0; ai < 2; ++ai)
#pragma unroll
            for (int m = 0; m < 4; ++m) rc[ai][m] = ssqC ? rsq(rc[ai][m] * (1.0f / 128.0f) + EPS) : 1.0f;
        if (u.pn < 2) {
            const int head = 4 * u.pn + wc;
            f32x4 gv[2][2];
#pragma unroll
            for (int bj = 0; bj < 2; ++bj)
#pragma unroll
                for (int n = 0; n < 2; ++n) gv[bj][n] = *(const f32x4*)(gkn + 32 * bj + 8 * fq + 4 * n);
#pragma unroll
            for (int ai = 0; ai < 2; ++ai)
#pragma unroll
                for (int m = 0; m < 4; ++m) { const int row = row0 + ai * HALF + m * 16;
                    float ss = (dot4(acc[ai][0][m][0]) + dot4(acc[ai][0][m][1])) + (dot4(acc[ai][1][m][0]) + dot4(acc[ai][1][m][1]));
                    ss = sum32(sum16(ss)) * (rc[ai][m] * rc[ai][m]);
                    const float rn = rsq(ss * (1.0f / 64.0f) + EPS) * rc[ai][m];
#pragma unroll
                    for (int bj = 0; bj < 2; ++bj) { const f32x4 v0 = acc[ai][bj][m][0] * gv[bj][0] * rn, v1 = acc[ai][bj][m][1] * gv[bj][1] * rn;
                        u32x4 w; w.x = pk2(v0[0], v0[1]); w.y = pk2(v0[2], v0[3]); w.z = pk2(v1[0], v1[1]); w.w = pk2(v1[2], v1[3]);
                        st16pl(wsb, KN + (size_t)row * 512 + head * 64 + 32 * bj + 8 * fq, w); }  __builtin_amdgcn_sched_barrier(0); }
        } else {
            const int head = 4 * (u.pn - 2) + wc;
#pragma unroll
            for (int ai = 0; ai < 2; ++ai)
#pragma unroll
                for (int m = 0; m < 4; ++m) { const int row = row0 + ai * HALF + m * 16;
#pragma unroll
                    for (int bj = 0; bj < 2; ++bj) { const f32x4 v0 = acc[ai][bj][m][0] * rc[ai][m], v1 = acc[ai][bj][m][1] * rc[ai][m];
                        u32x4 w; w.x = pk2(v0[0], v0[1]); w.y = pk2(v0[2], v0[3]); w.z = pk2(v1[0], v1[1]); w.w = pk2(v1[2], v1[3]);
                        st16pl(wsb, VV + (size_t)row * 512 + head * 64 + 32 * bj + 8 * fq, w); }  __builtin_amdgcn_sched_barrier(0); }
        }
    }
};

template <class Epi, class Sched, bool ALIGN_EPI = false, bool SP2 = false>
__device__ __forceinline__ void gemm_phase(PG8_LAS unsigned char* lds, const Gemm g, const Sched& S, const Epi& E, const int wid_in) {
    int wid = wid_in; asm volatile("" : "+s"(wid));
    unsigned z_ = 0u; asm volatile("" : "+v"(z_)); const int lane_ = (int)__builtin_amdgcn_mbcnt_hi(~0u, __builtin_amdgcn_mbcnt_lo(~0u, z_));
    const int lane = lane_, tid = wid * 64 + lane, wr = wid >> 2, wc = wid & 3, fr = lane & 15, fq = lane >> 4;
    const int K = g.K, nt = K / BK;
    unsigned voffA[2], voffB[2];
#pragma unroll
    for (int i = 0; i < 2; ++i) { int R, C; stage_rc(tid * 16 + i * 8192, R, C); const int Rb = Epi::PERM ? ((R & ~31) + perm32(R & 31)) : R;
        voffA[i] = (unsigned)(R * g.lda + C) * 2u; voffB[i] = (unsigned)(Rb * K + C) * 2u; }
    const size_t kstep = (size_t)(BK * 2);
    const size_t hstepA = (size_t)HALF * g.lda * 2, hstepB = (size_t)HALF * K * 2;
    const size_t tstepA = 2 * hstepA, tstepB = 2 * hstepB;
    const unsigned ldsw = (unsigned)wid * 1024u;
    const int aoff = lds_byte(wr * 64 + fr, fq * 8), boff = lds_byte(wc * 32 + fr, fq * 8);
#define PG8_SA(b, h) (((b) * 2 + (h)) * HTB)
#define PG8_SB(b, h) ((4 + (b) * 2 + (h)) * HTB)
#define PG8_STAGE(bufoff, gbase, voff) do { _Pragma("unroll") for (int _i = 0; _i < 2; ++_i) \
        __builtin_amdgcn_global_load_lds((const unsigned*)((const char*)(gbase) + (voff)[_i]), (PG8_LAS unsigned*)(lds + (bufoff) + ldsw + _i * 8192), 16, 0, 0); } while (0)
#define PG8_LDA(dst, b, h) do { _Pragma("unroll") for (int m = 0; m < 4; ++m) _Pragma("unroll") for (int k = 0; k < 2; ++k) dst[m][k] = *(const PG8_LAS bf16x8*)(lds + PG8_SA(b, h) + aoff + m * 2048 + k * 1024); } while (0)
#define PG8_LDB(dst, b, h) do { _Pragma("unroll") for (int n = 0; n < 2; ++n) _Pragma("unroll") for (int k = 0; k < 2; ++k) dst[n][k] = *(const PG8_LAS bf16x8*)(lds + PG8_SB(b, h) + boff + n * 2048 + k * 1024); } while (0)
#define PG8_MMA(ai, bj, At, Bt) do { __builtin_amdgcn_s_setprio(1); _Pragma("unroll") for (int m = 0; m < 4; ++m) _Pragma("unroll") for (int n = 0; n < 2; ++n) _Pragma("unroll") for (int k = 0; k < 2; ++k) \
        acc[ai][bj][m][n] = __builtin_amdgcn_mfma_f32_16x16x32_bf16(Bt[n][k], At[m][k], acc[ai][bj][m][n], 0, 0, 0); __builtin_amdgcn_s_setprio(0); } while (0)
#define PG8_WAIT_V(n) asm volatile("s_waitcnt vmcnt(" #n ")" ::: "memory")
#define PG8_WAIT_L(n) asm volatile("s_waitcnt lgkmcnt(" #n ")" ::: "memory")
#define PG8_BAR __builtin_amdgcn_s_barrier()
#define PG8_SCHED __builtin_amdgcn_sched_barrier(0)
    Unit cur, nxt; int ui = 0;
    if (!S.next(0, cur)) return;
    f32x4 acc[2][2][4][2];
#pragma unroll
    for (int a = 0; a < 2; ++a)
#pragma unroll
        for (int b = 0; b < 2; ++b)
#pragma unroll
            for (int m = 0; m < 4; ++m)
#pragma unroll
                for (int n = 0; n < 2; ++n) acc[a][b][m][n] = (f32x4){0.f, 0.f, 0.f, 0.f};
    bf16x8 At[4][2], B0[2][2], B1[2][2];
    const char* cA = (const char*)g.A + (size_t)cur.pm * tstepA; const char* cB = (const char*)g.Bt + (size_t)cur.pn * tstepB;
    S.a_ready(cur);
    if constexpr (SP2) {
        PG8_STAGE(PG8_SB(0, 0), cB, voffB); PG8_STAGE(PG8_SB(0, 1), cB + hstepB, voffB); PG8_STAGE(PG8_SA(0, 0), cA, voffA); PG8_STAGE(PG8_SA(0, 1), cA + hstepA, voffA);
        if (wr == 1) PG8_BAR;
        PG8_WAIT_V(2); PG8_BAR;
        PG8_STAGE(PG8_SB(1, 0), cB + kstep, voffB); PG8_STAGE(PG8_SA(1, 0), cA + kstep, voffA); PG8_STAGE(PG8_SB(1, 1), cB + hstepB + kstep, voffB);
        PG8_WAIT_V(6); PG8_BAR;
    } else {
        PG8_STAGE(PG8_SB(0, 0), cB, voffB); PG8_STAGE(PG8_SA(0, 0), cA, voffA); PG8_STAGE(PG8_SB(0, 1), cB + hstepB, voffB); PG8_STAGE(PG8_SA(0, 1), cA + hstepA, voffA);
        if (wr == 1) PG8_BAR;
        PG8_WAIT_V(4); PG8_BAR;
        PG8_STAGE(PG8_SB(1, 0), cB + kstep, voffB); PG8_STAGE(PG8_SA(1, 0), cA + kstep, voffA); PG8_STAGE(PG8_SB(1, 1), cB + hstepB + kstep, voffB);
        PG8_WAIT_V(6); PG8_BAR;
    }
    for (;;) {
        const bool has_next = S.next(ui + 1, nxt);
        const char* nA = has_next ? (const char*)g.A + (size_t)nxt.pm * tstepA : cA; const char* nB = has_next ? (const char*)g.Bt + (size_t)nxt.pn * tstepB : cB;
        for (int t = 0; t < nt; t += 2) {
            const bool last = (t == nt - 2);
            const char* a1 = cA + (size_t)(t + 1) * kstep;
            const char* a2 = last ? nA : cA + (size_t)(t + 2) * kstep; const char* b2 = last ? nB : cB + (size_t)(t + 2) * kstep;
            const char* a3 = a2 + kstep; const char* b3 = b2 + kstep;
            if (last && has_next) S.a_ready(nxt);
            if constexpr (SP2) {
            PG8_LDB(B0, 0, 0); PG8_LDB(B1, 0, 1); PG8_SCHED; PG8_LDA(At, 0, 0); PG8_STAGE(PG8_SA(1, 1), a1 + hstepA, voffA);
            PG8_WAIT_V(8); PG8_WAIT_L(0); PG8_BAR; PG8_MMA(0, 0, At, B0); PG8_MMA(0, 1, At, B1); PG8_BAR; PG8_SCHED;
            PG8_LDA(At, 0, 1); PG8_STAGE(PG8_SB(0, 0), b2, voffB); PG8_STAGE(PG8_SB(0, 1), b2 + hstepB, voffB); PG8_STAGE(PG8_SA(0, 0), a2, voffA);
            PG8_WAIT_V(8); PG8_WAIT_L(0); PG8_BAR; PG8_MMA(1, 0, At, B0); PG8_MMA(1, 1, At, B1); PG8_BAR; PG8_SCHED;
            PG8_LDB(B0, 1, 0); PG8_LDB(B1, 1, 1); PG8_SCHED; PG8_LDA(At, 1, 0); PG8_STAGE(PG8_SA(0, 1), a2 + hstepA, voffA);
            PG8_WAIT_V(8); PG8_WAIT_L(0); PG8_BAR; PG8_MMA(0, 0, At, B0); PG8_MMA(0, 1, At, B1); PG8_BAR; PG8_SCHED;
            PG8_LDA(At, 1, 1); PG8_STAGE(PG8_SB(1, 0), b3, voffB); PG8_STAGE(PG8_SB(1, 1), b3 + hstepB, voffB); PG8_STAGE(PG8_SA(1, 0), a3, voffA);
            PG8_WAIT_V(8); PG8_WAIT_L(0); PG8_BAR; PG8_MMA(1, 0, At, B0); PG8_MMA(1, 1, At, B1); PG8_BAR; PG8_SCHED;
            } else {
            PG8_LDB(B0, 0, 0); PG8_SCHED; PG8_LDA(At, 0, 0); PG8_STAGE(PG8_SA(1, 1), a1 + hstepA, voffA);
            PG8_WAIT_L(8); PG8_BAR; PG8_WAIT_L(0); PG8_MMA(0, 0, At, B0); PG8_BAR; PG8_SCHED;
            PG8_LDB(B1, 0, 1); PG8_STAGE(PG8_SB(0, 0), b2, voffB);
            PG8_BAR; PG8_WAIT_L(0); PG8_MMA(0, 1, At, B1); PG8_BAR;
            PG8_LDA(At, 0, 1); PG8_STAGE(PG8_SA(0, 0), a2, voffA);
            PG8_BAR; PG8_WAIT_L(0); PG8_MMA(1, 0, At, B0); PG8_BAR; PG8_SCHED;
            PG8_STAGE(PG8_SB(0, 1), b2 + hstepB, voffB);
            PG8_WAIT_V(6); PG8_BAR; PG8_MMA(1, 1, At, B1); PG8_BAR;
            PG8_LDB(B0, 1, 0); PG8_SCHED; PG8_LDA(At, 1, 0); PG8_STAGE(PG8_SA(0, 1), a2 + hstepA, voffA);
            PG8_WAIT_L(8); PG8_BAR; PG8_WAIT_L(0); PG8_MMA(0, 0, At, B0); PG8_BAR; PG8_SCHED;
            PG8_LDB(B1, 1, 1); PG8_STAGE(PG8_SB(1, 0), b3, voffB);
            PG8_BAR; PG8_WAIT_L(0); PG8_MMA(0, 1, At, B1); PG8_BAR;
            PG8_LDA(At, 1, 1); PG8_STAGE(PG8_SA(1, 0), a3, voffA);
            PG8_BAR; PG8_WAIT_L(0); PG8_MMA(1, 0, At, B0); PG8_BAR; PG8_SCHED;
            PG8_STAGE(PG8_SB(1, 1), b3 + hstepB, voffB);
            PG8_WAIT_V(6); PG8_BAR; PG8_MMA(1, 1, At, B1); PG8_BAR;
            }
        }
        if constexpr (ALIGN_EPI) { if (wr == 0) PG8_BAR; }
        if constexpr (!Epi::AFTER_DRAIN) { E(acc, cur, wr, wc, fr, fq); S.done(cur); }
        if (!has_next) break;
#pragma unroll
        for (int a = 0; a < 2; ++a)
#pragma unroll
            for (int b = 0; b < 2; ++b)
#pragma unroll
                for (int m = 0; m < 4; ++m)
#pragma unroll
                    for (int n = 0; n < 2; ++n) acc[a][b][m][n] = (f32x4){0.f, 0.f, 0.f, 0.f};
        cur = nxt; cA = nA; cB = nB; ++ui;
        if constexpr (ALIGN_EPI) { if (wr == 1) PG8_BAR; }
    }
    PG8_WAIT_V(0);
    if constexpr (!ALIGN_EPI) { if (wr == 0) PG8_BAR; }
    PG8_BAR;
    if constexpr (Epi::AFTER_DRAIN) { E.fused(acc, cur, wr, wc, fr, fq, lds, wid, lane); S.done(cur); }
#undef PG8_SA
#undef PG8_SB
#undef PG8_STAGE
#undef PG8_LDA
#undef PG8_LDB
#undef PG8_MMA
#undef PG8_WAIT_V
#undef PG8_WAIT_L
#undef PG8_BAR
#undef PG8_SCHED
}
}
namespace att {
constexpr int KSTR = 208, VSTR = 192, KB_BYTES = 64 * KSTR, VB_BYTES = 64 * VSTR, TILE_BYTES = KB_BYTES + VB_BYTES;
typedef short v4i16_t __attribute__((ext_vector_type(4)));
__device__ __forceinline__ s16x4 vtr(const LAS char* p) { return __builtin_bit_cast(s16x4, __builtin_amdgcn_ds_read_tr16_b64_v4i16((LAS v4i16_t*)p)); }
__device__ __forceinline__ bf16x8 cat8(s16x4 lo, s16x4 hi) { return (bf16x8){lo[0], lo[1], lo[2], lo[3], hi[0], hi[1], hi[2], hi[3]}; }

struct Ptrs { const bf16* QNP; const bf16* QRP; const bf16* KN; const bf16* VV; const bf16* KR; bf16* MRG; const float* gout; };
struct Stage { u32x4 kn, kr, vv; };

__device__ __forceinline__ void stage_load(Stage& s, const Ptrs& P, size_t krow0, int h, int tid) {
    const int row = tid >> 3, ch = tid & 7;
    s.kn = *(const u32x4*)(P.KN + (krow0 + row) * 512 + h * 64 + ch * 8);
    s.vv = *(const u32x4*)(P.VV + (krow0 + row) * 512 + h * 64 + ch * 8);
    if (tid < 256) { const int r2 = tid >> 2, c2 = tid & 3; s.kr = *(const u32x4*)(P.KR + (krow0 + r2) * 32 + c2 * 8); }
}
__device__ __forceinline__ void stage_store(const Stage& s, LAS char* buf, int tid) {
    const int row = tid >> 3, ch = tid & 7;
    *(LAS u32x4*)(buf + row * KSTR + ch * 16) = s.kn;
    *(LAS u32x4*)(buf + KB_BYTES + row * VSTR + ch * 16) = s.vv;
    if (tid < 256) { const int r2 = tid >> 2, c2 = tid & 3; *(LAS u32x4*)(buf + r2 * KSTR + 128 + c2 * 16) = s.kr; }
}
__device__ __forceinline__ void load_q(bf16x8 (&qf)[6], const Ptrs& P, size_t qrow, int h, int hi) {
#pragma unroll
    for (int s = 0; s < 4; ++s) qf[s] = *(const bf16x8*)(P.QNP + qrow * 512 + h * 64 + 16 * s + 8 * hi);
#pragma unroll
    for (int s = 0; s < 2; ++s) qf[4 + s] = *(const bf16x8*)(P.QRP + qrow * 256 + h * 32 + 16 * s + 8 * hi);
}

template <bool FIRST>
__device__ __forceinline__ void attn_tile(const LAS char* buf, const bf16x8 (&qf)[6], float& mrun, float& lrun, f32x16& o0, f32x16& o1, f32x16& negm, int lane) {
    const int r32 = lane & 31, hi = lane >> 5;
    const LAS char* kp = buf + r32 * KSTR + hi * 16;
    f32x16 p0, p1;
    { const bf16x8 a0 = *(const LAS bf16x8*)(kp), a1 = *(const LAS bf16x8*)(kp + 32 * KSTR);
      if (FIRST) { const f32x16 z = {}; p0 = __builtin_amdgcn_mfma_f32_32x32x16_bf16(a0, qf[0], z, 0, 0, 0); p1 = __builtin_amdgcn_mfma_f32_32x32x16_bf16(a1, qf[0], z, 0, 0, 0); }
      else { p0 = __builtin_amdgcn_mfma_f32_32x32x16_bf16(a0, qf[0], negm, 0, 0, 0); p1 = __builtin_amdgcn_mfma_f32_32x32x16_bf16(a1, qf[0], negm, 0, 0, 0); } }
#pragma unroll
    for (int s = 1; s < 6; ++s) {
        const bf16x8 a0 = *(const LAS bf16x8*)(kp + s * 32), a1 = *(const LAS bf16x8*)(kp + 32 * KSTR + s * 32);
        p0 = __builtin_amdgcn_mfma_f32_32x32x16_bf16(a0, qf[s], p0, 0, 0, 0);
        p1 = __builtin_amdgcn_mfma_f32_32x32x16_bf16(a1, qf[s], p1, 0, 0, 0);
    }
    float mx = fmaxf(p0[0], p1[0]);
#pragma unroll
    for (int r = 1; r < 16; ++r) mx = fmaxf(mx, fmaxf(p0[r], p1[r]));
    mx = max32(mx);
    if (FIRST) {
        mrun = mx;
#pragma unroll
        for (int r = 0; r < 16; ++r) { p0[r] -= mx; p1[r] -= mx; negm[r] = -mx; }
    } else if (__any(mx > 6.0f)) {
        const float dl = fmaxf(mx, 0.f), alpha = __builtin_amdgcn_exp2f(-dl);
        mrun += dl; lrun *= alpha;
#pragma unroll
        for (int r = 0; r < 16; ++r) { p0[r] -= dl; p1[r] -= dl; negm[r] = -mrun; }
        o0 *= alpha; o1 *= alpha;
    }
    float sum = 0.f;
#pragma unroll
    for (int r = 0; r < 16; ++r) { p0[r] = __builtin_amdgcn_exp2f(p0[r]); p1[r] = __builtin_amdgcn_exp2f(p1[r]); sum += p0[r] + p1[r]; }
    lrun += sum;
    u32x4 pw[4];
#pragma unroll
    for (int j = 0; j < 4; ++j) { pw[0][j] = pk2(p0[2 * j], p0[2 * j + 1]); pw[1][j] = pk2(p0[8 + 2 * j], p0[8 + 2 * j + 1]); pw[2][j] = pk2(p1[2 * j], p1[2 * j + 1]); pw[3][j] = pk2(p1[8 + 2 * j], p1[8 + 2 * j + 1]); }
    const LAS char* vp = buf + KB_BYTES + (4 * hi + ((lane & 15) >> 2)) * VSTR + (16 * ((lane >> 4) & 1) + 4 * (lane & 3)) * 2;
#pragma unroll
    for (int ks = 0; ks < 4; ++ks) {
        const bf16x8 pf = __builtin_bit_cast(bf16x8, pw[ks]);
        const bf16x8 v0 = cat8(vtr(vp + ks * 16 * VSTR), vtr(vp + (ks * 16 + 8) * VSTR));
        const bf16x8 v1 = cat8(vtr(vp + ks * 16 * VSTR + 64), vtr(vp + (ks * 16 + 8) * VSTR + 64));
        o0 = __builtin_amdgcn_mfma_f32_32x32x16_bf16(v0, pf, o0, 0, 0, 0);
        o1 = __builtin_amdgcn_mfma_f32_32x32x16_bf16(v1, pf, o1, 0, 0, 0);
    }
}

__device__ __forceinline__ void finalize(const Ptrs& P, size_t qrow, int h, float lrun, f32x16& o0, f32x16& o1, int lane) {
    const int hi = lane >> 5;
    const float l = sum32(lrun), inv = 1.0f / l;
    o0 *= inv; o1 *= inv;
    float ss = 0.f;
#pragma unroll
    for (int r = 0; r < 16; ++r) ss += o0[r] * o0[r] + o1[r] * o1[r];
    ss = sum32(ss);
    const float rn = rsq(ss * (1.0f / 64.0f) + EPS);
    bf16* op = P.MRG + qrow * 1024 + h * 64;
#pragma unroll
    for (int rg = 0; rg < 4; ++rg) { const int d0 = 8 * rg + 4 * hi;
        u32x2 w0, w1;
        w0.x = pk2(o0[4 * rg] * rn, o0[4 * rg + 1] * rn); w0.y = pk2(o0[4 * rg + 2] * rn, o0[4 * rg + 3] * rn);
        w1.x = pk2(o1[4 * rg] * rn, o1[4 * rg + 1] * rn); w1.y = pk2(o1[4 * rg + 2] * rn, o1[4 * rg + 3] * rn);
        *(u32x2*)(op + d0) = w0; *(u32x2*)(op + 32 + d0) = w1; }
}

template <bool FIRST>
__device__ __forceinline__ void attn_tile2(const LAS char* bufA, const LAS char* bufB, int nv, const bf16x8 (&qf)[6], float& mrun, float& lrun, f32x16& o0, f32x16& o1, f32x16& negm, int lane) {
    const int r32 = lane & 31, hi = lane >> 5;
    const LAS char* kpa = bufA + r32 * KSTR + hi * 16; const LAS char* kpb = bufB + r32 * KSTR + hi * 16;
    f32x16 p0, p1, p2, p3;
    { const bf16x8 a0 = *(const LAS bf16x8*)(kpa), a1 = *(const LAS bf16x8*)(kpa + 32 * KSTR), a2 = *(const LAS bf16x8*)(kpb), a3 = *(const LAS bf16x8*)(kpb + 32 * KSTR);
      if (FIRST) { const f32x16 z = {}; p0 = __builtin_amdgcn_mfma_f32_32x32x16_bf16(a0, qf[0], z, 0, 0, 0); p1 = __builtin_amdgcn_mfma_f32_32x32x16_bf16(a1, qf[0], z, 0, 0, 0);
                   p2 = __builtin_amdgcn_mfma_f32_32x32x16_bf16(a2, qf[0], z, 0, 0, 0); p3 = __builtin_amdgcn_mfma_f32_32x32x16_bf16(a3, qf[0], z, 0, 0, 0); }
      else { p0 = __builtin_amdgcn_mfma_f32_32x32x16_bf16(a0, qf[0], negm, 0, 0, 0); p1 = __builtin_amdgcn_mfma_f32_32x32x16_bf16(a1, qf[0], negm, 0, 0, 0);
             p2 = __builtin_amdgcn_mfma_f32_32x32x16_bf16(a2, qf[0], negm, 0, 0, 0); p3 = __builtin_amdgcn_mfma_f32_32x32x16_bf16(a3, qf[0], negm, 0, 0, 0); } }
#pragma unroll
    for (int s = 1; s < 6; ++s) {
        const bf16x8 a0 = *(const LAS bf16x8*)(kpa + s * 32), a1 = *(const LAS bf16x8*)(kpa + 32 * KSTR + s * 32), a2 = *(const LAS bf16x8*)(kpb + s * 32), a3 = *(const LAS bf16x8*)(kpb + 32 * KSTR + s * 32);
        p0 = __builtin_amdgcn_mfma_f32_32x32x16_bf16(a0, qf[s], p0, 0, 0, 0); p1 = __builtin_amdgcn_mfma_f32_32x32x16_bf16(a1, qf[s], p1, 0, 0, 0);
        p2 = __builtin_amdgcn_mfma_f32_32x32x16_bf16(a2, qf[s], p2, 0, 0, 0); p3 = __builtin_amdgcn_mfma_f32_32x32x16_bf16(a3, qf[s], p3, 0, 0, 0);
    }
    if (nv < 2) {
#pragma unroll
        for (int r = 0; r < 16; ++r) { p2[r] = -1e30f; p3[r] = -1e30f; } }
    float mx = fmaxf(fmaxf(p0[0], p1[0]), fmaxf(p2[0], p3[0]));
#pragma unroll
    for (int r = 1; r < 16; ++r) mx = fmaxf(mx, fmaxf(fmaxf(p0[r], p1[r]), fmaxf(p2[r], p3[r])));
    mx = max32(mx);
    if (FIRST) {
        mrun = mx;
#pragma unroll
        for (int r = 0; r < 16; ++r) { p0[r] -= mx; p1[r] -= mx; p2[r] -= mx; p3[r] -= mx; negm[r] = -mx; }
    } else if (__any(mx > 6.0f)) {
        const float dl = fmaxf(mx, 0.f), alpha = __builtin_amdgcn_exp2f(-dl);
        mrun += dl; lrun *= alpha;
#pragma unroll
        for (int r = 0; r < 16; ++r) { p0[r] -= dl; p1[r] -= dl; p2[r] -= dl; p3[r] -= dl; negm[r] = -mrun; }
        o0 *= alpha; o1 *= alpha;
    }
    float sa = 0.f, sb = 0.f;
#pragma unroll
    for (int r = 0; r < 16; ++r) { p0[r] = __builtin_amdgcn_exp2f(p0[r]); p1[r] = __builtin_amdgcn_exp2f(p1[r]); p2[r] = __builtin_amdgcn_exp2f(p2[r]); p3[r] = __builtin_amdgcn_exp2f(p3[r]); sa += p0[r] + p1[r]; sb += p2[r] + p3[r]; }
    lrun += sa + sb;
    u32x4 pw[8];
#pragma unroll
    for (int j = 0; j < 4; ++j) { pw[0][j] = pk2(p0[2 * j], p0[2 * j + 1]); pw[1][j] = pk2(p0[8 + 2 * j], p0[8 + 2 * j + 1]); pw[2][j] = pk2(p1[2 * j], p1[2 * j + 1]); pw[3][j] = pk2(p1[8 + 2 * j], p1[8 + 2 * j + 1]);
                                  pw[4][j] = pk2(p2[2 * j], p2[2 * j + 1]); pw[5][j] = pk2(p2[8 + 2 * j], p2[8 + 2 * j + 1]); pw[6][j] = pk2(p3[2 * j], p3[2 * j + 1]); pw[7][j] = pk2(p3[8 + 2 * j], p3[8 + 2 * j + 1]); }
    const int voff = (4 * hi + ((lane & 15) >> 2)) * VSTR + (16 * ((lane >> 4) & 1) + 4 * (lane & 3)) * 2;
#pragma unroll
    for (int ks = 0; ks < 8; ++ks) {
        if (ks >= 4 && nv < 2) break;
        const LAS char* vp = (ks < 4 ? bufA : bufB) + KB_BYTES + voff;
        const int kk = ks & 3;
        const bf16x8 pf = __builtin_bit_cast(bf16x8, pw[ks]);
        const bf16x8 v0 = cat8(vtr(vp + kk * 16 * VSTR), vtr(vp + (kk * 16 + 8) * VSTR));
        const bf16x8 v1 = cat8(vtr(vp + kk * 16 * VSTR + 64), vtr(vp + (kk * 16 + 8) * VSTR + 64));
        o0 = __builtin_amdgcn_mfma_f32_32x32x16_bf16(v0, pf, o0, 0, 0, 0);
        o1 = __builtin_amdgcn_mfma_f32_32x32x16_bf16(v1, pf, o1, 0, 0, 0);
    }
}

__device__ __forceinline__ void prompt_unit(const Ptrs& P, int b, int h, int qb, LAS char* lds, int tid_in, int lane_in, int wid) {
    int tid = tid_in, lane = lane_in; asm volatile("" : "+v"(tid), "+v"(lane));
    const size_t rowbase = (size_t)b * 2048; const int r32 = lane & 31, hi = lane >> 5;
    const size_t qrow = rowbase + qb * 256 + wid * 32 + r32;
    bf16x8 qf[6]; load_q(qf, P, qrow, h, hi);
    const int NT = 4 * qb + 4, myNT = 4 * qb + (wid >> 1) + 1, NP = NT >> 1;
    float mrun = 0.f, lrun = 0.f; f32x16 o0 = {}, o1 = {}, negm = {};
    Stage sa, sb; stage_load(sa, P, rowbase, h, tid); stage_load(sb, P, rowbase + 64, h, tid);
    stage_store(sa, lds, tid); stage_store(sb, lds + TILE_BYTES, tid); __syncthreads();
    stage_load(sa, P, rowbase + 128, h, tid); stage_load(sb, P, rowbase + 192, h, tid);
    for (int i = 0; i < NP; ++i) {
        LAS char* cur = lds + (i & 1) * (2 * TILE_BYTES); LAS char* nxt = lds + ((i + 1) & 1) * (2 * TILE_BYTES);
        const int nv = myNT - 2 * i;
        if (i == 0) attn_tile2<true>(cur, cur + TILE_BYTES, nv, qf, mrun, lrun, o0, o1, negm, lane);
        else if (nv >= 1) attn_tile2<false>(cur, cur + TILE_BYTES, nv, qf, mrun, lrun, o0, o1, negm, lane);
        if (i + 1 < NP) { stage_store(sa, nxt, tid); stage_store(sb, nxt + TILE_BYTES, tid); }
        __syncthreads();
        if (i + 2 < NP) { stage_load(sa, P, rowbase + (size_t)(2 * i + 4) * 64, h, tid); stage_load(sb, P, rowbase + (size_t)(2 * i + 5) * 64, h, tid); }
    }
    finalize(P, qrow, h, lrun, o0, o1, lane);
}

constexpr int LSTR = 320, STILE_BYTES = KB_BYTES + 64 * LSTR;
struct SStage { u32x4 kn, kr, c0, c1; };
__device__ __forceinline__ void sstage_load(SStage& s, const Ptrs& P, const bf16* CL, size_t krow0, int h, int tid) {
    const int row = tid >> 3, ch = tid & 7;
    s.kn = *(const u32x4*)(P.KN + (krow0 + row) * 512 + h * 64 + ch * 8);
    if (tid < 256) { const int r2 = tid >> 2, c2 = tid & 3; s.kr = *(const u32x4*)(P.KR + (krow0 + r2) * 32 + c2 * 8); }
    const int lr = tid >> 4, lc = tid & 15;
    s.c0 = *(const u32x4*)(CL + (krow0 + lr) * 128 + lc * 8);
    s.c1 = *(const u32x4*)(CL + (krow0 + 32 + lr) * 128 + lc * 8);
}
__device__ __forceinline__ void sstage_store(const SStage& s, LAS char* buf, int tid) {
    const int row = tid >> 3, ch = tid & 7;
    *(LAS u32x4*)(buf + row * KSTR + ch * 16) = s.kn;
    if (tid < 256) { const int r2 = tid >> 2, c2 = tid & 3; *(LAS u32x4*)(buf + r2 * KSTR + 128 + c2 * 16) = s.kr; }
    const int lr = tid >> 4, lc = tid & 15;
    *(LAS u32x4*)(buf + KB_BYTES + lr * LSTR + lc * 16) = s.c0;
    *(LAS u32x4*)(buf + KB_BYTES + (32 + lr) * LSTR + lc * 16) = s.c1;
}
template <bool FIRST>
__device__ __forceinline__ void attn_tile_lat(const LAS char* buf, const bf16x8 (&qf)[6], float& mrun, float& lrun, f32x16 (&ol)[4], int lane) {
    const int r32 = lane & 31, hi = lane >> 5;
    const LAS char* kp = buf + r32 * KSTR + hi * 16;
    f32x16 p0 = {}, p1 = {};
#pragma unroll
    for (int s = 0; s < 6; ++s) {
        const bf16x8 a0 = *(const LAS bf16x8*)(kp + s * 32), a1 = *(const LAS bf16x8*)(kp + 32 * KSTR + s * 32);
        p0 = __builtin_amdgcn_mfma_f32_32x32x16_bf16(a0, qf[s], p0, 0, 0, 0);
        p1 = __builtin_amdgcn_mfma_f32_32x32x16_bf16(a1, qf[s], p1, 0, 0, 0);
    }
    float mx = fmaxf(p0[0], p1[0]);
#pragma unroll
    for (int r = 1; r < 16; ++r) mx = fmaxf(mx, fmaxf(p0[r], p1[r]));
    mx = max32(mx);
    const float mnew = FIRST ? mx : fmaxf(mrun, mx);
    if (!FIRST && __any(mnew > mrun)) { const float alpha = __builtin_amdgcn_exp2f(mrun - mnew); lrun *= alpha;
#pragma unroll
        for (int cb = 0; cb < 4; ++cb) ol[cb] *= alpha; }
    mrun = mnew;
    float sum = 0.f;
#pragma unroll
    for (int r = 0; r < 16; ++r) { p0[r] = __builtin_amdgcn_exp2f(p0[r] - mnew); p1[r] = __builtin_amdgcn_exp2f(p1[r] - mnew); sum += p0[r] + p1[r]; }
    lrun += sum;
    u32x4 pw[4];
#pragma unroll
    for (int j = 0; j < 4; ++j) { pw[0][j] = pk2(p0[2 * j], p0[2 * j + 1]); pw[1][j] = pk2(p0[8 + 2 * j], p0[8 + 2 * j + 1]); pw[2][j] = pk2(p1[2 * j], p1[2 * j + 1]); pw[3][j] = pk2(p1[8 + 2 * j], p1[8 + 2 * j + 1]); }
    const LAS char* vp = buf + KB_BYTES + (4 * hi + ((lane & 15) >> 2)) * LSTR + (16 * ((lane >> 4) & 1) + 4 * (lane & 3)) * 2;
#pragma unroll
    for (int ks = 0; ks < 4; ++ks) {
        const bf16x8 pf = __builtin_bit_cast(bf16x8, pw[ks]);
#pragma unroll
        for (int cb = 0; cb < 4; ++cb) {
            const bf16x8 v = cat8(vtr(vp + ks * 16 * LSTR + cb * 64), vtr(vp + (ks * 16 + 8) * LSTR + cb * 64));
            ol[cb] = __builtin_amdgcn_mfma_f32_32x32x16_bf16(v, pf, ol[cb], 0, 0, 0);
        }
    }
}
__device__ __forceinline__ void project_v(const bf16* WkvT, int h, const f32x16 (&ol)[4], f32x16& o0, f32x16& o1, int lane) {
    const int d_lo = lane & 31, hi = lane >> 5;
    const bf16* w0 = WkvT + (size_t)(256 * (2 + (h >> 2)) + 32 * (h & 3) + d_lo) * 128 + 4 * hi;
    const bf16* w1 = w0 + (size_t)128 * 128;
    o0 = f32x16{}; o1 = f32x16{};
#pragma unroll
    for (int s = 0; s < 8; ++s) {
        const int cb = s >> 1, rb = 8 * (s & 1), c0 = 32 * cb + 16 * (s & 1);
        u32x4 bw; bw.x = pk2(ol[cb][rb], ol[cb][rb + 1]); bw.y = pk2(ol[cb][rb + 2], ol[cb][rb + 3]); bw.z = pk2(ol[cb][rb + 4], ol[cb][rb + 5]); bw.w = pk2(ol[cb][rb + 6], ol[cb][rb + 7]);
        const bf16x8 bfr = __builtin_bit_cast(bf16x8, bw);
        const u32x2 a00 = *(const u32x2*)(w0 + c0), a01 = *(const u32x2*)(w0 + c0 + 8), a10 = *(const u32x2*)(w1 + c0), a11 = *(const u32x2*)(w1 + c0 + 8);
        const bf16x8 af0 = __builtin_bit_cast(bf16x8, (u32x4){a00.x, a00.y, a01.x, a01.y}), af1 = __builtin_bit_cast(bf16x8, (u32x4){a10.x, a10.y, a11.x, a11.y});
        o0 = __builtin_amdgcn_mfma_f32_32x32x16_bf16(af0, bfr, o0, 0, 0, 0);
        o1 = __builtin_amdgcn_mfma_f32_32x32x16_bf16(af1, bfr, o1, 0, 0, 0);
    }
}

__device__ __forceinline__ void sample_unit(const Ptrs& P, const bf16* CL  , const bf16* WkvT, int b, int h, int qk, float* part, unsigned* cnt, LAS char* lds, int tid_in, int lane_in, int wid) {
    int tid = tid_in, lane = lane_in; asm volatile("" : "+v"(tid), "+v"(lane));
    const int r32 = lane & 31, hi = lane >> 5, qblk = wid & 1, ks = wid >> 1;
    const size_t qrow = (size_t)MP + b * 64 + qblk * 32 + r32;
    bf16x8 qf[6]; load_q(qf, P, qrow, h, hi);
    float mrun = 0.f, lrun = 0.f; f32x16 ol[4] = {f32x16{}, f32x16{}, f32x16{}, f32x16{}};
    const size_t cbase = (size_t)MT + (size_t)b * 4096, nbase = (size_t)MP + b * 64;
    const int t0 = 16 * qk, ntile = (qk == 3) ? 17 : 16, nit = (ntile + 3) >> 2;
    SStage st[4];
#pragma unroll
    for (int j = 0; j < 4; ++j) { sstage_load(st[j], P, CL, cbase + (size_t)(t0 + j) * 64, h, tid); }
#pragma unroll
    for (int j = 0; j < 4; ++j) { sstage_store(st[j], lds + j * STILE_BYTES, tid); }
    __syncthreads();
    for (int it = 0; it < nit; ++it) {
        const int tn = 4 * (it + 1);
#pragma unroll
        for (int j = 0; j < 4; ++j) if (tn + j < ntile) sstage_load(st[j], P, CL, (t0 + tn + j < 64) ? cbase + (size_t)(t0 + tn + j) * 64 : nbase, h, tid);
        if (it == 0) attn_tile_lat<true>(lds + ks * STILE_BYTES, qf, mrun, lrun, ol, lane);
        else if (4 * it + ks < ntile) attn_tile_lat<false>(lds + ks * STILE_BYTES, qf, mrun, lrun, ol, lane);
        __syncthreads();
#pragma unroll
        for (int j = 0; j < 4; ++j) if (tn + j < ntile) sstage_store(st[j], lds + j * STILE_BYTES, tid);
        __syncthreads();
    }
    f32x16 o0, o1; project_v(WkvT, h, ol, o0, o1, lane);
    LAS float* xs = (LAS float*)lds;
    if (ks > 0) { LAS float* s = xs + ((ks - 1) * 2 + qblk) * (34 * 64) + lane; s[0] = mrun; s[64] = lrun;
#pragma unroll
        for (int r = 0; r < 16; ++r) { s[(2 + r) * 64] = o0[r]; s[(18 + r) * 64] = o1[r]; } }
    __syncthreads();
    float* mypart = part + ((size_t)((b * 8 + h) * 4 + qk) * 2 + qblk) * (34 * 64);
    if (ks == 0) {
        float mt = mrun, mo[3];
#pragma unroll
        for (int s = 0; s < 3; ++s) { mo[s] = xs[(s * 2 + qblk) * (34 * 64) + lane]; mt = fmaxf(mt, mo[s]); }
        const float a0 = __builtin_amdgcn_exp2f(mrun - mt); lrun *= a0; o0 *= a0; o1 *= a0; mrun = mt;
#pragma unroll
        for (int s = 0; s < 3; ++s) { const LAS float* sp = xs + (s * 2 + qblk) * (34 * 64) + lane; const float as = __builtin_amdgcn_exp2f(mo[s] - mt);
            lrun += sp[64] * as;
#pragma unroll
            for (int r = 0; r < 16; ++r) { o0[r] += sp[(2 + r) * 64] * as; o1[r] += sp[(18 + r) * 64] * as; } }
        st8wt(part, mypart + 2048 + 2 * lane, (f32x2){mrun, lrun});
#pragma unroll
        for (int k = 0; k < 4; ++k) { st16wt(part, mypart + (k * 64 + lane) * 4, __builtin_bit_cast(u32x4, (f32x4){o0[4 * k], o0[4 * k + 1], o0[4 * k + 2], o0[4 * k + 3]}));
                                      st16wt(part, mypart + ((4 + k) * 64 + lane) * 4, __builtin_bit_cast(u32x4, (f32x4){o1[4 * k], o1[4 * k + 1], o1[4 * k + 2], o1[4 * k + 3]})); }
    }
    asm volatile("s_waitcnt vmcnt(0)" ::: "memory");
    __syncthreads();
    LAS unsigned* flag = (LAS unsigned*)(lds + 6 * 34 * 64 * 4);
    if (tid == 0) {
        asm volatile("s_waitcnt vmcnt(0)" ::: "memory");
        const unsigned old = __hip_atomic_fetch_add(cnt + (b * 8 + h), 1u, __ATOMIC_RELAXED, __HIP_MEMORY_SCOPE_AGENT);
        if (old == 3u) { __builtin_amdgcn_fence(__ATOMIC_ACQUIRE, "agent"); asm volatile("s_waitcnt vmcnt(0)" ::: "memory"); }
        flag[0] = (old == 3u) ? 1u : 0u;
    }
    __syncthreads();
    if (flag[0] != 0u && ks == 0) {
        float mt = mrun, mo[3]; const float* op[3];
#pragma unroll
        for (int s = 0; s < 3; ++s) { const int q2 = (qk + 1 + s) & 3; op[s] = part + ((size_t)((b * 8 + h) * 4 + q2) * 2 + qblk) * (34 * 64); mo[s] = op[s][2048 + 2 * lane]; mt = fmaxf(mt, mo[s]); }
        const float a0 = __builtin_amdgcn_exp2f(mrun - mt); lrun *= a0; o0 *= a0; o1 *= a0;
#pragma unroll
        for (int s = 0; s < 3; ++s) { const float as = __builtin_amdgcn_exp2f(mo[s] - mt);
            lrun += op[s][2048 + 2 * lane + 1] * as;
#pragma unroll
            for (int k = 0; k < 4; ++k) { const f32x4 v0 = *(const f32x4*)(op[s] + (k * 64 + lane) * 4), v1 = *(const f32x4*)(op[s] + ((4 + k) * 64 + lane) * 4);
#pragma unroll
                for (int e = 0; e < 4; ++e) { o0[4 * k + e] += v0[e] * as; o1[4 * k + e] += v1[e] * as; } } }
        finalize(P, qrow, h, lrun, o0, o1, lane);
    }
    __syncthreads();
}

struct GmPtrs { const bf16* VN; bf16* MRG; const bf16* WsB; const float* bs; const float* gog; };
constexpr int WSTR = 272, WS_LDS = 128 * WSTR;
__device__ __forceinline__ void gmlp_wg(const GmPtrs& G, int vcu, LAS char* lds, int tid, int lane, int wave) {
    const int g = vcu & 7, cs = vcu >> 3;
    const bool active = wave < 4 || (wave == 4 && cs < 8);
    int L = 128; size_t row0 = 0;
    if (wave < 4) { const int cidx = 4 * cs + wave; row0 = (size_t)(cidx >> 4) * 2048 + (cidx & 15) * 128; }
    else { row0 = (size_t)MP + cs * 64; L = 64; }
    LAS char* wl = lds + WS_LDS + wave * 24576;
    const int r32 = lane & 31, hi = lane >> 5, nib = L >> 5;
    u32x4 wsr[4], vnr[16];
    { const bf16* Wg = G.WsB + (size_t)g * 128 * 128;
#pragma unroll
      for (int k = 0; k < 4; ++k) { const int idx = k * 512 + tid, r = idx >> 4, ch = idx & 15; wsr[k] = *(const u32x4*)(Wg + r * 128 + ch * 8); } }
    if (active) {
#pragma unroll
        for (int k = 0; k < 16; ++k) { const int idx = k * 64 + lane, r = idx >> 3, ch = idx & 7;
            vnr[k] = (u32x4){0u, 0u, 0u, 0u}; if (r < L) vnr[k] = *(const u32x4*)(G.VN + (row0 + r) * 512 + g * 64 + ch * 8); } }
#pragma unroll
    for (int k = 0; k < 4; ++k) { const int idx = k * 512 + tid, r = idx >> 4, ch = idx & 15; *(LAS u32x4*)(lds + r * WSTR + ch * 16) = wsr[k]; }
    if (active) {
#pragma unroll
        for (int k = 0; k < 16; ++k) { const int idx = k * 64 + lane, r = idx >> 3, ch = idx & 7; if (r < L) *(LAS u32x4*)(wl + r * VSTR + ch * 16) = vnr[k]; } }
    __syncthreads();
    if (active) {
        u32x2 ur[4][4][2];
#pragma unroll
        for (int ib = 0; ib < 4; ++ib) { const bf16* up = G.MRG + (row0 + 32 * ib + r32) * 1024 + 512 + g * 64;
#pragma unroll
            for (int rg = 0; rg < 4; ++rg) { const int d0 = 8 * rg + 4 * hi; ur[ib][rg][0] = (u32x2){0u, 0u}; ur[ib][rg][1] = (u32x2){0u, 0u};
                if (ib < nib) { ur[ib][rg][0] = *(const u32x2*)(up + d0); ur[ib][rg][1] = *(const u32x2*)(up + 32 + d0); } } }
        float bsv4[4];
#pragma unroll
        for (int ib = 0; ib < 4; ++ib) bsv4[ib] = G.bs[g * 128 + 32 * ib + r32];
        f32x16 acc[4][2];
#pragma unroll
        for (int ib = 0; ib < 4; ++ib) { acc[ib][0] = f32x16{}; acc[ib][1] = f32x16{}; }
        const LAS char* vp = wl + (8 * hi + ((lane & 15) >> 2)) * VSTR + (16 * ((lane >> 4) & 1) + 4 * (lane & 3)) * 2;
        const LAS char* wp = lds + r32 * WSTR + hi * 16;
#pragma unroll
        for (int hj = 0; hj < 2; ++hj) {
            if (hj * 64 < L) {
#pragma unroll
                for (int ks = 0; ks < 4; ++ks) {
                    const LAS char* vq = vp + (64 * hj + 16 * ks) * VSTR;
                    const bf16x8 a0 = cat8(vtr(vq), vtr(vq + 4 * VSTR));
                    const bf16x8 a1 = cat8(vtr(vq + 64), vtr(vq + 4 * VSTR + 64));
                    bf16x8 bfr[4];
#pragma unroll
                    for (int ib = 0; ib < 4; ++ib) if (hj == 0 || ib >= 2) bfr[ib] = *(const LAS bf16x8*)(wp + 32 * ib * WSTR + (64 * hj + 16 * ks) * 2);
#pragma unroll
                    for (int ib = 0; ib < 4; ++ib) {
                        if (ib < nib && (hj == 0 || ib >= 2)) {
                            acc[ib][0] = __builtin_amdgcn_mfma_f32_32x32x16_bf16(a0, bfr[ib], acc[ib][0], 0, 0, 0);
                            acc[ib][1] = __builtin_amdgcn_mfma_f32_32x32x16_bf16(a1, bfr[ib], acc[ib][1], 0, 0, 0);
                        }
                    }
                }
            }
        }
#pragma unroll
        for (int ib = 0; ib < 4; ++ib) {
            if (ib < nib) {
                const int i = 32 * ib + r32; const size_t row = row0 + i; const float bsv = bsv4[ib];
                bf16* up = G.MRG + row * 1024 + 512 + g * 64;
                float ss = 0.f;
#pragma unroll
                for (int rg = 0; rg < 4; ++rg) {
                    const u32x2 u0 = ur[ib][rg][0], u1 = ur[ib][rg][1];
                    const float ua[4] = {bflo(u0.x), bfhi(u0.x), bflo(u0.y), bfhi(u0.y)}, ub[4] = {bflo(u1.x), bfhi(u1.x), bflo(u1.y), bfhi(u1.y)};
#pragma unroll
                    for (int e = 0; e < 4; ++e) { const float x0 = ua[e] * (acc[ib][0][4 * rg + e] + bsv), x1 = ub[e] * (acc[ib][1][4 * rg + e] + bsv);
                        acc[ib][0][4 * rg + e] = x0; acc[ib][1][4 * rg + e] = x1; ss += x0 * x0 + x1 * x1; } }
                ss = sum32(ss);
                const float rn = rsq(ss * (1.0f / 64.0f) + EPS);
#pragma unroll
                for (int rg = 0; rg < 4; ++rg) { const int d0 = 8 * rg + 4 * hi;
                    u32x2 w0, w1;
                    w0.x = pk2(acc[ib][0][4 * rg] * rn, acc[ib][0][4 * rg + 1] * rn); w0.y = pk2(acc[ib][0][4 * rg + 2] * rn, acc[ib][0][4 * rg + 3] * rn);
                    w1.x = pk2(acc[ib][1][4 * rg] * rn, acc[ib][1][4 * rg + 1] * rn); w1.y = pk2(acc[ib][1][4 * rg + 2] * rn, acc[ib][1][4 * rg + 3] * rn);
                    *(u32x2*)(up + d0) = w0; *(u32x2*)(up + 32 + d0) = w1; }
            }
        }
    }
    __syncthreads();
}
}
typedef GAS unsigned gu32;
#define RLX_AGENT __ATOMIC_RELAXED, __HIP_MEMORY_SCOPE_AGENT
#define LDS_WAIT() asm volatile("s_waitcnt lgkmcnt(0)" ::: "memory")
#define VM_WAIT() asm volatile("s_waitcnt vmcnt(0)" ::: "memory")
#define XB_TMO      128
#define XB_XCNT(j)  (256  + 64 * (j))
#define XB_XSUB(j)  (1280 + 64 * (j))
#define XB_XGEN(j)  (2304 + 64 * (j))
#define XB_TOP      3328
#define XB_TOPGEN   3392
#define XCD_BAR_WORDS 3456
#define XB_SPIN_CAP (1u << 22)

__device__ __forceinline__ unsigned xb_ld(unsigned* p)              { return __hip_atomic_load(p, __ATOMIC_RELAXED, __HIP_MEMORY_SCOPE_AGENT); }
__device__ __forceinline__ unsigned xb_add(unsigned* p, unsigned v) { return __hip_atomic_fetch_add(p, v, __ATOMIC_RELAXED, __HIP_MEMORY_SCOPE_AGENT); }
__device__ __forceinline__ unsigned xb_xcc_id() { return (unsigned)__builtin_amdgcn_s_getreg((3 << 11) | 20) & 0xFu; }
#define XB_SPIN(cond, bar) do { unsigned _sp = 0; while (cond) { __builtin_amdgcn_s_sleep(1); \
    if ((++_sp & 255u) == 0u) { if (xb_ld(&(bar)[XB_TMO])) break; if (_sp > XB_SPIN_CAP) { atomicAdd(&(bar)[XB_TMO], 1u); break; } } } } while (0)

struct XcdBarrier {
    unsigned* bar; unsigned x;
    volatile LAS unsigned* st;
};

__device__ __forceinline__ bool xb_first_thread(int wave) { unsigned z = 0u; asm volatile("" : "+v"(z)); return wave == 0 && __builtin_amdgcn_mbcnt_hi(~0u, __builtin_amdgcn_mbcnt_lo(~0u, z)) == 0u; }
__device__ __forceinline__ XcdBarrier xcd_barrier_post(unsigned* bar, volatile LAS unsigned* st, int wave) {
    XcdBarrier b; b.bar = bar; b.x = xb_xcc_id(); b.st = st;
    if (xb_first_thread(wave)) (void)xb_add(&bar[XB_XCNT(b.x)], 1u);
    return b;
}
__device__ __forceinline__ void xcd_barrier_complete(unsigned* bar, unsigned x, unsigned& nloc, unsigned& nx) {
    const unsigned G = gridDim.x * gridDim.y * gridDim.z;
    unsigned sum, cnt, mine, sp = 0u;
    for (;;) {
        sum = 0u; cnt = 0u; mine = 0u;
#pragma unroll
        for (unsigned j = 0; j < 16; ++j) { const unsigned c = xb_ld(&bar[XB_XCNT(j)]); sum += c; cnt += (c > 0u) ? 1u : 0u; mine = (j == x) ? c : mine; }
        if (sum == G) break;
        __builtin_amdgcn_s_sleep(1);
        if ((++sp & 255u) == 0u) { if (xb_ld(&bar[XB_TMO])) break; if (sp > XB_SPIN_CAP) { atomicAdd(&bar[XB_TMO], 1u); break; } }
    }
    nloc = mine > 0u ? mine : 1u; nx = cnt > 0u ? cnt : 1u;
}

__device__ __forceinline__ void xcd_barrier(const XcdBarrier& b, int wave) {
    asm volatile("s_waitcnt vmcnt(0)" ::: "memory");
    __syncthreads();
    if (xb_first_thread(wave)) {
        unsigned* bar = b.bar; const unsigned x = xb_xcc_id();
        __builtin_amdgcn_s_waitcnt(0);
        unsigned nloc = b.st[0], nx = b.st[1];
        if (nloc == 0u) { xcd_barrier_complete(bar, x, nloc, nx); b.st[0] = nloc; b.st[1] = nx; }
        const unsigned old = xb_add(&bar[XB_XSUB(x)], 1u);
        const unsigned gen = old / nloc;
        if (old + 1u == (gen + 1u) * nloc) {
            __builtin_amdgcn_fence(__ATOMIC_RELEASE, "agent");
            asm volatile("s_waitcnt vmcnt(0)" ::: "memory");
            const unsigned og = xb_add(&bar[XB_TOP], 1u);
            const unsigned tg = og / nx;
            if (og + 1u == (tg + 1u) * nx) xb_add(&bar[XB_TOPGEN], 1u);
            else XB_SPIN(xb_ld(&bar[XB_TOPGEN]) == tg, bar);
            __builtin_amdgcn_fence(__ATOMIC_ACQUIRE, "agent");
            xb_add(&bar[XB_XGEN(x)], 1u);
            asm volatile("s_waitcnt vmcnt(0)" ::: "memory");
        } else {
            XB_SPIN(xb_ld(&bar[XB_XGEN(x)]) == gen, bar);
            __builtin_amdgcn_fence(__ATOMIC_ACQUIRE, "agent");
            asm volatile("s_waitcnt vmcnt(0)" ::: "memory");
        }
    }
    __syncthreads();
}

__device__ __forceinline__ void seam_wait(unsigned* c0, unsigned* c1, unsigned need, unsigned* bar, int wave) {
    if (xb_first_thread(wave)) {
        XB_SPIN(xb_ld(c0) < need, bar);
        XB_SPIN(xb_ld(c1) < need, bar);
        __builtin_amdgcn_fence(__ATOMIC_ACQUIRE, "agent");
        asm volatile("s_waitcnt vmcnt(0)" ::: "memory");
    }
    __syncthreads();
}

struct PanelOrder {
    int pm, j, ks, wave; unsigned* scnt; unsigned* bar;
    __device__ __forceinline__ void init(int G, int c, unsigned* scnt_, unsigned* bar_, int wave_) {
        pg8::StaticOrder S; S.init(MP, 1024, G, c); pg8::Unit u; u.pm = 0; u.pn = 0; (void)S.next(0, u); pm = u.pm; j = u.pn;
        const int k = 2 * pm + (j - 2); ks = (j >= 2 && k < 44) ? k : -1; scnt = scnt_; bar = bar_; wave = wave_; }
    __device__ __forceinline__ bool next(int i, pg8::Unit& u) const {
#ifdef SAMPLE_SECOND
        if (ks >= 0) {
            if (i == 1) { u.pm = 64 + (ks & 1); u.pn = ks >> 1; return true; }
            if (i < 6) { u.pm = pm; u.pn = 4 * (i == 0 ? 0 : i - 1) + j; return true; }
            return false; }
#endif
        if (i < 5) { u.pm = pm; u.pn = 4 * i + j; return true; }
        if (i == 5) { if (j < 2) { u.pm = pm; u.pn = 20 + j; return true; } if (ks >= 0) { u.pm = 64 + (ks & 1); u.pn = ks >> 1; return true; } }
        return false; }
    __device__ __forceinline__ void a_ready(const pg8::Unit& u) const {
        if (u.pm >= 64) {
            if (xb_first_thread(wave)) { XB_SPIN(xb_ld(scnt) < 256u, bar); __builtin_amdgcn_fence(__ATOMIC_ACQUIRE, "agent"); asm volatile("s_waitcnt vmcnt(0)" ::: "memory"); }
            asm volatile("" ::: "memory"); __builtin_amdgcn_s_barrier(); asm volatile("" ::: "memory");
        }
    }
    __device__ __forceinline__ void done(const pg8::Unit&) const {}
};

struct OwnerOrder6 {
    int pm, j, ks; unsigned* cnt;
    __device__ __forceinline__ void init(int G, int c, unsigned* cnt_) { pg8::StaticOrder S; S.init(MP, 1024, G, c); pg8::Unit u; u.pm = 0; u.pn = 0; (void)S.next(0, u); pm = u.pm; j = u.pn;
        const int k = 2 * pm + (j - 2); ks = (j >= 2 && k < 12) ? k : -1; cnt = cnt_; }
    __device__ __forceinline__ bool idle() const { return j >= 2 && ks < 0; }
    __device__ __forceinline__ int idle_index() const { return 2 * (pm - 6) + (j - 2); }
    __device__ __forceinline__ bool next(int i, pg8::Unit& u) const {
        if (i == 0) { u.pm = pm; u.pn = j; return true; }
        if (i == 1) { if (j < 2) { u.pm = pm; u.pn = 4 + j; return true; } if (ks >= 0) { u.pm = 64 + (ks & 1); u.pn = ks >> 1; return true; } }
        return false; }
    __device__ __forceinline__ void a_ready(const pg8::Unit&) const {}
    __device__ __forceinline__ void done(const pg8::Unit& u) const {
        if (cnt != nullptr && u.pn < 2) { asm volatile("s_waitcnt vmcnt(0)" ::: "memory");
            unsigned z = 0u; asm volatile("" : "+v"(z)); if (__builtin_amdgcn_mbcnt_hi(~0u, __builtin_amdgcn_mbcnt_lo(~0u, z)) == 0u) (void)xb_add(cnt + 16 * u.pm, 1u); } }
};
struct ListOrder {
    int n, c0, c1, c2;
    __device__ __forceinline__ bool next(int i, pg8::Unit& u) const { if (i >= n) return false; const int c = i == 0 ? c0 : (i == 1 ? c1 : c2); u.pm = c >> 8; u.pn = c & 255; return true; }
    __device__ __forceinline__ void a_ready(const pg8::Unit&) const {}
    __device__ __forceinline__ void done(const pg8::Unit&) const {}
};

__device__ __forceinline__ int cmap_in(int n)  {
    if (n < 416) return n; if (n < 512) return -1; if (n < 1024) return n - 96;
    const int t = (n - 1024) >> 8, p = n & 255, bj = p >> 7, wc = (p >> 5) & 3, q = p & 31; return 928 + 64 * (4 * t + wc) + 32 * bj + q; }
__device__ __forceinline__ int cmap_qup(int n) { const int t = n >> 8, p = n & 255, bj = p >> 7, wc = (p >> 5) & 3, q = p & 31;
    if (t < 2) return (4 * t + wc) * 96 + 32 * bj + q;
    return (2 * wc + bj) * 96 + 64 + 16 * ((q >> 2) & 1) + 4 * (q >> 3) + (q & 3); }
__device__ __forceinline__ int cmap_kv(int n)  { const int t = n >> 8, p = n & 255, bj = p >> 7, wc = (p >> 5) & 3, q = p & 31;
    return (t < 2) ? (4 * t + wc) * 128 + 32 * bj + q : (4 * (t - 2) + wc) * 128 + 64 + 32 * bj + q; }

template <int WHICH  , bool GAIN>
__device__ __forceinline__ void transpose_item(const float* W, const float* W2, int K, int Nsrc, const float* gain, bf16* WT, LAS float* scr, int item, int nblk, int lane) {
    (void)scr;
    const int kb = item / nblk, nb = item % nblk, k0 = 64 * kb + 8 * (lane >> 3), n0 = 32 * nb, n = n0 + 4 * (lane & 7);
    int colq; const float* srcq = W;
    if (WHICH == 0) colq = cmap_in(n); else if (WHICH == 1) colq = cmap_qup(n); else if (WHICH == 2) colq = cmap_kv(n); else if (WHICH == 3 || WHICH == 5) colq = n;
    else { const int t = n >> 8, p = n & 255; if (p < 128) colq = 128 * t + p; else { colq = 128 * t + p - 128; srcq = W2; } }
    f32x4 v[8];
#pragma unroll
    for (int j = 0; j < 8; ++j) v[j] = (f32x4){0.f, 0.f, 0.f, 0.f};
    if (colq >= 0) {
#pragma unroll
        for (int j = 0; j < 8; ++j) v[j] = *(const f32x4*)(srcq + (size_t)(k0 + j) * Nsrc + colq);
        if (GAIN) { const float* gq = (WHICH == 5 && k0 >= 512) ? W2 + (k0 - 512) : gain + k0;
            const f32x4 g0 = *(const f32x4*)gq, g1 = *(const f32x4*)(gq + 4);
#pragma unroll
            for (int j = 0; j < 4; ++j) { v[j] = v[j] * g0[j]; v[4 + j] = v[4 + j] * g1[j]; } }
    }
#pragma unroll
    for (int e = 0; e < 4; ++e) { u32x4 o; o.x = pk2(v[0][e], v[1][e]); o.y = pk2(v[2][e], v[3][e]); o.z = pk2(v[4][e], v[5][e]); o.w = pk2(v[6][e], v[7][e]);
        *(u32x4*)(WT + (size_t)(n + e) * K + k0) = o; }
}

template <int KTOT>
__device__ __forceinline__ void sample_res_gemm(const bf16* A, int lda, const bf16* Bt, float* out, bf16* XB, float* ssq, int final_f32, int wt, int task, LAS char* lds, int lane, int wave) {
    const int fr = lane & 15, fq = lane >> 4, xcd_ = task >> 5, j_ = task & 31, t0 = 64 * (4 * (xcd_ & 1) + (j_ & 3)), n0 = 32 * (8 * (xcd_ >> 1) + (j_ >> 2));
    constexpr int KW = KTOT / 8, NS = KW / 32, CH = 4;
    static_assert(KW % 32 == 0, "k split");
    const bf16* wp = Bt + (size_t)(n0 + fr) * KTOT + wave * KW + 8 * fq;
    const bf16* xq = A + (size_t)(MP + t0 + fr) * lda + wave * KW + 8 * fq;
    f32x4 acc[2][4];
#pragma unroll
    for (int nf = 0; nf < 2; ++nf)
#pragma unroll
        for (int mf = 0; mf < 4; ++mf) acc[nf][mf] = (f32x4){0.f, 0.f, 0.f, 0.f};
#pragma unroll
    for (int c0 = 0; c0 < NS; c0 += CH) {
        bf16x8 wv[2][CH], xv[4][CH];
#pragma unroll
        for (int nf = 0; nf < 2; ++nf)
#pragma unroll
            for (int s = 0; s < CH; ++s) if (c0 + s < NS) wv[nf][s] = *(const bf16x8*)(wp + (size_t)16 * nf * KTOT + 32 * (c0 + s));
#pragma unroll
        for (int mf = 0; mf < 4; ++mf)
#pragma unroll
            for (int s = 0; s < CH; ++s) if (c0 + s < NS) xv[mf][s] = *(const bf16x8*)(xq + (size_t)16 * mf * lda + 32 * (c0 + s));
        __builtin_amdgcn_sched_barrier(0);
#pragma unroll
        for (int s = 0; s < CH; ++s) if (c0 + s < NS) {
#pragma unroll
            for (int nf = 0; nf < 2; ++nf)
#pragma unroll
                for (int mf = 0; mf < 4; ++mf) acc[nf][mf] = __builtin_amdgcn_mfma_f32_16x16x32_bf16(wv[nf][s], xv[mf][s], acc[nf][mf], 0, 0, 0);
        }
        __builtin_amdgcn_sched_barrier(0);
    }
    LAS f32x4* ps = (LAS f32x4*)lds + wave * 512 + lane;
#pragma unroll
    for (int nf = 0; nf < 2; ++nf)
#pragma unroll
        for (int mf = 0; mf < 4; ++mf) ps[(nf * 4 + mf) * 64] = acc[nf][mf];
    __syncthreads();
    { const int nf = wave >> 2, mf = wave & 3; f32x4 sum = {0.f, 0.f, 0.f, 0.f};
      const LAS f32x4* rp = (const LAS f32x4*)lds + wave * 64 + lane;
#pragma unroll
      for (int p = 0; p < 8; ++p) sum += rp[p * 512];
      const size_t rs = (size_t)t0 + 16 * mf + fr;
      const int col = n0 + 16 * nf + 4 * fq;
      bf16* xp = XB + ((size_t)MP + rs) * 1024 + col; const u32x2 xw = *(const u32x2*)xp;
      const f32x4 o = (f32x4){bflo(xw.x), bfhi(xw.x), bflo(xw.y), bfhi(xw.y)} + sum;
      if (final_f32) *(f32x4*)(out + ((size_t)MP + rs) * 1024 + col) = o;
      else { u32x2 w; w.x = pk2(o[0], o[1]); w.y = pk2(o[2], o[3]); if (wt) st8wtu(XB, xp, w); else *(u32x2*)xp = w; const float ss = sum32(sum16(dot4v(o))); if (fq == 0) atomicAdd(ssq + MP + rs, ss); } }
    asm volatile("s_waitcnt vmcnt(0)" ::: "memory");
    __syncthreads();
}

struct Args { const float* in[25]; float* out; unsigned char* ws; };
enum { I_XP = 0, I_XS, I_CCKV, I_CKR, I_GMIX, I_WIN, I_GQL, I_WQUP, I_GQN, I_GQR, I_GKVL, I_GKR, I_WKV, I_GKN, I_LNG, I_LNB, I_WS, I_BS, I_GOA, I_GOG, I_WO, I_GFFN, I_WG, I_WU, I_WD };

constexpr int I_IN = 16 * 48, I_QU = 4 * 24, I_KV = 2 * 32, I_KVG = 2 * 32, I_O = 16 * 32, I_GU = 16 * 176, I_D = 44 * 32, I_LAYER = I_IN + I_QU + I_KV + I_KVG + I_O + I_GU + I_D, I_EARLY = I_IN + I_QU + I_KV + I_KVG;
__device__ __forceinline__ void convert_items(const Args& A, unsigned char* ws, LAS float* scr, int first, int last, int widx, int nw, int lane) {
    for (int it = first + widx; it < last; it += nw) {
        const int l = it / I_LAYER; int r = it % I_LAYER; unsigned char* wb = ws + WS_W + (size_t)l * LW;
        if (r < I_IN) { transpose_item<0, true>(A.in[I_WIN] + (size_t)l * 1024 * 1440, nullptr, 1024, 1440, A.in[I_GMIX] + l * 1024, (bf16*)(wb + W_IN), scr, r, 48, lane); continue; } r -= I_IN;
        if (r < I_QU) { transpose_item<1, true>(A.in[I_WQUP] + (size_t)l * 256 * 768, nullptr, 256, 768, A.in[I_GQL] + l * 256, (bf16*)(wb + W_QUP), scr, r, 24, lane); continue; } r -= I_QU;
        if (r < I_KV) { transpose_item<2, false>(A.in[I_WKV] + (size_t)l * 128 * 1024, nullptr, 128, 1024, nullptr, (bf16*)(wb + W_KV), scr, r, 32, lane); continue; } r -= I_KV;
        if (r < I_KVG) { transpose_item<2, true>(A.in[I_WKV] + (size_t)l * 128 * 1024, nullptr, 128, 1024, A.in[I_GKVL] + l * 128, (bf16*)(ws + WS_WKVG + (size_t)l * 262144), scr, r, 32, lane); continue; } r -= I_KVG;
        if (r < I_O) { transpose_item<5, true>(A.in[I_WO] + (size_t)l * 1024 * 1024, A.in[I_GOG] + l * 512, 1024, 1024, A.in[I_GOA] + l * 512, (bf16*)(wb + W_O), scr, r, 32, lane); continue; } r -= I_O;
        if (r < I_GU) { transpose_item<4, true>(A.in[I_WG] + (size_t)l * 1024 * DFF, A.in[I_WU] + (size_t)l * 1024 * DFF, 1024, DFF, A.in[I_GFFN] + l * 1024, (bf16*)(wb + W_GU), scr, r, 176, lane); continue; } r -= I_GU;
        transpose_item<3, false>(A.in[I_WD] + (size_t)l * DFF * 1024, nullptr, DFF, 1024, nullptr, (bf16*)(wb + W_D), scr, r, 32, lane);
    }
}
__device__ __forceinline__ void convert_cache(const Args& A, unsigned char* ws, int l, int tix, int ntx) {
    for (int i0 = tix; i0 < MC * 16; i0 += 4 * ntx) { f32x4 a[4], b[4];
#pragma unroll
        for (int u = 0; u < 4; ++u) { const int i = i0 + u * ntx; if (i < MC * 16) { const float* s = A.in[I_CCKV] + ((size_t)l * MC + (i >> 4)) * 128 + (i & 15) * 8; a[u] = *(const f32x4*)s; b[u] = *(const f32x4*)(s + 4); } }
#pragma unroll
        for (int u = 0; u < 4; ++u) { const int i = i0 + u * ntx; if (i < MC * 16) { u32x4 o; o.x = pk2(a[u][0], a[u][1]); o.y = pk2(a[u][2], a[u][3]); o.z = pk2(b[u][0], b[u][1]); o.w = pk2(b[u][2], b[u][3]);
            *(u32x4*)(ws + WS_CKVA + (size_t)l * L_CKVA + ((size_t)(MT + (i >> 4)) * 128 + (i & 15) * 8) * 2) = o; } } }
    for (int i = tix; i < MC * 4; i += ntx) { const int r = i >> 2, c0 = (i & 3) * 8;
        const float* s = A.in[I_CKR] + ((size_t)l * MC + r) * 32 + c0; const f32x4 a = *(const f32x4*)s, b = *(const f32x4*)(s + 4);
        u32x4 o; o.x = pk2(a[0], a[1]); o.y = pk2(a[2], a[3]); o.z = pk2(b[0], b[1]); o.w = pk2(b[2], b[3]);
        *(u32x4*)(ws + WS_KR + (size_t)l * L_KR + ((size_t)(MT + r) * 32 + c0) * 2) = o; }
}
__device__ __forceinline__ void p0_prologue(const Args& A, unsigned char* ws, LAS unsigned char* lds, int vcu, int G, int wave, int lane, int tid) {
    LAS float* scr = (LAS float*)(lds + wave * 16384);
    const int gw = vcu * 8 + wave, NGW = G * 8;
#ifdef NO_DEFER
    convert_items(A, ws, scr, 0, 2 * I_LAYER, gw, NGW, lane);
#else
    convert_items(A, ws, scr, 0, I_EARLY, gw, NGW, lane);
#endif
    const int gt = vcu * 512 + tid, NGT = G * 512;
    for (int i = gt; i < 2 * 8 * 128 * 16; i += NGT) { const int l = i >> 14, rem = i & 16383, gi = rem >> 4, j0 = (rem & 15) * 8, ii = gi & 127;
        const float* s = A.in[I_WS] + (size_t)l * 131072 + (size_t)gi * 128 + j0; const bool vis = (ii >> 6) >= (j0 >> 6);
        const f32x4 a = *(const f32x4*)s, b = *(const f32x4*)(s + 4);
        u32x4 o; o.x = pk2(a[0], a[1]); o.y = pk2(a[2], a[3]); o.z = pk2(b[0], b[1]); o.w = pk2(b[2], b[3]); if (!vis) o = (u32x4){0u, 0u, 0u, 0u};
        *(u32x4*)(ws + WS_W + (size_t)l * LW + W_S + ((size_t)gi * 128 + j0) * 2) = o; }
#ifdef NO_DEFER
    convert_cache(A, ws, 0, gt, NGT); convert_cache(A, ws, 1, gt, NGT);
#endif
    for (int i = gt; i < 2112 * 16; i += NGT) { const int pi = i >> 4, j = i & 15; const int pos = pi < 2048 ? pi : 4096 + (pi - 2048);
        const float inv = __builtin_amdgcn_exp2f(-(float)j * (13.287712379549449f / 16.0f)); const float ang = (float)pos * inv;
        const double t = (double)ang * 0.15915494309189535; const float fr = (float)(t - __builtin_rint(t));
        f32x2 cs; cs.x = __builtin_amdgcn_cosf(fr); cs.y = __builtin_amdgcn_sinf(fr);
        *(f32x2*)(ws + WS_ROPE + (size_t)i * 8) = cs; }
    bf16* XB = (bf16*)(ws + B_XB); float* ssq0 = (float*)(ws + WS_CTL + CTL_SSQ);
    for (int mp = gw; mp < MT / 2; mp += NGW) {
        f32x4 v[2][4];
#pragma unroll
        for (int u = 0; u < 2; ++u) { const int m = 2 * mp + u; const float* xr = (m < MP) ? A.in[I_XP] + (size_t)m * 1024 : A.in[I_XS] + (size_t)(m - MP) * 1024;
#pragma unroll
            for (int j = 0; j < 4; ++j) v[u][j] = *(const f32x4*)(xr + 256 * j + 4 * lane); }
#pragma unroll
        for (int u = 0; u < 2; ++u) { const int m = 2 * mp + u; float s = 0.f;
#pragma unroll
            for (int j = 0; j < 4; ++j) { s += dot4v(v[u][j]); u32x2 w; w.x = pk2(v[u][j][0], v[u][j][1]); w.y = pk2(v[u][j][2], v[u][j][3]); *(u32x2*)(XB + (size_t)m * 1024 + 256 * j + 4 * lane) = w; }
            s = wave_sum(s); if (lane == 0) ssq0[m] = s; } }
}

struct P2Ptrs { const bf16* Z; bf16* MRG; bf16* CKVA; bf16* KR; bf16* VN; const float* rope; float* out;
                const float* gql; const float* gkvl; const float* gkr; const float* lng; const float* lnb; };
__device__ __forceinline__ void p2_rows8(const P2Ptrs& P, int l, int m0, int lane) {
    const int j = lane & 7, m = m0 + (lane >> 3);
    const bf16* z = P.Z + (size_t)m * NZ;
    const u32x4 c0 = *(const u32x4*)(z + 256 + 16 * j), c1 = *(const u32x4*)(z + 256 + 16 * j + 8);
    const u32x2 kw = *(const u32x2*)(z + 384 + 4 * j);
    const bool smp = m >= MP; const int ms = m - MP; const int posidx = smp ? 2048 + (ms & 63) : (m & 2047);
    { f32x4 c[4] = {(f32x4){bflo(c0.x), bfhi(c0.x), bflo(c0.y), bfhi(c0.y)}, (f32x4){bflo(c0.z), bfhi(c0.z), bflo(c0.w), bfhi(c0.w)},
                    (f32x4){bflo(c1.x), bfhi(c1.x), bflo(c1.y), bfhi(c1.y)}, (f32x4){bflo(c1.z), bfhi(c1.z), bflo(c1.w), bfhi(c1.w)}};
      const float ss = sum8((dot4v(c[0]) + dot4v(c[1])) + (dot4v(c[2]) + dot4v(c[3]))); const float rn = rsq(ss * (1.0f / 128.0f) + EPS);
      float* o = (smp ? P.out + O_CKVS + ((size_t)l * MS + ms) * 128 : P.out + O_CKVP + ((size_t)l * MP + m) * 128) + 16 * j;
#pragma unroll
      for (int q = 0; q < 4; ++q) { c[q] = c[q] * rn * *(const f32x4*)(P.gkvl + 16 * j + 4 * q); *(f32x4*)(o + 4 * q) = c[q]; }
      if (smp) { u32x4 w0, w1;
          w0.x = pk2(c[0][0], c[0][1]); w0.y = pk2(c[0][2], c[0][3]); w0.z = pk2(c[1][0], c[1][1]); w0.w = pk2(c[1][2], c[1][3]);
          w1.x = pk2(c[2][0], c[2][1]); w1.y = pk2(c[2][2], c[2][3]); w1.z = pk2(c[3][0], c[3][1]); w1.w = pk2(c[3][2], c[3][3]);
          bf16* cp = P.CKVA + (size_t)m * 128 + 16 * j; *(u32x4*)cp = w0; *(u32x4*)(cp + 8) = w1; } }
    { const f32x4 k = {bflo(kw.x), bfhi(kw.x), bflo(kw.y), bfhi(kw.y)};
      const float ss = sum8(dot4v(k)); const float rn = rsq(ss * (1.0f / 32.0f) + EPS);
      const f32x4 own = k * rn * *(const f32x4*)(P.gkr + 4 * j);
      f32x4 oth; oth[0] = SWZ_XOR(own[0], 4); oth[1] = SWZ_XOR(own[1], 4); oth[2] = SWZ_XOR(own[2], 4); oth[3] = SWZ_XOR(own[3], 4);
      const float* rp = P.rope + (size_t)(posidx * 16 + 4 * (j & 3)) * 2;
      const f32x4 cs0 = *(const f32x4*)rp, cs1 = *(const f32x4*)(rp + 4);
      const f32x4 cc = {cs0[0], cs0[2], cs1[0], cs1[2]}, sn = {cs0[1], cs0[3], cs1[1], cs1[3]};
      const f32x4 o = (j < 4) ? own * cc - oth * sn : oth * sn + own * cc;
      float* ok = (smp ? P.out + O_KRS + ((size_t)l * MS + ms) * 32 : P.out + O_KRP + ((size_t)l * MP + m) * 32) + 4 * j;
      *(f32x4*)ok = o;
      u32x2 w; w.x = pk2(o[0], o[1]); w.y = pk2(o[2], o[3]); *(u32x2*)(P.KR + (size_t)m * 32 + 4 * j) = w; }
}

#ifndef REP_P0
#define REP_P0 1
#endif
#ifndef REP_P1
#define REP_P1 1
#endif
#ifndef REP_P2
#define REP_P2 1
#endif
#ifndef REP_P3
#define REP_P3 1
#endif
#ifndef REP_P4A
#define REP_P4A 1
#endif
#ifndef REP_P4B
#define REP_P4B 1
#endif
#ifndef REP_P6
#define REP_P6 1
#endif
#ifndef REP_BAR
#define REP_BAR 1
#endif
template <class T> __device__ __forceinline__ T* as_global(T* p) {
#if defined(__HIP_DEVICE_COMPILE__)
    __builtin_assume(!__builtin_amdgcn_is_shared((const __attribute__((address_space(0))) void*)p));
    __builtin_assume(!__builtin_amdgcn_is_private((const __attribute__((address_space(0))) void*)p));
#endif
    return p;
}
#define FRESH_TID() unsigned z_p = 0u; asm volatile("" : "+v"(z_p)); const int lane_p = (int)__builtin_amdgcn_mbcnt_hi(~0u, __builtin_amdgcn_mbcnt_lo(~0u, z_p)); const int tid_p = wave * 64 + lane_p
#define FRESH_PTRS() size_t zo_p = 0; asm volatile("" : "+s"(zo_p)); \
    unsigned char* ws = args.ws + zo_p; float* out = args.out + zo_p;     \
    int G = gridDim.x, bx = blockIdx.x; asm volatile("" : "+s"(G), "+s"(bx)); const int vcu = (G % 8 == 0) ? (bx % 8) * (G / 8) + bx / 8 : bx; (void)vcu; (void)out
#define GRID_BAR() for (int repb_ = 0; repb_ < REP_BAR; ++repb_) do { size_t zo_b = 0; asm volatile("" : "+s"(zo_b)); unsigned char* wsb = args.ws + zo_b; XcdBarrier bar_; bar_.bar = (unsigned*)(wsb + WS_CTL) + CW_BAR; bar_.x = 0; bar_.st = (volatile LAS unsigned*)(lds + MISC_OFF) + 8; xcd_barrier(bar_, wave); } while (0)
#ifdef PROBE_STAMPS
#define STAMP(k) do { if (blockIdx.x == 0 && wave == 0) { const unsigned long long t_ = __builtin_amdgcn_s_memrealtime(); volatile LAS unsigned* m_ = (volatile LAS unsigned*)(lds + MISC_OFF) + 16 + 2 * (k); \
        if (xb_first_thread(wave)) { m_[0] = (unsigned)t_; m_[1] = (unsigned)(t_ >> 32); } } } while (0)
#define STAMPG(k, blk) do { if ((int)blockIdx.x == (blk) && wave == 0) { const unsigned long long t_ = __builtin_amdgcn_s_memrealtime(); \
        if (xb_first_thread(wave)) __hip_atomic_store((unsigned long long*)(args.ws + WS_CTL + 983040) + (k), t_, __ATOMIC_RELAXED, __HIP_MEMORY_SCOPE_AGENT); } } while (0)
#define STAMPW(q) do { if (wave == 0) { const unsigned long long t_ = __builtin_amdgcn_s_memrealtime(); \
        if (xb_first_thread(wave)) __hip_atomic_store((unsigned long long*)(args.ws + WS_CTL + 983040 + 1024) + (q) * 256 + blockIdx.x, t_, __ATOMIC_RELAXED, __HIP_MEMORY_SCOPE_AGENT); } } while (0)
#else
#define STAMP(k) do {} while (0)
#define STAMPG(k, blk) do {} while (0)
#define STAMPW(q) do {} while (0)
#endif
__global__ void __launch_bounds__(512, 2) hybrid_fwd(Args args) {
    extern __shared__ __attribute__((aligned(16))) unsigned char lds_raw[];
    LAS unsigned char* lds = (LAS unsigned char*)lds_raw;
    const int wave = __builtin_amdgcn_readfirstlane(threadIdx.x >> 6);
    { FRESH_TID(); for (int u = tid_p; u < (LDS_BYTES - RING_BYTES) / 4; u += 512) ((LAS unsigned*)(lds + RING_BYTES))[u] = 0u; }
    __syncthreads();
    { FRESH_PTRS(); (void)xcd_barrier_post((unsigned*)(ws + WS_CTL) + CW_BAR, (volatile LAS unsigned*)(lds + MISC_OFF) + 8, wave); }

    STAMP(0);
#ifndef NO_P0
    asm volatile("; MARK_P0");
    for (int rep_ = 0; rep_ < REP_P0; ++rep_) { FRESH_TID(); FRESH_PTRS(); p0_prologue(args, ws, lds, vcu, G, wave, lane_p, tid_p); }
#endif
    STAMPW(0); GRID_BAR();
        STAMP(1);

    for (int l = 0; l < NLAYER; ++l) {
#ifndef NO_P1
        asm volatile("; MARK_P1");
        for (int rep_ = 0; rep_ < REP_P1; ++rep_) { FRESH_PTRS(); unsigned char* wb = ws + WS_W + (size_t)l * LW;
          pg8::Gemm g{(const bf16*)(ws + B_XB), (const bf16*)(wb + W_IN), MT, NZ, 1024, 1024};
          OwnerOrder6 S; S.init(G, bx, l == NLAYER - 1 ? (unsigned*)(ws + WS_CTL + CTL_CNT1) : nullptr);
          pg8::EpiZ E{(bf16*)(ws + B_Z), (const float*)(ws + WS_CTL + CTL_SSQ) + (size_t)(2 * l) * MT, (bf16*)(ws + B_MRG), (bf16*)(ws + B_VN), out + O_GVS + (size_t)l * MS * 512, args.in[I_LNG] + l * 512, args.in[I_LNB] + l * 512,
                      (float*)(ws + WS_CTL + CTL_SSQQ) + (size_t)l * MT, (float*)(ws + WS_CTL + CTL_SSQC) + (size_t)l * MT, ws, l == NLAYER - 1 ? 1 : 0};
          pg8::gemm_phase<pg8::EpiZ, OwnerOrder6, true, true>(lds, g, S, E, wave); STAMPG(16 + l, 0); STAMPG(18 + l, 200);
          if (l == 1 && S.idle()) {
              const int T = S.idle_index();
              pg8::Gemm g3{(const bf16*)(ws + WS_CKVA + (size_t)l * L_CKVA) + (size_t)MT * 128, (const bf16*)(wb + W_KV), MC, 512, 128, 128}; ListOrder S3{1, ((T >> 1) << 8) | (T & 1), 0, 0};
              pg8::EpiKV E3{(bf16*)(ws + B_KN) + (size_t)MT * 512, (bf16*)(ws + B_VV) + (size_t)MT * 512, args.in[I_GKN] + l * 64, nullptr, ws};
              pg8::gemm_phase<pg8::EpiKV, ListOrder, true, true>(lds, g3, S3, E3, wave); }
#ifndef NO_DEFER
          if (l == 0 && S.idle()) { FRESH_TID(); const int idl = S.idle_index();
                                     convert_items(args, ws, (LAS float*)(lds + wave * 16384), I_EARLY, I_LAYER, idl * 8 + wave, 116 * 8, lane_p);
                                     convert_cache(args, ws, 0, idl * 512 + tid_p, 116 * 512); convert_cache(args, ws, 1, idl * 512 + tid_p, 116 * 512); }
#endif
          STAMPG(20 + l, 200);
          }
#endif
        STAMPW(1 + 6 * l); if (l != NLAYER - 1) GRID_BAR();
        STAMP(2 + 6 * l);
#ifndef NO_P3
        asm volatile("; MARK_P3");
        if (l != NLAYER - 1) {
        { FRESH_TID(); FRESH_PTRS(); if (bx >= 240) {
          P2Ptrs P{(const bf16*)(ws + B_Z), (bf16*)(ws + B_MRG), (bf16*)(ws + WS_CKVA + (size_t)l * L_CKVA), (bf16*)(ws + WS_KR + (size_t)l * L_KR), (bf16*)(ws + B_VN), (const float*)(ws + WS_ROPE), out,
                   args.in[I_GQL] + l * 256, args.in[I_GKVL] + l * 128, args.in[I_GKR] + l * 32, args.in[I_LNG] + l * 512, args.in[I_LNB] + l * 512};
          const int gw = (bx - 240) * 8 + wave, NGW = 16 * 8; for (int mg = gw; mg < MT / 8; mg += NGW) p2_rows8(P, l, 8 * mg, lane_p); } }
        STAMPG(36 + l, 0);
        { FRESH_PTRS(); if (bx < 66) { unsigned char* wb = ws + WS_W + (size_t)l * LW;
          pg8::Gemm g{(const bf16*)(ws + B_Z), (const bf16*)(wb + W_QUP), MT, 768, 256, NZ}; pg8::StaticOrder S; S.init(MT, 768, 66, bx);
          pg8::EpiQ E{(bf16*)(ws + B_QNP), (bf16*)(ws + B_QRP), args.in[I_GQN] + l * 64, args.in[I_GQR] + l * 32, (const float*)(ws + WS_ROPE), (const float*)(ws + WS_CTL + CTL_SSQQ) + (size_t)l * MT, ws};
          pg8::gemm_phase<pg8::EpiQ, pg8::StaticOrder, true, true>(lds, g, S, E, wave); } }
        STAMPG(38 + l, 0);
        asm volatile("; MARK_P3B");
        { FRESH_PTRS(); if (bx >= 66 && bx < 154) {
          pg8::Gemm g{(const bf16*)(ws + B_Z) + 256, (const bf16*)(ws + WS_WKVG + (size_t)l * 262144), MT, 1024, 128, NZ}; pg8::StaticOrder S; S.init(MT, 1024, 88, bx - 66);
          pg8::EpiKV E{(bf16*)(ws + B_KN), (bf16*)(ws + B_VV), args.in[I_GKN] + l * 64, (const float*)(ws + WS_CTL + CTL_SSQC) + (size_t)l * MT, ws};
          pg8::gemm_phase<pg8::EpiKV, pg8::StaticOrder, true, true>(lds, g, S, E, wave); } }
        STAMPG(40 + l, 0);
        { FRESH_PTRS(); if (bx >= 154 && bx < 240) { unsigned char* wb = ws + WS_W + (size_t)l * LW;
          pg8::Gemm g{(const bf16*)(ws + WS_CKVA + (size_t)l * L_CKVA) + (size_t)MT * 128, (const bf16*)(wb + W_KV), MC, 512, 128, 128}; pg8::StaticOrder S; S.init(MC, 512, 86, bx - 154);
          pg8::EpiKV E{(bf16*)(ws + B_KN) + (size_t)MT * 512, (bf16*)(ws + B_VV) + (size_t)MT * 512, args.in[I_GKN] + l * 64, nullptr, ws};
          pg8::gemm_phase<pg8::EpiKV, pg8::StaticOrder, true, true>(lds, g, S, E, wave); } }
        } else {
        int rowp = -1, nq = 0, q0 = 0, q1 = 0, nk = 0, k0 = 0, k1 = 0, k2 = 0, ownw = 0, smpw = 0, nc = 0, cc0 = 0, cc1 = 0;
        { FRESH_PTRS(); OwnerOrder6 O; O.init(G, bx, nullptr); const int pm = O.pm, j = O.j;
          if (pm >= 6) {
              if (j == 2) { rowp = pm; nq = 2; q0 = pm << 8; q1 = (pm << 8) | 1; nk = 1; k0 = pm << 8; ownw = 1; }
              else if (j == 3) { nq = 1; q0 = (pm << 8) | 2; nk = 3; k0 = (pm << 8) | 1; k1 = (pm << 8) | 2; k2 = (pm << 8) | 3; ownw = 1; }
              else { const int idx = 2 * (pm - 6) + j;
                  if (idx < 6) { nq = 1; q0 = ((64 + idx / 3) << 8) | (idx % 3); smpw = 1; }
                  else if (idx < 14) { nk = 1; k0 = ((64 + (idx - 6) / 4) << 8) | ((idx - 6) % 4); smpw = 1; }
                  else if (idx < 16) { rowp = 64 + (idx - 14); smpw = 1; }
                  else { const int e = idx - 16; int T = 116 + e; nc = 1; cc0 = ((T >> 1) << 8) | (T & 1); if (e < 40) { T = 216 + e; nc = 2; cc1 = ((T >> 1) << 8) | (T & 1); } } }
          } else {
              ownw = 1;
              if (j == 0) { rowp = pm; nq = 1; q0 = pm << 8; }
              else if (j == 1) { nq = 1; q0 = (pm << 8) | 1; nk = 1; k0 = pm << 8; }
              else if (j == 2) { nq = 1; q0 = (pm << 8) | 2; nk = 1; k0 = (pm << 8) | 1; }
              else { nk = 2; k0 = (pm << 8) | 2; k1 = (pm << 8) | 3; } }
          unsigned* cnt1 = (unsigned*)(ws + WS_CTL + CTL_CNT1); unsigned* barw = (unsigned*)(ws + WS_CTL) + CW_BAR;
          if (ownw) seam_wait(cnt1 + 16 * pm, cnt1 + 16 * pm, 16u, barw, wave);
          if (smpw) seam_wait(cnt1 + 16 * 64, cnt1 + 16 * 65, 16u, barw, wave); }
        if (rowp >= 0) { FRESH_TID(); FRESH_PTRS();
          P2Ptrs P{(const bf16*)(ws + B_Z), (bf16*)(ws + B_MRG), (bf16*)(ws + WS_CKVA + (size_t)l * L_CKVA), (bf16*)(ws + WS_KR + (size_t)l * L_KR), (bf16*)(ws + B_VN), (const float*)(ws + WS_ROPE), out,
                   args.in[I_GQL] + l * 256, args.in[I_GKVL] + l * 128, args.in[I_GKR] + l * 32, args.in[I_LNG] + l * 512, args.in[I_LNB] + l * 512};
          for (int mg = 32 * rowp + wave; mg < 32 * rowp + 32; mg += 8) p2_rows8(P, l, 8 * mg, lane_p); }
        if (nq > 0) { FRESH_PTRS(); unsigned char* wb = ws + WS_W + (size_t)l * LW;
          pg8::Gemm g{(const bf16*)(ws + B_Z), (const bf16*)(wb + W_QUP), MT, 768, 256, NZ}; ListOrder S{nq, q0, q1, 0};
          pg8::EpiQ E{(bf16*)(ws + B_QNP), (bf16*)(ws + B_QRP), args.in[I_GQN] + l * 64, args.in[I_GQR] + l * 32, (const float*)(ws + WS_ROPE), (const float*)(ws + WS_CTL + CTL_SSQQ) + (size_t)l * MT, ws};
          pg8::gemm_phase<pg8::EpiQ, ListOrder, true, true>(lds, g, S, E, wave); }
        if (nk > 0) { FRESH_PTRS();
          pg8::Gemm g{(const bf16*)(ws + B_Z) + 256, (const bf16*)(ws + WS_WKVG + (size_t)l * 262144), MT, 1024, 128, NZ}; ListOrder S{nk, k0, k1, k2};
          pg8::EpiKV E{(bf16*)(ws + B_KN), (bf16*)(ws + B_VV), args.in[I_GKN] + l * 64, (const float*)(ws + WS_CTL + CTL_SSQC) + (size_t)l * MT, ws};
          pg8::gemm_phase<pg8::EpiKV, ListOrder, true, true>(lds, g, S, E, wave); }
        if (nc > 0) { FRESH_PTRS(); unsigned char* wb = ws + WS_W + (size_t)l * LW;
          pg8::Gemm g{(const bf16*)(ws + WS_CKVA + (size_t)l * L_CKVA) + (size_t)MT * 128, (const bf16*)(wb + W_KV), MC, 512, 128, 128}; ListOrder S{nc, cc0, cc1, 0};
          pg8::EpiKV E{(bf16*)(ws + B_KN) + (size_t)MT * 512, (bf16*)(ws + B_VV) + (size_t)MT * 512, args.in[I_GKN] + l * 64, nullptr, ws};
          pg8::gemm_phase<pg8::EpiKV, ListOrder, true, true>(lds, g, S, E, wave); }
        }
#endif
        STAMPW(2 + 6 * l); GRID_BAR();
        STAMP(3 + 6 * l);
#ifndef NO_P4
        asm volatile("; MARK_P4");
        { FRESH_TID(); FRESH_PTRS();
          att::Ptrs P{(const bf16*)(ws + B_QNP), (const bf16*)(ws + B_QRP), (const bf16*)(ws + B_KN), (const bf16*)(ws + B_VV), (const bf16*)(ws + WS_KR + (size_t)l * L_KR), (bf16*)(ws + B_MRG), args.in[I_GOA] + l * 512};
          const int bh = vcu >> 2, s = vcu & 3;
          const int par = bh & 1;
          if (par) att::sample_unit(P, (const bf16*)(ws + WS_CKVA + (size_t)l * L_CKVA), (const bf16*)(ws + WS_W + (size_t)l * LW + W_KV), vcu >> 5, (vcu >> 2) & 7, vcu & 3, (float*)(ws + WS_PART), (unsigned*)(ws + WS_CTL + CTL_SCNT) + l * 64, (LAS char*)lds, tid_p, lane_p, wave);
          att::prompt_unit(P, bh >> 3, bh & 7, 7 - s, (LAS char*)lds, tid_p, lane_p, wave);
          att::prompt_unit(P, bh >> 3, bh & 7, s, (LAS char*)lds, tid_p, lane_p, wave);
          STAMPG(22 + l, 0);
          if (!par) att::sample_unit(P, (const bf16*)(ws + WS_CKVA + (size_t)l * L_CKVA), (const bf16*)(ws + WS_W + (size_t)l * LW + W_KV), vcu >> 5, (vcu >> 2) & 7, vcu & 3, (float*)(ws + WS_PART), (unsigned*)(ws + WS_CTL + CTL_SCNT) + l * 64, (LAS char*)lds, tid_p, lane_p, wave);
#ifndef NO_P4C
          STAMPG(24 + l, 0);
          asm volatile("; MARK_P4C");
          { att::GmPtrs Gm{(const bf16*)(ws + B_VN), (bf16*)(ws + B_MRG), (const bf16*)(ws + WS_W + (size_t)l * LW + W_S), args.in[I_BS] + l * 1024, args.in[I_GOG] + l * 512};
                 att::gmlp_wg(Gm, vcu, (LAS char*)lds, tid_p, lane_p, wave); } STAMPG(34 + l, 0);
#endif
        }
#endif
        STAMPW(3 + 6 * l); GRID_BAR();
        STAMP(4 + 6 * l);
#ifndef NO_P5
        asm volatile("; MARK_P5");
        { FRESH_PTRS(); unsigned char* wb = ws + WS_W + (size_t)l * LW;
          pg8::Gemm g{(const bf16*)(ws + B_MRG), (const bf16*)(wb + W_O), MP, 1024, 1024, 1024}; pg8::StaticOrder S; S.init(MP, 1024, G, bx);
          pg8::EpiRes E{out, (bf16*)(ws + B_XB), (float*)(ws + WS_CTL + CTL_SSQ) + (size_t)(2 * l + 1) * MT, 0, ws, 1};
          pg8::gemm_phase<pg8::EpiRes, pg8::StaticOrder, true, true>(lds, g, S, E, wave); STAMPG(26 + l, 0);
          if (wave == 0) { pg8::Unit u; u.pm = 0; u.pn = 0; if (S.next(0, u) && xb_first_thread(wave)) (void)xb_add((unsigned*)(ws + WS_CTL + CTL_CNT5) + l * (66 * 16) + 16 * u.pm, 1u); }
          { FRESH_TID(); if (vcu < 256) sample_res_gemm<1024>((const bf16*)(ws + B_MRG), 1024, (const bf16*)(wb + W_O), out, E.XB, E.ssq, 0, 1, vcu, (LAS char*)lds, lane_p, wave); } STAMPG(30 + l, 0);
          if (xb_first_thread(wave)) (void)xb_add((unsigned*)(ws + WS_CTL + CTL_CNT5) + l * (66 * 16) + 16 * 64, 1u); }
#endif
        STAMPW(4 + 6 * l);
        STAMP(5 + 6 * l);
#ifndef NO_P6
        asm volatile("; MARK_P6");
        for (int rep_ = 0; rep_ < REP_P6; ++rep_) { FRESH_PTRS(); unsigned char* wb = ws + WS_W + (size_t)l * LW;
          pg8::Gemm g{(const bf16*)(ws + B_XB), (const bf16*)(wb + W_GU), MT, NGU, 1024, 1024};
          unsigned* cnt5 = (unsigned*)(ws + WS_CTL + CTL_CNT5) + l * (66 * 16); PanelOrder S; S.init(G, bx, cnt5 + 16 * 64, (unsigned*)(ws + WS_CTL) + CW_BAR, wave);
          seam_wait(cnt5 + 16 * S.pm, cnt5 + 16 * S.pm, 4u, (unsigned*)(ws + WS_CTL) + CW_BAR, wave);
          pg8::EpiGU E{(bf16*)(ws + B_H), (const float*)(ws + WS_CTL + CTL_SSQ) + (size_t)(2 * l + 1) * MT, ws};
          pg8::gemm_phase<pg8::EpiGU, PanelOrder, true, true>(lds, g, S, E, wave);
          }
        { FRESH_PTRS(); PanelOrder S2; S2.init(G, bx, nullptr, nullptr, wave);
          if (wave == 0) { unsigned* cnt6 = (unsigned*)(ws + WS_CTL + CTL_CNT6) + l * (66 * 16); pg8::Unit u; u.pm = 0; u.pn = 0; const bool t0_ = xb_first_thread(wave);
            for (int i = 0; S2.next(i, u); ++i) { if (t0_) (void)xb_add(cnt6 + 16 * u.pm, 1u); } }
#ifndef NO_DEFER
          if (l == 0 && S2.j >= 2 && S2.ks < 0) { FRESH_TID(); const int idle_ = 2 * (S2.pm - 22) + (S2.j - 2);
                                     convert_items(args, ws, (LAS float*)(lds + wave * 16384), I_LAYER, 2 * I_LAYER, idle_ * 8 + wave, 84 * 8, lane_p);
                                     }
#endif
          }
#endif
        STAMPW(5 + 6 * l);
        STAMP(6 + 6 * l);
#ifndef NO_P7
        asm volatile("; MARK_P7");
        { FRESH_PTRS(); unsigned* cnt6 = (unsigned*)(ws + WS_CTL + CTL_CNT6) + l * (66 * 16); pg8::StaticOrder S; S.init(MP, 1024, G, bx); pg8::Unit u0;
          if (G == 256 && S.next(0, u0)) seam_wait(cnt6 + 16 * u0.pm, cnt6 + 16 * u0.pm, 22u, (unsigned*)(ws + WS_CTL) + CW_BAR, wave);
          else { for (int p = 0; p < 66; p += 2) seam_wait(cnt6 + 16 * p, cnt6 + 16 * (p + 1), 22u, (unsigned*)(ws + WS_CTL) + CW_BAR, wave); } }
        { FRESH_PTRS(); unsigned char* wb = ws + WS_W + (size_t)l * LW;
          pg8::Gemm g{(const bf16*)(ws + B_H), (const bf16*)(wb + W_D), MP, 1024, DFF, DFF}; pg8::StaticOrder S; S.init(MP, 1024, G, bx);
          pg8::EpiRes E{out, (bf16*)(ws + B_XB), (float*)(ws + WS_CTL + CTL_SSQ) + (size_t)(2 * l + 2) * MT, l == NLAYER - 1 ? 1 : 0, ws, 0};
          pg8::gemm_phase<pg8::EpiRes, pg8::StaticOrder, true, true>(lds, g, S, E, wave); STAMPG(28 + l, 0); }
        { FRESH_PTRS(); unsigned* cnt6 = (unsigned*)(ws + WS_CTL + CTL_CNT6) + l * (66 * 16);
          seam_wait(cnt6 + 16 * 64, cnt6 + 16 * 65, 22u, (unsigned*)(ws + WS_CTL) + CW_BAR, wave); }
        { FRESH_PTRS(); unsigned char* wb = ws + WS_W + (size_t)l * LW; pg8::EpiRes E{out, (bf16*)(ws + B_XB), (float*)(ws + WS_CTL + CTL_SSQ) + (size_t)(2 * l + 2) * MT, l == NLAYER - 1 ? 1 : 0, ws, 0};
          { FRESH_TID(); if (vcu < 256) sample_res_gemm<DFF>((const bf16*)(ws + B_H), DFF, (const bf16*)(wb + W_D), out, E.XB, E.ssq, E.final_f32, 0, vcu, (LAS char*)lds, lane_p, wave); } STAMPG(32 + l, 0); }
#endif
        STAMPW(6 + 6 * l); if (l + 1 < NLAYER) GRID_BAR();
        STAMP(7 + 6 * l);
    }
#ifdef PROBE_STAMPS
#ifdef PROBE_MODE
    GRID_BAR();
    if (blockIdx.x == 0 && wave == 0) { volatile LAS unsigned* m_ = (volatile LAS unsigned*)(lds + MISC_OFF) + 16;
        auto rdl = [&](int k) { return (((unsigned long long)m_[2 * k + 1] << 32) | m_[2 * k]); };
        unsigned z_q = 0u; asm volatile("" : "+v"(z_q)); const int lane = (int)__builtin_amdgcn_mbcnt_hi(~0u, __builtin_amdgcn_mbcnt_lo(~0u, z_q)); int total = 0;
        volatile LAS int* sc = (volatile LAS int*)lds;
        _Pragma("unroll 1") for (int q = 0; q < 13; ++q) { if (!((PROBE_QMASK >> q) & 1)) continue;
            const unsigned long long st = rdl(q), en = (q == 12) ? rdl(13) : rdl(q + 1);
            int mx = -(1 << 30), mn = 1 << 30, sm = 0;
            for (int j = 0; j < 4; ++j) { const unsigned long long t = __hip_atomic_load((unsigned long long*)(args.ws + WS_CTL + 983040 + 1024) + q * 256 + lane * 4 + j, __ATOMIC_RELAXED, __HIP_MEMORY_SCOPE_AGENT);
                const int d = (int)(long long)(t - st); mx = d > mx ? d : mx; mn = d < mn ? d : mn; sm += d; }
            sc[lane] = mx; sc[64 + lane] = mn; sc[128 + lane] = sm;
            __builtin_amdgcn_s_waitcnt(0); __builtin_amdgcn_wave_barrier();
            int MX = -(1 << 30), MN = 1 << 30; int SM = 0;
            for (int j = 0; j < 64; ++j) { const int a_ = sc[j], b_ = sc[64 + j]; MX = a_ > MX ? a_ : MX; MN = b_ < MN ? b_ : MN; SM += sc[128 + j]; }
            __builtin_amdgcn_wave_barrier();
            const int mean = SM >> 8, len = (int)(long long)(en - st);
            int v = 0;
            if (PROBE_MODE == 1) v = MX - mean; else if (PROBE_MODE == 2) v = len - MX; else if (PROBE_MODE == 3) v = MX - MN; else if (PROBE_MODE == 4) v = mean; else if (PROBE_MODE == 5) v = MN; else if (PROBE_MODE == 6) v = len;
            total += v > 0 ? v : 0; }
        const unsigned long long now = __builtin_amdgcn_s_memrealtime();
        const unsigned long long until = now + (unsigned long long)PROBE_MULT * (unsigned long long)total;
        while (__builtin_amdgcn_s_memrealtime() < until) __builtin_amdgcn_s_sleep(8); }
#else
    if (blockIdx.x == 0 && wave == 0) { volatile LAS unsigned* m_ = (volatile LAS unsigned*)(lds + MISC_OFF) + 16;
        auto rd = [&](int k) { return k >= 16 ? __hip_atomic_load((unsigned long long*)(args.ws + WS_CTL + 983040) + k, __ATOMIC_RELAXED, __HIP_MEMORY_SCOPE_AGENT) : (((unsigned long long)m_[2 * k + 1] << 32) | m_[2 * k]); };
        const unsigned long long now = __builtin_amdgcn_s_memrealtime();
        const unsigned long long e1 = (PROBE_B1 == 14) ? now : rd(PROBE_B1), e2 = (PROBE_B2 == 14) ? now : rd(PROBE_B2);
        const unsigned long long span = (e1 - rd(PROBE_A1)) + (e2 - rd(PROBE_A2));
        const unsigned long long until = now + (unsigned long long)PROBE_MULT * span;
        while (__builtin_amdgcn_s_memrealtime() < until) __builtin_amdgcn_s_sleep(8); }
#endif
#endif
}

extern "C" void kernel_launch(void* const* d_in, const int* in_sizes, int n_in, void* d_out, int out_size, void* d_ws, size_t ws_size, hipStream_t stream) {
    static int grid = 0;
    if (grid == 0) {
        #ifdef PROBE_WSMIN
        if (ws_size < (size_t)PROBE_WSMIN * MiB) { grid = -1; return; }
#endif
        if (n_in != 25 || (size_t)out_size != O_END || ws_size < WS_END) { fprintf(stderr, "kernel_launch: unexpected shapes (n_in %d, out %d, ws %zu); nothing launched\n", n_in, out_size, ws_size); grid = -1; return; }
        int dev = 0, cus = 0, per_cu = 0;
        if (hipGetDevice(&dev) != hipSuccess || hipDeviceGetAttribute(&cus, hipDeviceAttributeMultiprocessorCount, dev) != hipSuccess) { grid = -1; return; }
        if (hipFuncSetAttribute((const void*)hybrid_fwd, hipFuncAttributeMaxDynamicSharedMemorySize, LDS_BYTES) != hipSuccess) { fprintf(stderr, "kernel_launch: hipFuncSetAttribute failed\n"); grid = -1; return; }
        if (hipOccupancyMaxActiveBlocksPerMultiprocessor(&per_cu, (const void*)hybrid_fwd, 512, LDS_BYTES) != hipSuccess || per_cu < 1) { fprintf(stderr, "kernel_launch: occupancy query reports %d blocks per CU\n", per_cu); (void)hipGetLastError(); grid = -1; return; }
        if (cus < 256) { fprintf(stderr, "kernel_launch: built for a 256-CU device (found %d CUs); nothing launched\n", cus); grid = -1; return; }
        grid = 256;
    }
    if (grid < 0) return;
    if (hipMemsetAsync((char*)d_ws + WS_CTL, 0, CTL_ZERO_BYTES, stream) != hipSuccess) return;
    Args a{};
    for (int i = 0; i < 25; ++i) a.in[i] = (const float*)d_in[i];
    a.out = (float*)d_out; a.ws = (unsigned char*)d_ws;
    hipLaunchKernelGGL(hybrid_fwd, dim3(grid), dim3(512), LDS_BYTES, stream, a);
}
```

```cpp
#include <hip/hip_runtime.h>
#include <cstdio>
#include <cstdint>

#define LAS __attribute__((address_space(3)))
#define GAS __attribute__((address_space(1)))
typedef unsigned short bf16;
typedef short bf16x8 __attribute__((ext_vector_type(8)));
typedef short s16x4 __attribute__((ext_vector_type(4)));
typedef float f32x4 __attribute__((ext_vector_type(4)));
typedef float f32x2 __attribute__((ext_vector_type(2)));
typedef float f32x16 __attribute__((ext_vector_type(16)));
typedef unsigned u32x4 __attribute__((ext_vector_type(4)));
typedef unsigned u32x2 __attribute__((ext_vector_type(2)));
typedef __bf16 bf16x2_t __attribute__((ext_vector_type(2)));

constexpr int DM = 1024, MP = 16384, MS = 512, MT = MP + MS  , MC = 32768  , MA = MT + MC;
constexpr int NZ = 1536, DFF = 2816, NGU = 5632;
constexpr int NLAYER = 2;
constexpr float EPS = 1e-6f;
constexpr float QSCALE = 0.10206207261596577f * 1.4426950408889634f;

constexpr size_t O_Y = 0, O_CKVP = (size_t)MT * 1024, O_KRP = O_CKVP + (size_t)2 * MP * 128, O_CKVS = O_KRP + (size_t)2 * MP * 32,
                 O_KRS = O_CKVS + (size_t)2 * MS * 128, O_GVS = O_KRS + (size_t)2 * MS * 32, O_END = O_GVS + (size_t)2 * MS * 512;

constexpr size_t MiB = 1u << 20;
constexpr size_t WS_CTL = 0, CTL_ZERO_BYTES = 1 * MiB;
constexpr int CW_BAR = 4096;
constexpr size_t CTL_SSQ = 65536;
constexpr size_t WS_W = 1 * MiB, LW = 23461888;
constexpr size_t W_IN = 0, W_QUP = 3145728, W_KV = W_QUP + 393216, W_O = W_KV + 262144, W_GU = W_O + 2097152, W_D = W_GU + 11534336, W_S = W_D + 5767168;
static_assert(W_S + 262144 == LW, "weight block");
constexpr size_t WS_CKVA = WS_W + 2 * LW, L_CKVA = (size_t)MA * 128 * 2;
constexpr size_t WS_KR = WS_CKVA + 2 * L_CKVA, L_KR = (size_t)MA * 32 * 2;
constexpr size_t WS_ROPE = WS_KR + 2 * L_KR;
constexpr size_t WS_PART = 153 * MiB / 2, PART_BYTES = (size_t)64 * 4 * 2 * 34 * 64 * 4;
constexpr size_t WS_BIG = 324 * MiB / 4 - MiB / 4;
constexpr size_t CTL_SCNT = 32768;
constexpr size_t CTL_CNT5 = 49152;
constexpr size_t CTL_CNT1 = 57600;
constexpr size_t CTL_CNT6 = 36864;
constexpr size_t CTL_SSQQ = 524288, CTL_SSQC = CTL_SSQQ + 2 * (size_t)MT * 4;
constexpr size_t B_KN = WS_BIG, B_VV = B_KN + (size_t)MA * 512 * 2, B_QNP = B_VV + (size_t)MA * 512 * 2, B_QRP = B_QNP + (size_t)MT * 512 * 2,
                 B_VN = B_QRP + (size_t)MT * 256 * 2, B_MRG = B_VN + (size_t)MT * 512 * 2, B_MRG_END = B_MRG + (size_t)MT * 1024 * 2;
constexpr size_t B_H = WS_BIG, B_H_END = B_H + (size_t)MT * DFF * 2;
static_assert(B_H_END <= B_VN, "H must end below VN / MRG");
constexpr size_t B_XB = 256 * MiB;
constexpr size_t WS_WKVG = B_XB + (size_t)MT * 2048;
constexpr size_t B_Z = WS_WKVG + 2 * 262144;
constexpr size_t WS_END = B_Z + (size_t)MT * NZ * 2;
static_assert(WS_ROPE + 2112 * 16 * 8 <= WS_PART && WS_PART + PART_BYTES <= WS_BIG && WS_BIG % 65536 == 0 && WS_PART % 65536 == 0, "ws map 1");
static_assert(B_MRG_END <= B_XB && B_H_END <= B_XB && B_XB + (size_t)MT * 2048 <= WS_END, "ws map 2");
static_assert(B_Z >= B_XB + (size_t)MT * 2048, "Z above XB");
static_assert(CTL_SSQ + 5 * (size_t)MT * 4 <= CTL_SSQQ && CTL_SSQC + 2 * (size_t)MT * 4 <= CTL_ZERO_BYTES, "ssq arrays inside the memset region");

constexpr int RING_BYTES = 131072, LDS_BYTES = 147456, MISC_OFF = LDS_BYTES - 256;

__device__ __forceinline__ unsigned pk2(float lo, float hi) { f32x2 v = {lo, hi}; bf16x2_t b = __builtin_convertvector(v, bf16x2_t); return __builtin_bit_cast(unsigned, b); }
__device__ __forceinline__ float bflo(unsigned w) { return __uint_as_float(w << 16); }
__device__ __forceinline__ float bfhi(unsigned w) { return __uint_as_float(w & 0xffff0000u); }
#define SWZ_XOR(v, m) __int_as_float(__builtin_amdgcn_ds_swizzle(__float_as_int(v), ((m) << 10) | 0x1f))
__device__ __forceinline__ float sum16(float v) { return v + __int_as_float(__builtin_amdgcn_ds_swizzle(__float_as_int(v), 0x401F)); }
__device__ __forceinline__ float sum32(float v) { auto r = __builtin_amdgcn_permlane32_swap(__float_as_uint(v), __float_as_uint(v), false, false); return __uint_as_float(r[0]) + __uint_as_float(r[1]); }
__device__ __forceinline__ float max32(float v) { auto r = __builtin_amdgcn_permlane32_swap(__float_as_uint(v), __float_as_uint(v), false, false); return fmaxf(__uint_as_float(r[0]), __uint_as_float(r[1])); }
__device__ __forceinline__ float sum8(float v) { v += SWZ_XOR(v, 1); v += SWZ_XOR(v, 2); v += SWZ_XOR(v, 4); return v; }
__device__ __forceinline__ float wave_sum(float v) { v = sum8(v); v += SWZ_XOR(v, 8); v += SWZ_XOR(v, 16); return sum32(v); }
__device__ __forceinline__ float dot4v(const f32x4 a) { return (a[0] * a[0] + a[1] * a[1]) + (a[2] * a[2] + a[3] * a[3]); }
__device__ __forceinline__ float rsq(float x) { return __builtin_amdgcn_rsqf(x); }
__device__ __forceinline__ float gelu_tanh(float x) {
    const float u2 = 1.5957691216057308f * (x + 0.044715f * x * x * x);
    return x * __builtin_amdgcn_rcpf(1.0f + __builtin_amdgcn_exp2f(-1.4426950408889634f * u2));
}
__device__ __forceinline__ float silu_f(float x) { return x * __builtin_amdgcn_rcpf(1.0f + __builtin_amdgcn_exp2f(-1.4426950408889634f * x)); }
#ifndef NO_WT
__device__ __forceinline__ void st16wt(const void* base, void* p, u32x4 v) {
    __builtin_amdgcn_raw_buffer_store_b128(v, __builtin_amdgcn_make_buffer_rsrc((void*)base, 0, 0x7fffffff, 0x00027000), (int)((const char*)p - (const char*)base), 0, 0x11);
}
__device__ __forceinline__ void st8wt(const void* base, void* p, f32x2 v) {
    __builtin_amdgcn_raw_buffer_store_b64(__builtin_bit_cast(u32x2, v), __builtin_amdgcn_make_buffer_rsrc((void*)base, 0, 0x7fffffff, 0x00027000), (int)((const char*)p - (const char*)base), 0, 0x11);
}
__device__ __forceinline__ void st8wtu(const void* base, void* p, u32x2 v) { st8wt(base, p, __builtin_bit_cast(f32x2, v)); }
#else
__device__ __forceinline__ void st8wtu(const void* base, void* p, u32x2 v) { (void)base; *(u32x2*)p = v; }
__device__ __forceinline__ void st16wt(const void* base, void* p, u32x4 v) { (void)base; *(u32x4*)p = v; }
__device__ __forceinline__ void st8wt(const void* base, void* p, f32x2 v) { (void)base; *(f32x2*)p = v; }
#endif
#ifdef WT_ALL
#define st16pl st16wt
#else
__device__ __forceinline__ void st16pl(const void* base, void* p, u32x4 v) { (void)base; *(u32x4*)p = v; }
#endif
namespace pg8 {
#define PG8_LAS __attribute__((address_space(3)))
typedef unsigned short bf16_t;
constexpr int BM = 256, BK = 64, HALF = 128, HTB = HALF * BK * 2  , STAGE_BYTES = 8 * HTB, NXCD = 8, WGM = 8;

__host__ __device__ __forceinline__ int lds_byte(int r, int c) { const int st = (r >> 4) * 2 + (c >> 5), rr = r & 15, cc = c & 31, ob = rr * 64 + cc * 2; return st * 1024 + (ob ^ (((ob >> 9) & 1) << 5)); }
__host__ __device__ __forceinline__ void stage_rc(int b, int& R, int& C) { const int st = b / 1024, sb = b % 1024, swz = sb ^ (((sb >> 9) & 1) << 5); R = (st >> 1) * 16 + swz / 64; C = (st & 1) * 32 + (swz % 64) / 2; }
__host__ __device__ __forceinline__ int perm32(int rho) { const int n = rho >> 4, i = rho & 15; return 8 * (i >> 2) + 4 * n + (i & 3); }

struct Unit { int pm, pn; };
struct Gemm { const bf16_t* A; const bf16_t* Bt; int M, N, K, lda; };

struct StaticOrder {
    int nM, nN, nwg, G, c, i0 = 0, i1 = 1 << 20;
    __host__ __device__ __forceinline__ void init(int M, int N, int G_, int c_) { nM = M / BM; nN = N / BM; nwg = nM * nN; G = G_; c = c_; }
    __host__ __device__ __forceinline__ bool next(int i_, Unit& u) const {
        const int i = i_ + i0; if (i >= i1) return false;
        const long L = (long)i * G + c; if (L >= nwg) return false;
        int wgid = (int)L; { const int q = nwg / NXCD, r = nwg % NXCD, xcd = wgid % NXCD, off = wgid / NXCD; wgid = (xcd < r ? xcd * (q + 1) : r * (q + 1) + (xcd - r) * q) + off; }
        const int nig = WGM * nN, gid = wgid / nig, fm = gid * WGM, gsz = (nM - fm) < WGM ? (nM - fm) : WGM;
        u.pm = fm + ((wgid % nig) % gsz); u.pn = (wgid % nig) / gsz; return true;
    }
    __device__ __forceinline__ void a_ready(const Unit&) const {}
    __device__ __forceinline__ void done(const Unit&) const {}
};
__device__ __forceinline__ float dot4(const f32x4 a) { return (a[0] * a[0] + a[1] * a[1]) + (a[2] * a[2] + a[3] * a[3]); }

struct EpiZ {
    static constexpr bool PERM = true, AFTER_DRAIN = false;
    bf16_t* Z; const float* ssq; bf16_t* MRG; bf16_t* VN; float* gvs; const float* lng; const float* lnb; float* ssqQ; float* ssqC; const unsigned char* wsb; int wtz;
    __device__ __forceinline__ void operator()(const f32x4 (&acc)[2][2][4][2], const Unit& u, int wr, int wc, int fr_, int fq_) const {
        unsigned z_e = 0u; asm volatile("" : "+v"(z_e)); const int lane_e = (int)__builtin_amdgcn_mbcnt_hi(~0u, __builtin_amdgcn_mbcnt_lo(~0u, z_e)), fr = lane_e & 15, fq = lane_e >> 4; (void)fr_; (void)fq_;
        const int row0 = u.pm * BM + wr * 64 + fr;
        float rs[2][4];
#pragma unroll
        for (int ai = 0; ai < 2; ++ai)
#pragma unroll
            for (int m = 0; m < 4; ++m) rs[ai][m] = ssq[row0 + ai * HALF + m * 16];
        if (u.pn < 4) {
            bf16_t* dst; int ld;
            if (u.pn < 2) { dst = Z + u.pn * BM + wc * 32 + 8 * fq; ld = NZ; } else { dst = MRG + 512 + (u.pn - 2) * BM + wc * 32 + 8 * fq; ld = 1024; }
            const bool act = u.pn >= 2;
#pragma unroll
            for (int ai = 0; ai < 2; ++ai)
#pragma unroll
                for (int m = 0; m < 4; ++m) { const int row = row0 + ai * HALF + m * 16; const float r = rsq(rs[ai][m] * (1.0f / 1024.0f) + EPS); float sq = 0.f;
                    bf16_t* rowp = dst + (size_t)row * ld;
#pragma unroll
                    for (int bj = 0; bj < 2; ++bj) { f32x4 v0 = acc[ai][bj][m][0] * r, v1 = acc[ai][bj][m][1] * r;
                        if (act) {
#pragma unroll
                            for (int e = 0; e < 4; ++e) { v0[e] = gelu_tanh(v0[e]); v1[e] = gelu_tanh(v1[e]); } }
                        u32x4 w; w.x = pk2(v0[0], v0[1]); w.y = pk2(v0[2], v0[3]); w.z = pk2(v1[0], v1[1]); w.w = pk2(v1[2], v1[3]);
                        if (wtz && u.pn < 2) st16wt(wsb, rowp + bj * HALF, w); else st16pl(wsb, rowp + bj * HALF, w);
                        if (!act && (u.pn == 0 || bj == 0)) sq += dot4(v0) + dot4(v1); }
                    if (!act) { sq = sum32(sum16(sq)); if (fq == 0) atomicAdd((u.pn == 0 ? ssqQ : ssqC) + row, sq); }
                    __builtin_amdgcn_sched_barrier(0); }
        } else {
            const int grp = 4 * (u.pn - 4) + wc;
            f32x4 gg[2][2], gb[2][2];
#pragma unroll
            for (int bj = 0; bj < 2; ++bj)
#pragma unroll
                for (int n = 0; n < 2; ++n) { gg[bj][n] = *(const f32x4*)(lng + grp * 64 + 32 * bj + 8 * fq + 4 * n); gb[bj][n] = *(const f32x4*)(lnb + grp * 64 + 32 * bj + 8 * fq + 4 * n); }
#pragma unroll
            for (int ai = 0; ai < 2; ++ai)
#pragma unroll
                for (int m = 0; m < 4; ++m) { const int row = row0 + ai * HALF + m * 16; const float r = rsq(rs[ai][m] * (1.0f / 1024.0f) + EPS);
                    f32x4 y[2][2]; float s = 0.f;
#pragma unroll
                    for (int bj = 0; bj < 2; ++bj)
#pragma unroll
                        for (int n = 0; n < 2; ++n) { const f32x4 a = acc[ai][bj][m][n] * r;
#pragma unroll
                            for (int e = 0; e < 4; ++e) { y[bj][n][e] = gelu_tanh(a[e]); s += y[bj][n][e]; } }
                    s = sum32(sum16(s)); const float mean = s * (1.0f / 64.0f); float s2 = 0.f;
#pragma unroll
                    for (int bj = 0; bj < 2; ++bj)
#pragma unroll
                        for (int n = 0; n < 2; ++n) { y[bj][n] = y[bj][n] - mean; s2 += dot4(y[bj][n]); }
                    s2 = sum32(sum16(s2)); const float rstd = rsq(s2 * (1.0f / 64.0f) + EPS);
#pragma unroll
                    for (int bj = 0; bj < 2; ++bj) { const f32x4 o0 = y[bj][0] * rstd * gg[bj][0] + gb[bj][0], o1 = y[bj][1] * rstd * gg[bj][1] + gb[bj][1];
                        u32x4 w; w.x = pk2(o0[0], o0[1]); w.y = pk2(o0[2], o0[3]); w.z = pk2(o1[0], o1[1]); w.w = pk2(o1[2], o1[3]);
                        st16pl(wsb, VN + (size_t)row * 512 + grp * 64 + 32 * bj + 8 * fq, w);
                        if (row >= MP) { float* op = gvs + (size_t)(row - MP) * 512 + grp * 64 + 32 * bj + 8 * fq; *(f32x4*)op = o0; *(f32x4*)(op + 4) = o1; } }
                    __builtin_amdgcn_sched_barrier(0); }
        }
    }
};

struct EpiGU {
    static constexpr bool PERM = true, AFTER_DRAIN = false;
    bf16_t* H; const float* ssq; const unsigned char* wsb;
    __device__ __forceinline__ void operator()(const f32x4 (&acc)[2][2][4][2], const Unit& u, int wr, int wc, int fr_, int fq_) const {
        unsigned z_e = 0u; asm volatile("" : "+v"(z_e)); const int lane_e = (int)__builtin_amdgcn_mbcnt_hi(~0u, __builtin_amdgcn_mbcnt_lo(~0u, z_e)), fr = lane_e & 15, fq = lane_e >> 4; (void)fr_; (void)fq_;
        const int row0 = u.pm * BM + wr * 64 + fr, colh = u.pn * HALF + wc * 32 + 8 * fq;
        float rs[2][4];
#pragma unroll
        for (int ai = 0; ai < 2; ++ai)
#pragma unroll
            for (int m = 0; m < 4; ++m) rs[ai][m] = ssq[row0 + ai * HALF + m * 16];
#pragma unroll
        for (int ai = 0; ai < 2; ++ai)
#pragma unroll
            for (int m = 0; m < 4; ++m) { const int row = row0 + ai * HALF + m * 16; const float r = rsq(rs[ai][m] * (1.0f / 1024.0f) + EPS);
                const f32x4 g0 = acc[ai][0][m][0] * r, g1 = acc[ai][0][m][1] * r, u0 = acc[ai][1][m][0] * r, u1 = acc[ai][1][m][1] * r;
                f32x4 h0, h1;
#pragma unroll
                for (int e = 0; e < 4; ++e) { h0[e] = silu_f(g0[e]) * u0[e]; h1[e] = silu_f(g1[e]) * u1[e]; }
                u32x4 w; w.x = pk2(h0[0], h0[1]); w.y = pk2(h0[2], h0[3]); w.z = pk2(h1[0], h1[1]); w.w = pk2(h1[2], h1[3]);
                st16wt(wsb, H + (size_t)row * DFF + colh, w); }
    }
};

struct EpiRes {
    static constexpr bool PERM = true, AFTER_DRAIN = false;
    float* out; bf16_t* XB; float* ssq; int final_f32; const unsigned char* wsb; int wt;
    __device__ __forceinline__ void operator()(const f32x4 (&acc)[2][2][4][2], const Unit& u, int wr, int wc, int fr_, int fq_) const {
        unsigned z_e = 0u; asm volatile("" : "+v"(z_e)); const int lane_e = (int)__builtin_amdgcn_mbcnt_hi(~0u, __builtin_amdgcn_mbcnt_lo(~0u, z_e)), fr = lane_e & 15, fq = lane_e >> 4; (void)fr_; (void)fq_;
        const int col0 = u.pn * BM + wc * 32 + 8 * fq;
#pragma unroll
        for (int ai = 0; ai < 2; ++ai)
#pragma unroll
            for (int m = 0; m < 4; ++m) { const size_t row = (size_t)u.pm * BM + ai * HALF + wr * 64 + m * 16 + fr; float ss = 0.f;
#pragma unroll
                for (int bj = 0; bj < 2; ++bj) { bf16_t* xp = XB + row * 1024 + col0 + bj * HALF;
                    const u32x4 xw = *(const u32x4*)xp;
                    const f32x4 o0 = (f32x4){bflo(xw.x), bfhi(xw.x), bflo(xw.y), bfhi(xw.y)} + acc[ai][bj][m][0], o1 = (f32x4){bflo(xw.z), bfhi(xw.z), bflo(xw.w), bfhi(xw.w)} + acc[ai][bj][m][1];
                    if (final_f32) { float* op = out + row * 1024 + col0 + bj * HALF; *(f32x4*)op = o0; *(f32x4*)(op + 4) = o1; }
                    else { u32x4 w; w.x = pk2(o0[0], o0[1]); w.y = pk2(o0[2], o0[3]); w.z = pk2(o1[0], o1[1]); w.w = pk2(o1[2], o1[3]); if (wt) st16wt(wsb, xp, w); else st16pl(wsb, xp, w); ss += dot4(o0) + dot4(o1); } }
                if (!final_f32) { ss = sum32(sum16(ss)); if (fq == 0) atomicAdd(ssq + row, ss); }
                if (m & 1) asm volatile("" ::: "memory"); }
    }
};

struct EpiQ {
    static constexpr bool PERM = true, AFTER_DRAIN = false;
    bf16_t* QNP; bf16_t* QRP; const float* gqn; const float* gqr; const float* rope; const float* ssqQ; const unsigned char* wsb;
    __device__ __forceinline__ void operator()(const f32x4 (&acc)[2][2][4][2], const Unit& u, int wr, int wc, int fr_, int fq_) const {
        unsigned z_e = 0u; asm volatile("" : "+v"(z_e)); const int lane_e = (int)__builtin_amdgcn_mbcnt_hi(~0u, __builtin_amdgcn_mbcnt_lo(~0u, z_e)), fr = lane_e & 15, fq = lane_e >> 4; (void)fr_; (void)fq_;
        const int row0 = u.pm * BM + wr * 64 + fr;
        float rq[2][4];
#pragma unroll
        for (int ai = 0; ai < 2; ++ai)
#pragma unroll
            for (int m = 0; m < 4; ++m) rq[ai][m] = ssqQ[row0 + ai * HALF + m * 16];
#pragma unroll
        for (int ai = 0; ai < 2; ++ai)
#pragma unroll
            for (int m = 0; m < 4; ++m) rq[ai][m] = rsq(rq[ai][m] * (1.0f / 256.0f) + EPS);
        if (u.pn < 2) {
            const int head = 4 * u.pn + wc;
            f32x4 gv[2][2];
#pragma unroll
            for (int bj = 0; bj < 2; ++bj)
#pragma unroll
                for (int n = 0; n < 2; ++n) gv[bj][n] = *(const f32x4*)(gqn + 32 * bj + 8 * fq + 4 * n) * QSCALE;
#pragma unroll
            for (int ai = 0; ai < 2; ++ai)
#pragma unroll
                for (int m = 0; m < 4; ++m) { const int row = row0 + ai * HALF + m * 16;
                    float ss = (dot4(acc[ai][0][m][0]) + dot4(acc[ai][0][m][1])) + (dot4(acc[ai][1][m][0]) + dot4(acc[ai][1][m][1]));
                    ss = sum32(sum16(ss)) * (rq[ai][m] * rq[ai][m]);
                    const float rn = rsq(ss * (1.0f / 64.0f) + EPS) * rq[ai][m];
#pragma unroll
                    for (int bj = 0; bj < 2; ++bj) { const f32x4 v0 = acc[ai][bj][m][0] * gv[bj][0] * rn, v1 = acc[ai][bj][m][1] * gv[bj][1] * rn;
                        u32x4 w; w.x = pk2(v0[0], v0[1]); w.y = pk2(v0[2], v0[3]); w.z = pk2(v1[0], v1[1]); w.w = pk2(v1[2], v1[3]);
                        st16pl(wsb, QNP + (size_t)row * 512 + head * 64 + 32 * bj + 8 * fq, w); }  __builtin_amdgcn_sched_barrier(0); }
        } else {
            const f32x4 g1 = *(const f32x4*)(gqr + 4 * fq) * QSCALE, g2 = *(const f32x4*)(gqr + 16 + 4 * fq) * QSCALE;
#pragma unroll
            for (int ai = 0; ai < 2; ++ai)
#pragma unroll
                for (int m = 0; m < 4; ++m) { const int row = row0 + ai * HALF + m * 16;
                    const int posidx = row < MP ? (row & 2047) : 2048 + ((row - MP) & 63);
                    const float* rp = rope + (size_t)(posidx * 16 + 4 * fq) * 2;
                    const f32x4 cs0 = *(const f32x4*)rp, cs1 = *(const f32x4*)(rp + 4);
                    const f32x4 cc = {cs0[0], cs0[2], cs1[0], cs1[2]}, sn = {cs0[1], cs0[3], cs1[1], cs1[3]};
#pragma unroll
                    for (int bj = 0; bj < 2; ++bj) { const f32x4 x1 = acc[ai][bj][m][0], x2 = acc[ai][bj][m][1];
                        float ss = dot4(x1) + dot4(x2); ss = sum32(sum16(ss)) * (rq[ai][m] * rq[ai][m]);
                        const float rn = rsq(ss * (1.0f / 32.0f) + EPS) * rq[ai][m];
                        const f32x4 a = x1 * g1 * rn, b = x2 * g2 * rn;
                        const f32x4 o1 = a * cc - b * sn, o2 = a * sn + b * cc;
                        const int head = 2 * wc + bj;
                        u32x2 w1, w2; w1.x = pk2(o1[0], o1[1]); w1.y = pk2(o1[2], o1[3]); w2.x = pk2(o2[0], o2[1]); w2.y = pk2(o2[2], o2[3]);
                        bf16_t* qp = QRP + (size_t)row * 256 + head * 32 + 4 * fq;
                        *(u32x2*)qp = w1; *(u32x2*)(qp + 16) = w2; }  __builtin_amdgcn_sched_barrier(0); }
        }
    }
};

struct EpiKV {
    static constexpr bool PERM = true, AFTER_DRAIN = false;
    bf16_t* KN; bf16_t* VV; const float* gkn; const float* ssqC; const unsigned char* wsb;
    __device__ __forceinline__ void operator()(const f32x4 (&acc)[2][2][4][2], const Unit& u, int wr, int wc, int fr_, int fq_) const {
        unsigned z_e = 0u; asm volatile("" : "+v"(z_e)); const int lane_e = (int)__builtin_amdgcn_mbcnt_hi(~0u, __builtin_amdgcn_mbcnt_lo(~0u, z_e)), fr = lane_e & 15, fq = lane_e >> 4; (void)fr_; (void)fq_;
        const int row0 = u.pm * BM + wr * 64 + fr;
        float rc[2][4];
#pragma unroll
        for (int ai = 0; ai < 2; ++ai)
#pragma unroll
            for (int m = 0; m < 4; ++m) rc[ai][m] = ssqC ? ssqC[row0 + ai * HALF + m * 16] : 0.f;
#pragma unroll
        for (int ai = 0; ai < 2; ++ai)
#pragma unroll
            for (int m = 0; m < 4; ++m) rc[ai][m] = ssqC ? rsq(rc[ai][m] * (1.0f / 128.0f) + EPS) : 1.0f;
        if (u.pn < 2) {
            const int head = 4 * u.pn + wc;
            f32x4 gv[2][2];
#pragma unroll
            for (int bj = 0; bj < 2; ++bj)
#pragma unroll
                for (int n = 0; n < 2; ++n) gv[bj][n] = *(const f32x4*)(gkn + 32 * bj + 8 * fq + 4 * n);
#pragma unroll
            for (int ai = 0; ai < 2; ++ai)
#pragma unroll
                for (int m = 0; m < 4; ++m) { const int row = row0 + ai * HALF + m * 16;
                    float ss = (dot4(acc[ai][0][m][0]) + dot4(acc[ai][0][m][1])) + (dot4(acc[ai][1][m][0]) + dot4(acc[ai][1][m][1]));
                    ss = sum32(sum16(ss)) * (rc[ai][m] * rc[ai][m]);
                    const float rn = rsq(ss * (1.0f / 64.0f) + EPS) * rc[ai][m];
#pragma unroll
                    for (int bj = 0; bj < 2; ++bj) { const f32x4 v0 = acc[ai][bj][m][0] * gv[bj][0] * rn, v1 = acc[ai][bj][m][1] * gv[bj][1] * rn;
                        u32x4 w; w.x = pk2(v0[0], v0[1]); w.y = pk2(v0[2], v0[3]); w.z = pk2(v1[0], v1[1]); w.w = pk2(v1[2], v1[3]);
                        st16pl(wsb, KN + (size_t)row * 512 + head * 64 + 32 * bj + 8 * fq, w); }  __builtin_amdgcn_sched_barrier(0); }
        } else {
            const int head = 4 * (u.pn - 2) + wc;
#pragma unroll
            for (int ai = 0; ai < 2; ++ai)
#pragma unroll
                for (int m = 0; m < 4; ++m) { const int row = row0 + ai * HALF + m * 16;
#pragma unroll
                    for (int bj = 0; bj < 2; ++bj) { const f32x4 v0 = acc[ai][bj][m][0] * rc[ai][m], v1 = acc[ai][bj][m][1] * rc[ai][m];
                        u32x4 w; w.x = pk2(v0[0], v0[1]); w.y = pk2(v0[2], v0[3]); w.z = pk2(v1[0], v1[1]); w.w = pk2(v1[2], v1[3]);
                        st16pl(wsb, VV + (size_t)row * 512 + head * 64 + 32 * bj + 8 * fq, w); }  __builtin_amdgcn_sched_barrier(0); }
        }
    }
};

template <class Epi, class Sched, bool ALIGN_EPI = false, bool SP2 = false>
__device__ __forceinline__ void gemm_phase(PG8_LAS unsigned char* lds, const Gemm g, const Sched& S, const Epi& E, const int wid_in) {
    int wid = wid_in; asm volatile("" : "+s"(wid));
    unsigned z_ = 0u; asm volatile("" : "+v"(z_)); const int lane_ = (int)__builtin_amdgcn_mbcnt_hi(~0u, __builtin_amdgcn_mbcnt_lo(~0u, z_));
    const int lane = lane_, tid = wid * 64 + lane, wr = wid >> 2, wc = wid & 3, fr = lane & 15, fq = lane >> 4;
    const int K = g.K, nt = K / BK;
    unsigned voffA[2], voffB[2];
#pragma unroll
    for (int i = 0; i < 2; ++i) { int R, C; stage_rc(tid * 16 + i * 8192, R, C); const int Rb = Epi::PERM ? ((R & ~31) + perm32(R & 31)) : R;
        voffA[i] = (unsigned)(R * g.lda + C) * 2u; voffB[i] = (unsigned)(Rb * K + C) * 2u; }
    const size_t kstep = (size_t)(BK * 2);
    const size_t hstepA = (size_t)HALF * g.lda * 2, hstepB = (size_t)HALF * K * 2;
    const size_t tstepA = 2 * hstepA, tstepB = 2 * hstepB;
    const unsigned ldsw = (unsigned)wid * 1024u;
    const int aoff = lds_byte(wr * 64 + fr, fq * 8), boff = lds_byte(wc * 32 + fr, fq * 8);
#define PG8_SA(b, h) (((b) * 2 + (h)) * HTB)
#define PG8_SB(b, h) ((4 + (b) * 2 + (h)) * HTB)
#define PG8_STAGE(bufoff, gbase, voff) do { _Pragma("unroll") for (int _i = 0; _i < 2; ++_i) \
        __builtin_amdgcn_global_load_lds((const unsigned*)((const char*)(gbase) + (voff)[_i]), (PG8_LAS unsigned*)(lds + (bufoff) + ldsw + _i * 8192), 16, 0, 0); } while (0)
#define PG8_LDA(dst, b, h) do { _Pragma("unroll") for (int m = 0; m < 4; ++m) _Pragma("unroll") for (int k = 0; k < 2; ++k) dst[m][k] = *(const PG8_LAS bf16x8*)(lds + PG8_SA(b, h) + aoff + m * 2048 + k * 1024); } while (0)
#define PG8_LDB(dst, b, h) do { _Pragma("unroll") for (int n = 0; n < 2; ++n) _Pragma("unroll") for (int k = 0; k < 2; ++k) dst[n][k] = *(const PG8_LAS bf16x8*)(lds + PG8_SB(b, h) + boff + n * 2048 + k * 1024); } while (0)
#define PG8_MMA(ai, bj, At, Bt) do { __builtin_amdgcn_s_setprio(1); _Pragma("unroll") for (int m = 0; m < 4; ++m) _Pragma("unroll") for (int n = 0; n < 2; ++n) _Pragma("unroll") for (int k = 0; k < 2; ++k) \
        acc[ai][bj][m][n] = __builtin_amdgcn_mfma_f32_16x16x32_bf16(Bt[n][k], At[m][k], acc[ai][bj][m][n], 0, 0, 0); __builtin_amdgcn_s_setprio(0); } while (0)
#define PG8_WAIT_V(n) asm volatile("s_waitcnt vmcnt(" #n ")" ::: "memory")
#define PG8_WAIT_L(n) asm volatile("s_waitcnt lgkmcnt(" #n ")" ::: "memory")
#define PG8_BAR __builtin_amdgcn_s_barrier()
#define PG8_SCHED __builtin_amdgcn_sched_barrier(0)
    Unit cur, nxt; int ui = 0;
    if (!S.next(0, cur)) return;
    f32x4 acc[2][2][4][2];
#pragma unroll
    for (int a = 0; a < 2; ++a)
#pragma unroll
        for (int b = 0; b < 2; ++b)
#pragma unroll
            for (int m = 0; m < 4; ++m)
#pragma unroll
                for (int n = 0; n < 2; ++n) acc[a][b][m][n] = (f32x4){0.f, 0.f, 0.f, 0.f};
    bf16x8 At[4][2], B0[2][2], B1[2][2];
    const char* cA = (const char*)g.A + (size_t)cur.pm * tstepA; const char* cB = (const char*)g.Bt + (size_t)cur.pn * tstepB;
    S.a_ready(cur);
    if constexpr (SP2) {
        PG8_STAGE(PG8_SB(0, 0), cB, voffB); PG8_STAGE(PG8_SB(0, 1), cB + hstepB, voffB); PG8_STAGE(PG8_SA(0, 0), cA, voffA); PG8_STAGE(PG8_SA(0, 1), cA + hstepA, voffA);
        if (wr == 1) PG8_BAR;
        PG8_WAIT_V(2); PG8_BAR;
        PG8_STAGE(PG8_SB(1, 0), cB + kstep, voffB); PG8_STAGE(PG8_SA(1, 0), cA + kstep, voffA); PG8_STAGE(PG8_SB(1, 1), cB + hstepB + kstep, voffB);
        PG8_WAIT_V(6); PG8_BAR;
    } else {
        PG8_STAGE(PG8_SB(0, 0), cB, voffB); PG8_STAGE(PG8_SA(0, 0), cA, voffA); PG8_STAGE(PG8_SB(0, 1), cB + hstepB, voffB); PG8_STAGE(PG8_SA(0, 1), cA + hstepA, voffA);
        if (wr == 1) PG8_BAR;
        PG8_WAIT_V(4); PG8_BAR;
        PG8_STAGE(PG8_SB(1, 0), cB + kstep, voffB); PG8_STAGE(PG8_SA(1, 0), cA + kstep, voffA); PG8_STAGE(PG8_SB(1, 1), cB + hstepB + kstep, voffB);
        PG8_WAIT_V(6); PG8_BAR;
    }
    for (;;) {
        const bool has_next = S.next(ui + 1, nxt);
        const char* nA = has_next ? (const char*)g.A + (size_t)nxt.pm * tstepA : cA; const char* nB = has_next ? (const char*)g.Bt + (size_t)nxt.pn * tstepB : cB;
        for (int t = 0; t < nt; t += 2) {
            const bool last = (t == nt - 2);
            const char* a1 = cA + (size_t)(t + 1) * kstep;
            const char* a2 = last ? nA : cA + (size_t)(t + 2) * kstep; const char* b2 = last ? nB : cB + (size_t)(t + 2) * kstep;
            const char* a3 = a2 + kstep; const char* b3 = b2 + kstep;
            if (last && has_next) S.a_ready(nxt);
            if constexpr (SP2) {
            PG8_LDB(B0, 0, 0); PG8_LDB(B1, 0, 1); PG8_SCHED; PG8_LDA(At, 0, 0); PG8_STAGE(PG8_SA(1, 1), a1 + hstepA, voffA);
            PG8_WAIT_V(8); PG8_WAIT_L(0); PG8_BAR; PG8_MMA(0, 0, At, B0); PG8_MMA(0, 1, At, B1); PG8_BAR; PG8_SCHED;
            PG8_LDA(At, 0, 1); PG8_STAGE(PG8_SB(0, 0), b2, voffB); PG8_STAGE(PG8_SB(0, 1), b2 + hstepB, voffB); PG8_STAGE(PG8_SA(0, 0), a2, voffA);
            PG8_WAIT_V(8); PG8_WAIT_L(0); PG8_BAR; PG8_MMA(1, 0, At, B0); PG8_MMA(1, 1, At, B1); PG8_BAR; PG8_SCHED;
            PG8_LDB(B0, 1, 0); PG8_LDB(B1, 1, 1); PG8_SCHED; PG8_LDA(At, 1, 0); PG8_STAGE(PG8_SA(0, 1), a2 + hstepA, voffA);
            PG8_WAIT_V(8); PG8_WAIT_L(0); PG8_BAR; PG8_MMA(0, 0, At, B0); PG8_MMA(0, 1, At, B1); PG8_BAR; PG8_SCHED;
            PG8_LDA(At, 1, 1); PG8_STAGE(PG8_SB(1, 0), b3, voffB); PG8_STAGE(PG8_SB(1, 1), b3 + hstepB, voffB); PG8_STAGE(PG8_SA(1, 0), a3, voffA);
            PG8_WAIT_V(8); PG8_WAIT_L(0); PG8_BAR; PG8_MMA(1, 0, At, B0); PG8_MMA(1, 1, At, B1); PG8_BAR; PG8_SCHED;
            } else {
            PG8_LDB(B0, 0, 0); PG8_SCHED; PG8_LDA(At, 0, 0); PG8_STAGE(PG8_SA(1, 1), a1 + hstepA, voffA);
            PG8_WAIT_L(8); PG8_BAR; PG8_WAIT_L(0); PG8_MMA(0, 0, At, B0); PG8_BAR; PG8_SCHED;
            PG8_LDB(B1, 0, 1); PG8_STAGE(PG8_SB(0, 0), b2, voffB);
            PG8_BAR; PG8_WAIT_L(0); PG8_MMA(0, 1, At, B1); PG8_BAR;
            PG8_LDA(At, 0, 1); PG8_STAGE(PG8_SA(0, 0), a2, voffA);
            PG8_BAR; PG8_WAIT_L(0); PG8_MMA(1, 0, At, B0); PG8_BAR; PG8_SCHED;
            PG8_STAGE(PG8_SB(0, 1), b2 + hstepB, voffB);
            PG8_WAIT_V(6); PG8_BAR; PG8_MMA(1, 1, At, B1); PG8_BAR;
            PG8_LDB(B0, 1, 0); PG8_SCHED; PG8_LDA(At, 1, 0); PG8_STAGE(PG8_SA(0, 1), a2 + hstepA, voffA);
            PG8_WAIT_L(8); PG8_BAR; PG8_WAIT_L(0); PG8_MMA(0, 0, At, B0); PG8_BAR; PG8_SCHED;
            PG8_LDB(B1, 1, 1); PG8_STAGE(PG8_SB(1, 0), b3, voffB);
            PG8_BAR; PG8_WAIT_L(0); PG8_MMA(0, 1, At, B1); PG8_BAR;
            PG8_LDA(At, 1, 1); PG8_STAGE(PG8_SA(1, 0), a3, voffA);
            PG8_BAR; PG8_WAIT_L(0); PG8_MMA(1, 0, At, B0); PG8_BAR; PG8_SCHED;
            PG8_STAGE(PG8_SB(1, 1), b3 + hstepB, voffB);
            PG8_WAIT_V(6); PG8_BAR; PG8_MMA(1, 1, At, B1); PG8_BAR;
            }
        }
        if constexpr (ALIGN_EPI) { if (wr == 0) PG8_BAR; }
        if constexpr (!Epi::AFTER_DRAIN) { E(acc, cur, wr, wc, fr, fq); S.done(cur); }
        if (!has_next) break;
#pragma unroll
        for (int a = 0; a < 2; ++a)
#pragma unroll
            for (int b = 0; b < 2; ++b)
#pragma unroll
                for (int m = 0; m < 4; ++m)
#pragma unroll
                    for (int n = 0; n < 2; ++n) acc[a][b][m][n] = (f32x4){0.f, 0.f, 0.f, 0.f};
        cur = nxt; cA = nA; cB = nB; ++ui;
        if constexpr (ALIGN_EPI) { if (wr == 1) PG8_BAR; }
    }
    PG8_WAIT_V(0);
    if constexpr (!ALIGN_EPI) { if (wr == 0) PG8_BAR; }
    PG8_BAR;
    if constexpr (Epi::AFTER_DRAIN) { E.fused(acc, cur, wr, wc, fr, fq, lds, wid, lane); S.done(cur); }
#undef PG8_SA
#undef PG8_SB
#undef PG8_STAGE
#undef PG8_LDA
#undef PG8_LDB
#undef PG8_MMA
#undef PG8_WAIT_V
#undef PG8_WAIT_L
#undef PG8_BAR
#undef PG8_SCHED
}
}
namespace att {
constexpr int KSTR = 208, VSTR = 192, KB_BYTES = 64 * KSTR, VB_BYTES = 64 * VSTR, TILE_BYTES = KB_BYTES + VB_BYTES;
typedef short v4i16_t __attribute__((ext_vector_type(4)));
__device__ __forceinline__ s16x4 vtr(const LAS char* p) { return __builtin_bit_cast(s16x4, __builtin_amdgcn_ds_read_tr16_b64_v4i16((LAS v4i16_t*)p)); }
__device__ __forceinline__ bf16x8 cat8(s16x4 lo, s16x4 hi) { return (bf16x8){lo[0], lo[1], lo[2], lo[3], hi[0], hi[1], hi[2], hi[3]}; }

struct Ptrs { const bf16* QNP; const bf16* QRP; const bf16* KN; const bf16* VV; const bf16* KR; bf16* MRG; const float* gout; };
struct Stage { u32x4 kn, kr, vv; };

__device__ __forceinline__ void stage_load(Stage& s, const Ptrs& P, size_t krow0, int h, int tid) {
    const int row = tid >> 3, ch = tid & 7;
    s.kn = *(const u32x4*)(P.KN + (krow0 + row) * 512 + h * 64 + ch * 8);
    s.vv = *(const u32x4*)(P.VV + (krow0 + row) * 512 + h * 64 + ch * 8);
    if (tid < 256) { const int r2 = tid >> 2, c2 = tid & 3; s.kr = *(const u32x4*)(P.KR + (krow0 + r2) * 32 + c2 * 8); }
}
__device__ __forceinline__ void stage_store(const Stage& s, LAS char* buf, int tid) {
    const int row = tid >> 3, ch = tid & 7;
    *(LAS u32x4*)(buf + row * KSTR + ch * 16) = s.kn;
    *(LAS u32x4*)(buf + KB_BYTES + row * VSTR + ch * 16) = s.vv;
    if (tid < 256) { const int r2 = tid >> 2, c2 = tid & 3; *(LAS u32x4*)(buf + r2 * KSTR + 128 + c2 * 16) = s.kr; }
}
__device__ __forceinline__ void load_q(bf16x8 (&qf)[6], const Ptrs& P, size_t qrow, int h, int hi) {
#pragma unroll
    for (int s = 0; s < 4; ++s) qf[s] = *(const bf16x8*)(P.QNP + qrow * 512 + h * 64 + 16 * s + 8 * hi);
#pragma unroll
    for (int s = 0; s < 2; ++s) qf[4 + s] = *(const bf16x8*)(P.QRP + qrow * 256 + h * 32 + 16 * s + 8 * hi);
}

template <bool FIRST>
__device__ __forceinline__ void attn_tile(const LAS char* buf, const bf16x8 (&qf)[6], float& mrun, float& lrun, f32x16& o0, f32x16& o1, f32x16& negm, int lane) {
    const int r32 = lane & 31, hi = lane >> 5;
    const LAS char* kp = buf + r32 * KSTR + hi * 16;
    f32x16 p0, p1;
    { const bf16x8 a0 = *(const LAS bf16x8*)(kp), a1 = *(const LAS bf16x8*)(kp + 32 * KSTR);
      if (FIRST) { const f32x16 z = {}; p0 = __builtin_amdgcn_mfma_f32_32x32x16_bf16(a0, qf[0], z, 0, 0, 0); p1 = __builtin_amdgcn_mfma_f32_32x32x16_bf16(a1, qf[0], z, 0, 0, 0); }
      else { p0 = __builtin_amdgcn_mfma_f32_32x32x16_bf16(a0, qf[0], negm, 0, 0, 0); p1 = __builtin_amdgcn_mfma_f32_32x32x16_bf16(a1, qf[0], negm, 0, 0, 0); } }
#pragma unroll
    for (int s = 1; s < 6; ++s) {
        const bf16x8 a0 = *(const LAS bf16x8*)(kp + s * 32), a1 = *(const LAS bf16x8*)(kp + 32 * KSTR + s * 32);
        p0 = __builtin_amdgcn_mfma_f32_32x32x16_bf16(a0, qf[s], p0, 0, 0, 0);
        p1 = __builtin_amdgcn_mfma_f32_32x32x16_bf16(a1, qf[s], p1, 0, 0, 0);
    }
    float mx = fmaxf(p0[0], p1[0]);
#pragma unroll
    for (int r = 1; r < 16; ++r) mx = fmaxf(mx, fmaxf(p0[r], p1[r]));
    mx = max32(mx);
    if (FIRST) {
        mrun = mx;
#pragma unroll
        for (int r = 0; r < 16; ++r) { p0[r] -= mx; p1[r] -= mx; negm[r] = -mx; }
    } else if (__any(mx > 6.0f)) {
        const float dl = fmaxf(mx, 0.f), alpha = __builtin_amdgcn_exp2f(-dl);
        mrun += dl; lrun *= alpha;
#pragma unroll
        for (int r = 0; r < 16; ++r) { p0[r] -= dl; p1[r] -= dl; negm[r] = -mrun; }
        o0 *= alpha; o1 *= alpha;
    }
    float sum = 0.f;
#pragma unroll
    for (int r = 0; r < 16; ++r) { p0[r] = __builtin_amdgcn_exp2f(p0[r]); p1[r] = __builtin_amdgcn_exp2f(p1[r]); sum += p0[r] + p1[r]; }
    lrun += sum;
    u32x4 pw[4];
#pragma unroll
    for (int j = 0; j < 4; ++j) { pw[0][j] = pk2(p0[2 * j], p0[2 * j + 1]); pw[1][j] = pk2(p0[8 + 2 * j], p0[8 + 2 * j + 1]); pw[2][j] = pk2(p1[2 * j], p1[2 * j + 1]); pw[3][j] = pk2(p1[8 + 2 * j], p1[8 + 2 * j + 1]); }
    const LAS char* vp = buf + KB_BYTES + (4 * hi + ((lane & 15) >> 2)) * VSTR + (16 * ((lane >> 4) & 1) + 4 * (lane & 3)) * 2;
#pragma unroll
    for (int ks = 0; ks < 4; ++ks) {
        const bf16x8 pf = __builtin_bit_cast(bf16x8, pw[ks]);
        const bf16x8 v0 = cat8(vtr(vp + ks * 16 * VSTR), vtr(vp + (ks * 16 + 8) * VSTR));
        const bf16x8 v1 = cat8(vtr(vp + ks * 16 * VSTR + 64), vtr(vp + (ks * 16 + 8) * VSTR + 64));
        o0 = __builtin_amdgcn_mfma_f32_32x32x16_bf16(v0, pf, o0, 0, 0, 0);
        o1 = __builtin_amdgcn_mfma_f32_32x32x16_bf16(v1, pf, o1, 0, 0, 0);
    }
}

__device__ __forceinline__ void finalize(const Ptrs& P, size_t qrow, int h, float lrun, f32x16& o0, f32x16& o1, int lane) {
    const int hi = lane >> 5;
    const float l = sum32(lrun), inv = 1.0f / l;
    o0 *= inv; o1 *= inv;
    float ss = 0.f;
#pragma unroll
    for (int r = 0; r < 16; ++r) ss += o0[r] * o0[r] + o1[r] * o1[r];
    ss = sum32(ss);
    const float rn = rsq(ss * (1.0f / 64.0f) + EPS);
    bf16* op = P.MRG + qrow * 1024 + h * 64;
#pragma unroll
    for (int rg = 0; rg < 4; ++rg) { const int d0 = 8 * rg + 4 * hi;
        u32x2 w0, w1;
        w0.x = pk2(o0[4 * rg] * rn, o0[4 * rg + 1] * rn); w0.y = pk2(o0[4 * rg + 2] * rn, o0[4 * rg + 3] * rn);
        w1.x = pk2(o1[4 * rg] * rn, o1[4 * rg + 1] * rn); w1.y = pk2(o1[4 * rg + 2] * rn, o1[4 * rg + 3] * rn);
        *(u32x2*)(op + d0) = w0; *(u32x2*)(op + 32 + d0) = w1; }
}

template <bool FIRST>
__device__ __forceinline__ void attn_tile2(const LAS char* bufA, const LAS char* bufB, int nv, const bf16x8 (&qf)[6], float& mrun, float& lrun, f32x16& o0, f32x16& o1, f32x16& negm, int lane) {
    const int r32 = lane & 31, hi = lane >> 5;
    const LAS char* kpa = bufA + r32 * KSTR + hi * 16; const LAS char* kpb = bufB + r32 * KSTR + hi * 16;
    f32x16 p0, p1, p2, p3;
    { const bf16x8 a0 = *(const LAS bf16x8*)(kpa), a1 = *(const LAS bf16x8*)(kpa + 32 * KSTR), a2 = *(const LAS bf16x8*)(kpb), a3 = *(const LAS bf16x8*)(kpb + 32 * KSTR);
      if (FIRST) { const f32x16 z = {}; p0 = __builtin_amdgcn_mfma_f32_32x32x16_bf16(a0, qf[0], z, 0, 0, 0); p1 = __builtin_amdgcn_mfma_f32_32x32x16_bf16(a1, qf[0], z, 0, 0, 0);
                   p2 = __builtin_amdgcn_mfma_f32_32x32x16_bf16(a2, qf[0], z, 0, 0, 0); p3 = __builtin_amdgcn_mfma_f32_32x32x16_bf16(a3, qf[0], z, 0, 0, 0); }
      else { p0 = __builtin_amdgcn_mfma_f32_32x32x16_bf16(a0, qf[0], negm, 0, 0, 0); p1 = __builtin_amdgcn_mfma_f32_32x32x16_bf16(a1, qf[0], negm, 0, 0, 0);
             p2 = __builtin_amdgcn_mfma_f32_32x32x16_bf16(a2, qf[0], negm, 0, 0, 0); p3 = __builtin_amdgcn_mfma_f32_32x32x16_bf16(a3, qf[0], negm, 0, 0, 0); } }
#pragma unroll
    for (int s = 1; s < 6; ++s) {
        const bf16x8 a0 = *(const LAS bf16x8*)(kpa + s * 32), a1 = *(const LAS bf16x8*)(kpa + 32 * KSTR + s * 32), a2 = *(const LAS bf16x8*)(kpb + s * 32), a3 = *(const LAS bf16x8*)(kpb + 32 * KSTR + s * 32);
        p0 = __builtin_amdgcn_mfma_f32_32x32x16_bf16(a0, qf[s], p0, 0, 0, 0); p1 = __builtin_amdgcn_mfma_f32_32x32x16_bf16(a1, qf[s], p1, 0, 0, 0);
        p2 = __builtin_amdgcn_mfma_f32_32x32x16_bf16(a2, qf[s], p2, 0, 0, 0); p3 = __builtin_amdgcn_mfma_f32_32x32x16_bf16(a3, qf[s], p3, 0, 0, 0);
    }
    if (nv < 2) {
#pragma unroll
        for (int r = 0; r < 16; ++r) { p2[r] = -1e30f; p3[r] = -1e30f; } }
    float mx = fmaxf(fmaxf(p0[0], p1[0]), fmaxf(p2[0], p3[0]));
#pragma unroll
    for (int r = 1; r < 16; ++r) mx = fmaxf(mx, fmaxf(fmaxf(p0[r], p1[r]), fmaxf(p2[r], p3[r])));
    mx = max32(mx);
    if (FIRST) {
        mrun = mx;
#pragma unroll
        for (int r = 0; r < 16; ++r) { p0[r] -= mx; p1[r] -= mx; p2[r] -= mx; p3[r] -= mx; negm[r] = -mx; }
    } else if (__any(mx > 6.0f)) {
        const float dl = fmaxf(mx, 0.f), alpha = __builtin_amdgcn_exp2f(-dl);
        mrun += dl; lrun *= alpha;
#pragma unroll
        for (int r = 0; r < 16; ++r) { p0[r] -= dl; p1[r] -= dl; p2[r] -= dl; p3[r] -= dl; negm[r] = -mrun; }
        o0 *= alpha; o1 *= alpha;
    }
    float sa = 0.f, sb = 0.f;
#pragma unroll
    for (int r = 0; r < 16; ++r) { p0[r] = __builtin_amdgcn_exp2f(p0[r]); p1[r] = __builtin_amdgcn_exp2f(p1[r]); p2[r] = __builtin_amdgcn_exp2f(p2[r]); p3[r] = __builtin_amdgcn_exp2f(p3[r]); sa += p0[r] + p1[r]; sb += p2[r] + p3[r]; }
    lrun += sa + sb;
    u32x4 pw[8];
#pragma unroll
    for (int j = 0; j < 4; ++j) { pw[0][j] = pk2(p0[2 * j], p0[2 * j + 1]); pw[1][j] = pk2(p0[8 + 2 * j], p0[8 + 2 * j + 1]); pw[2][j] = pk2(p1[2 * j], p1[2 * j + 1]); pw[3][j] = pk2(p1[8 + 2 * j], p1[8 + 2 * j + 1]);
                                  pw[4][j] = pk2(p2[2 * j], p2[2 * j + 1]); pw[5][j] = pk2(p2[8 + 2 * j], p2[8 + 2 * j + 1]); pw[6][j] = pk2(p3[2 * j], p3[2 * j + 1]); pw[7][j] = pk2(p3[8 + 2 * j], p3[8 + 2 * j + 1]); }
    const int voff = (4 * hi + ((lane & 15) >> 2)) * VSTR + (16 * ((lane >> 4) & 1) + 4 * (lane & 3)) * 2;
#pragma unroll
    for (int ks = 0; ks < 8; ++ks) {
        if (ks >= 4 && nv < 2) break;
        const LAS char* vp = (ks < 4 ? bufA : bufB) + KB_BYTES + voff;
        const int kk = ks & 3;
        const bf16x8 pf = __builtin_bit_cast(bf16x8, pw[ks]);
        const bf16x8 v0 = cat8(vtr(vp + kk * 16 * VSTR), vtr(vp + (kk * 16 + 8) * VSTR));
        const bf16x8 v1 = cat8(vtr(vp + kk * 16 * VSTR + 64), vtr(vp + (kk * 16 + 8) * VSTR + 64));
        o0 = __builtin_amdgcn_mfma_f32_32x32x16_bf16(v0, pf, o0, 0, 0, 0);
        o1 = __builtin_amdgcn_mfma_f32_32x32x16_bf16(v1, pf, o1, 0, 0, 0);
    }
}

__device__ __forceinline__ void prompt_unit(const Ptrs& P, int b, int h, int qb, LAS char* lds, int tid_in, int lane_in, int wid) {
    int tid = tid_in, lane = lane_in; asm volatile("" : "+v"(tid), "+v"(lane));
    const size_t rowbase = (size_t)b * 2048; const int r32 = lane & 31, hi = lane >> 5;
    const size_t qrow = rowbase + qb * 256 + wid * 32 + r32;
    bf16x8 qf[6]; load_q(qf, P, qrow, h, hi);
    const int NT = 4 * qb + 4, myNT = 4 * qb + (wid >> 1) + 1, NP = NT >> 1;
    float mrun = 0.f, lrun = 0.f; f32x16 o0 = {}, o1 = {}, negm = {};
    Stage sa, sb; stage_load(sa, P, rowbase, h, tid); stage_load(sb, P, rowbase + 64, h, tid);
    stage_store(sa, lds, tid); stage_store(sb, lds + TILE_BYTES, tid); __syncthreads();
    stage_load(sa, P, rowbase + 128, h, tid); stage_load(sb, P, rowbase + 192, h, tid);
    for (int i = 0; i < NP; ++i) {
        LAS char* cur = lds + (i & 1) * (2 * TILE_BYTES); LAS char* nxt = lds + ((i + 1) & 1) * (2 * TILE_BYTES);
        const int nv = myNT - 2 * i;
        if (i == 0) attn_tile2<true>(cur, cur + TILE_BYTES, nv, qf, mrun, lrun, o0, o1, negm, lane);
        else if (nv >= 1) attn_tile2<false>(cur, cur + TILE_BYTES, nv, qf, mrun, lrun, o0, o1, negm, lane);
        if (i + 1 < NP) { stage_store(sa, nxt, tid); stage_store(sb, nxt + TILE_BYTES, tid); }
        __syncthreads();
        if (i + 2 < NP) { stage_load(sa, P, rowbase + (size_t)(2 * i + 4) * 64, h, tid); stage_load(sb, P, rowbase + (size_t)(2 * i + 5) * 64, h, tid); }
    }
    finalize(P, qrow, h, lrun, o0, o1, lane);
}

constexpr int LSTR = 320, STILE_BYTES = KB_BYTES + 64 * LSTR;
struct SStage { u32x4 kn, kr, c0, c1; };
__device__ __forceinline__ void sstage_load(SStage& s, const Ptrs& P, const bf16* CL, size_t krow0, int h, int tid) {
    const int row = tid >> 3, ch = tid & 7;
    s.kn = *(const u32x4*)(P.KN + (krow0 + row) * 512 + h * 64 + ch * 8);
    if (tid < 256) { const int r2 = tid >> 2, c2 = tid & 3; s.kr = *(const u32x4*)(P.KR + (krow0 + r2) * 32 + c2 * 8); }
    const int lr = tid >> 4, lc = tid & 15;
    s.c0 = *(const u32x4*)(CL + (krow0 + lr) * 128 + lc * 8);
    s.c1 = *(const u32x4*)(CL + (krow0 + 32 + lr) * 128 + lc * 8);
}
__device__ __forceinline__ void sstage_store(const SStage& s, LAS char* buf, int tid) {
    const int row = tid >> 3, ch = tid & 7;
    *(LAS u32x4*)(buf + row * KSTR + ch * 16) = s.kn;
    if (tid < 256) { const int r2 = tid >> 2, c2 = tid & 3; *(LAS u32x4*)(buf + r2 * KSTR + 128 + c2 * 16) = s.kr; }
    const int lr = tid >> 4, lc = tid & 15;
    *(LAS u32x4*)(buf + KB_BYTES + lr * LSTR + lc * 16) = s.c0;
    *(LAS u32x4*)(buf + KB_BYTES + (32 + lr) * LSTR + lc * 16) = s.c1;
}
template <bool FIRST>
__device__ __forceinline__ void attn_tile_lat(const LAS char* buf, const bf16x8 (&qf)[6], float& mrun, float& lrun, f32x16 (&ol)[4], int lane) {
    const int r32 = lane & 31, hi = lane >> 5;
    const LAS char* kp = buf + r32 * KSTR + hi * 16;
    f32x16 p0 = {}, p1 = {};
#pragma unroll
    for (int s = 0; s < 6; ++s) {
        const bf16x8 a0 = *(const LAS bf16x8*)(kp + s * 32), a1 = *(const LAS bf16x8*)(kp + 32 * KSTR + s * 32);
        p0 = __builtin_amdgcn_mfma_f32_32x32x16_bf16(a0, qf[s], p0, 0, 0, 0);
        p1 = __builtin_amdgcn_mfma_f32_32x32x16_bf16(a1, qf[s], p1, 0, 0, 0);
    }
    float mx = fmaxf(p0[0], p1[0]);
#pragma unroll
    for (int r = 1; r < 16; ++r) mx = fmaxf(mx, fmaxf(p0[r], p1[r]));
    mx = max32(mx);
    const float mnew = FIRST ? mx : fmaxf(mrun, mx);
    if (!FIRST && __any(mnew > mrun)) { const float alpha = __builtin_amdgcn_exp2f(mrun - mnew); lrun *= alpha;
#pragma unroll
        for (int cb = 0; cb < 4; ++cb) ol[cb] *= alpha; }
    mrun = mnew;
    float sum = 0.f;
#pragma unroll
    for (int r = 0; r < 16; ++r) { p0[r] = __builtin_amdgcn_exp2f(p0[r] - mnew); p1[r] = __builtin_amdgcn_exp2f(p1[r] - mnew); sum += p0[r] + p1[r]; }
    lrun += sum;
    u32x4 pw[4];
#pragma unroll
    for (int j = 0; j < 4; ++j) { pw[0][j] = pk2(p0[2 * j], p0[2 * j + 1]); pw[1][j] = pk2(p0[8 + 2 * j], p0[8 + 2 * j + 1]); pw[2][j] = pk2(p1[2 * j], p1[2 * j + 1]); pw[3][j] = pk2(p1[8 + 2 * j], p1[8 + 2 * j + 1]); }
    const LAS char* vp = buf + KB_BYTES + (4 * hi + ((lane & 15) >> 2)) * LSTR + (16 * ((lane >> 4) & 1) + 4 * (lane & 3)) * 2;
#pragma unroll
    for (int ks = 0; ks < 4; ++ks) {
        const bf16x8 pf = __builtin_bit_cast(bf16x8, pw[ks]);
#pragma unroll
        for (int cb = 0; cb < 4; ++cb) {
            const bf16x8 v = cat8(vtr(vp + ks * 16 * LSTR + cb * 64), vtr(vp + (ks * 16 + 8) * LSTR + cb * 64));
            ol[cb] = __builtin_amdgcn_mfma_f32_32x32x16_bf16(v, pf, ol[cb], 0, 0, 0);
        }
    }
}
__device__ __forceinline__ void project_v(const bf16* WkvT, int h, const f32x16 (&ol)[4], f32x16& o0, f32x16& o1, int lane) {
    const int d_lo = lane & 31, hi = lane >> 5;
    const bf16* w0 = WkvT + (size_t)(256 * (2 + (h >> 2)) + 32 * (h & 3) + d_lo) * 128 + 4 * hi;
    const bf16* w1 = w0 + (size_t)128 * 128;
    o0 = f32x16{}; o1 = f32x16{};
#pragma unroll
    for (int s = 0; s < 8; ++s) {
        const int cb = s >> 1, rb = 8 * (s & 1), c0 = 32 * cb + 16 * (s & 1);
        u32x4 bw; bw.x = pk2(ol[cb][rb], ol[cb][rb + 1]); bw.y = pk2(ol[cb][rb + 2], ol[cb][rb + 3]); bw.z = pk2(ol[cb][rb + 4], ol[cb][rb + 5]); bw.w = pk2(ol[cb][rb + 6], ol[cb][rb + 7]);
        const bf16x8 bfr = __builtin_bit_cast(bf16x8, bw);
        const u32x2 a00 = *(const u32x2*)(w0 + c0), a01 = *(const u32x2*)(w0 + c0 + 8), a10 = *(const u32x2*)(w1 + c0), a11 = *(const u32x2*)(w1 + c0 + 8);
        const bf16x8 af0 = __builtin_bit_cast(bf16x8, (u32x4){a00.x, a00.y, a01.x, a01.y}), af1 = __builtin_bit_cast(bf16x8, (u32x4){a10.x, a10.y, a11.x, a11.y});
        o0 = __builtin_amdgcn_mfma_f32_32x32x16_bf16(af0, bfr, o0, 0, 0, 0);
        o1 = __builtin_amdgcn_mfma_f32_32x32x16_bf16(af1, bfr, o1, 0, 0, 0);
    }
}

__device__ __forceinline__ void sample_unit(const Ptrs& P, const bf16* CL  , const bf16* WkvT, int b, int h, int qk, float* part, unsigned* cnt, LAS char* lds, int tid_in, int lane_in, int wid) {
    int tid = tid_in, lane = lane_in; asm volatile("" : "+v"(tid), "+v"(lane));
    const int r32 = lane & 31, hi = lane >> 5, qblk = wid & 1, ks = wid >> 1;
    const size_t qrow = (size_t)MP + b * 64 + qblk * 32 + r32;
    bf16x8 qf[6]; load_q(qf, P, qrow, h, hi);
    float mrun = 0.f, lrun = 0.f; f32x16 ol[4] = {f32x16{}, f32x16{}, f32x16{}, f32x16{}};
    const size_t cbase = (size_t)MT + (size_t)b * 4096, nbase = (size_t)MP + b * 64;
    const int t0 = 16 * qk, ntile = (qk == 3) ? 17 : 16, nit = (ntile + 3) >> 2;
    SStage st[4];
#pragma unroll
    for (int j = 0; j < 4; ++j) { sstage_load(st[j], P, CL, cbase + (size_t)(t0 + j) * 64, h, tid); }
#pragma unroll
    for (int j = 0; j < 4; ++j) { sstage_store(st[j], lds + j * STILE_BYTES, tid); }
    __syncthreads();
    for (int it = 0; it < nit; ++it) {
        const int tn = 4 * (it + 1);
#pragma unroll
        for (int j = 0; j < 4; ++j) if (tn + j < ntile) sstage_load(st[j], P, CL, (t0 + tn + j < 64) ? cbase + (size_t)(t0 + tn + j) * 64 : nbase, h, tid);
        if (it == 0) attn_tile_lat<true>(lds + ks * STILE_BYTES, qf, mrun, lrun, ol, lane);
        else if (4 * it + ks < ntile) attn_tile_lat<false>(lds + ks * STILE_BYTES, qf, mrun, lrun, ol, lane);
        __syncthreads();
#pragma unroll
        for (int j = 0; j < 4; ++j) if (tn + j < ntile) sstage_store(st[j], lds + j * STILE_BYTES, tid);
        __syncthreads();
    }
    f32x16 o0, o1; project_v(WkvT, h, ol, o0, o1, lane);
    LAS float* xs = (LAS float*)lds;
    if (ks > 0) { LAS float* s = xs + ((ks - 1) * 2 + qblk) * (34 * 64) + lane; s[0] = mrun; s[64] = lrun;
#pragma unroll
        for (int r = 0; r < 16; ++r) { s[(2 + r) * 64] = o0[r]; s[(18 + r) * 64] = o1[r]; } }
    __syncthreads();
    float* mypart = part + ((size_t)((b * 8 + h) * 4 + qk) * 2 + qblk) * (34 * 64);
    if (ks == 0) {
        float mt = mrun, mo[3];
#pragma unroll
        for (int s = 0; s < 3; ++s) { mo[s] = xs[(s * 2 + qblk) * (34 * 64) + lane]; mt = fmaxf(mt, mo[s]); }
        const float a0 = __builtin_amdgcn_exp2f(mrun - mt); lrun *= a0; o0 *= a0; o1 *= a0; mrun = mt;
#pragma unroll
        for (int s = 0; s < 3; ++s) { const LAS float* sp = xs + (s * 2 + qblk) * (34 * 64) + lane; const float as = __builtin_amdgcn_exp2f(mo[s] - mt);
            lrun += sp[64] * as;
#pragma unroll
            for (int r = 0; r < 16; ++r) { o0[r] += sp[(2 + r) * 64] * as; o1[r] += sp[(18 + r) * 64] * as; } }
        st8wt(part, mypart + 2048 + 2 * lane, (f32x2){mrun, lrun});
#pragma unroll
        for (int k = 0; k < 4; ++k) { st16wt(part, mypart + (k * 64 + lane) * 4, __builtin_bit_cast(u32x4, (f32x4){o0[4 * k], o0[4 * k + 1], o0[4 * k + 2], o0[4 * k + 3]}));
                                      st16wt(part, mypart + ((4 + k) * 64 + lane) * 4, __builtin_bit_cast(u32x4, (f32x4){o1[4 * k], o1[4 * k + 1], o1[4 * k + 2], o1[4 * k + 3]})); }
    }
    asm volatile("s_waitcnt vmcnt(0)" ::: "memory");
    __syncthreads();
    LAS unsigned* flag = (LAS unsigned*)(lds + 6 * 34 * 64 * 4);
    if (tid == 0) {
        asm volatile("s_waitcnt vmcnt(0)" ::: "memory");
        const unsigned old = __hip_atomic_fetch_add(cnt + (b * 8 + h), 1u, __ATOMIC_RELAXED, __HIP_MEMORY_SCOPE_AGENT);
        if (old == 3u) { __builtin_amdgcn_fence(__ATOMIC_ACQUIRE, "agent"); asm volatile("s_waitcnt vmcnt(0)" ::: "memory"); }
        flag[0] = (old == 3u) ? 1u : 0u;
    }
    __syncthreads();
    if (flag[0] != 0u && ks == 0) {
        float mt = mrun, mo[3]; const float* op[3];
#pragma unroll
        for (int s = 0; s < 3; ++s) { const int q2 = (qk + 1 + s) & 3; op[s] = part + ((size_t)((b * 8 + h) * 4 + q2) * 2 + qblk) * (34 * 64); mo[s] = op[s][2048 + 2 * lane]; mt = fmaxf(mt, mo[s]); }
        const float a0 = __builtin_amdgcn_exp2f(mrun - mt); lrun *= a0; o0 *= a0; o1 *= a0;
#pragma unroll
        for (int s = 0; s < 3; ++s) { const float as = __builtin_amdgcn_exp2f(mo[s] - mt);
            lrun += op[s][2048 + 2 * lane + 1] * as;
#pragma unroll
            for (int k = 0; k < 4; ++k) { const f32x4 v0 = *(const f32x4*)(op[s] + (k * 64 + lane) * 4), v1 = *(const f32x4*)(op[s] + ((4 + k) * 64 + lane) * 4);
#pragma unroll
                for (int e = 0; e < 4; ++e) { o0[4 * k + e] += v0[e] * as; o1[4 * k + e] += v1[e] * as; } } }
        finalize(P, qrow, h, lrun, o0, o1, lane);
    }
    __syncthreads();
}

struct GmPtrs { const bf16* VN; bf16* MRG; const bf16* WsB; const float* bs; const float* gog; };
constexpr int WSTR = 272, WS_LDS = 128 * WSTR;
__device__ __forceinline__ void gmlp_wg(const GmPtrs& G, int vcu, LAS char* lds, int tid, int lane, int wave) {
    const int g = vcu & 7, cs = vcu >> 3;
    const bool active = wave < 4 || (wave == 4 && cs < 8);
    int L = 128; size_t row0 = 0;
    if (wave < 4) { const int cidx = 4 * cs + wave; row0 = (size_t)(cidx >> 4) * 2048 + (cidx & 15) * 128; }
    else { row0 = (size_t)MP + cs * 64; L = 64; }
    LAS char* wl = lds + WS_LDS + wave * 24576;
    const int r32 = lane & 31, hi = lane >> 5, nib = L >> 5;
    u32x4 wsr[4], vnr[16];
    { const bf16* Wg = G.WsB + (size_t)g * 128 * 128;
#pragma unroll
      for (int k = 0; k < 4; ++k) { const int idx = k * 512 + tid, r = idx >> 4, ch = idx & 15; wsr[k] = *(const u32x4*)(Wg + r * 128 + ch * 8); } }
    if (active) {
#pragma unroll
        for (int k = 0; k < 16; ++k) { const int idx = k * 64 + lane, r = idx >> 3, ch = idx & 7;
            vnr[k] = (u32x4){0u, 0u, 0u, 0u}; if (r < L) vnr[k] = *(const u32x4*)(G.VN + (row0 + r) * 512 + g * 64 + ch * 8); } }
#pragma unroll
    for (int k = 0; k < 4; ++k) { const int idx = k * 512 + tid, r = idx >> 4, ch = idx & 15; *(LAS u32x4*)(lds + r * WSTR + ch * 16) = wsr[k]; }
    if (active) {
#pragma unroll
        for (int k = 0; k < 16; ++k) { const int idx = k * 64 + lane, r = idx >> 3, ch = idx & 7; if (r < L) *(LAS u32x4*)(wl + r * VSTR + ch * 16) = vnr[k]; } }
    __syncthreads();
    if (active) {
        u32x2 ur[4][4][2];
#pragma unroll
        for (int ib = 0; ib < 4; ++ib) { const bf16* up = G.MRG + (row0 + 32 * ib + r32) * 1024 + 512 + g * 64;
#pragma unroll
            for (int rg = 0; rg < 4; ++rg) { const int d0 = 8 * rg + 4 * hi; ur[ib][rg][0] = (u32x2){0u, 0u}; ur[ib][rg][1] = (u32x2){0u, 0u};
                if (ib < nib) { ur[ib][rg][0] = *(const u32x2*)(up + d0); ur[ib][rg][1] = *(const u32x2*)(up + 32 + d0); } } }
        float bsv4[4];
#pragma unroll
        for (int ib = 0; ib < 4; ++ib) bsv4[ib] = G.bs[g * 128 + 32 * ib + r32];
        f32x16 acc[4][2];
#pragma unroll
        for (int ib = 0; ib < 4; ++ib) { acc[ib][0] = f32x16{}; acc[ib][1] = f32x16{}; }
        const LAS char* vp = wl + (8 * hi + ((lane & 15) >> 2)) * VSTR + (16 * ((lane >> 4) & 1) + 4 * (lane & 3)) * 2;
        const LAS char* wp = lds + r32 * WSTR + hi * 16;
#pragma unroll
        for (int hj = 0; hj < 2; ++hj) {
            if (hj * 64 < L) {
#pragma unroll
                for (int ks = 0; ks < 4; ++ks) {
                    const LAS char* vq = vp + (64 * hj + 16 * ks) * VSTR;
                    const bf16x8 a0 = cat8(vtr(vq), vtr(vq + 4 * VSTR));
                    const bf16x8 a1 = cat8(vtr(vq + 64), vtr(vq + 4 * VSTR + 64));
                    bf16x8 bfr[4];
#pragma unroll
                    for (int ib = 0; ib < 4; ++ib) if (hj == 0 || ib >= 2) bfr[ib] = *(const LAS bf16x8*)(wp + 32 * ib * WSTR + (64 * hj + 16 * ks) * 2);
#pragma unroll
                    for (int ib = 0; ib < 4; ++ib) {
                        if (ib < nib && (hj == 0 || ib >= 2)) {
                            acc[ib][0] = __builtin_amdgcn_mfma_f32_32x32x16_bf16(a0, bfr[ib], acc[ib][0], 0, 0, 0);
                            acc[ib][1] = __builtin_amdgcn_mfma_f32_32x32x16_bf16(a1, bfr[ib], acc[ib][1], 0, 0, 0);
                        }
                    }
                }
            }
        }
#pragma unroll
        for (int ib = 0; ib < 4; ++ib) {
            if (ib < nib) {
                const int i = 32 * ib + r32; const size_t row = row0 + i; const float bsv = bsv4[ib];
                bf16* up = G.MRG + row * 1024 + 512 + g * 64;
                float ss = 0.f;
#pragma unroll
                for (int rg = 0; rg < 4; ++rg) {
                    const u32x2 u0 = ur[ib][rg][0], u1 = ur[ib][rg][1];
                    const float ua[4] = {bflo(u0.x), bfhi(u0.x), bflo(u0.y), bfhi(u0.y)}, ub[4] = {bflo(u1.x), bfhi(u1.x), bflo(u1.y), bfhi(u1.y)};
#pragma unroll
                    for (int e = 0; e < 4; ++e) { const float x0 = ua[e] * (acc[ib][0][4 * rg + e] + bsv), x1 = ub[e] * (acc[ib][1][4 * rg + e] + bsv);
                        acc[ib][0][4 * rg + e] = x0; acc[ib][1][4 * rg + e] = x1; ss += x0 * x0 + x1 * x1; } }
                ss = sum32(ss);
                const float rn = rsq(ss * (1.0f / 64.0f) + EPS);
#pragma unroll
                for (int rg = 0; rg < 4; ++rg) { const int d0 = 8 * rg + 4 * hi;
                    u32x2 w0, w1;
                    w0.x = pk2(acc[ib][0][4 * rg] * rn, acc[ib][0][4 * rg + 1] * rn); w0.y = pk2(acc[ib][0][4 * rg + 2] * rn, acc[ib][0][4 * rg + 3] * rn);
                    w1.x = pk2(acc[ib][1][4 * rg] * rn, acc[ib][1][4 * rg + 1] * rn); w1.y = pk2(acc[ib][1][4 * rg + 2] * rn, acc[ib][1][4 * rg + 3] * rn);
                    *(u32x2*)(up + d0) = w0; *(u32x2*)(up + 32 + d0) = w1; }
            }
        }
    }
    __syncthreads();
}
}
typedef GAS unsigned gu32;
#define RLX_AGENT __ATOMIC_RELAXED, __HIP_MEMORY_SCOPE_AGENT
#define LDS_WAIT() asm volatile("s_waitcnt lgkmcnt(0)" ::: "memory")
#define VM_WAIT() asm volatile("s_waitcnt vmcnt(0)" ::: "memory")
#define XB_TMO      128
#define XB_XCNT(j)  (256  + 64 * (j))
#define XB_XSUB(j)  (1280 + 64 * (j))
#define XB_XGEN(j)  (2304 + 64 * (j))
#define XB_TOP      3328
#define XB_TOPGEN   3392
#define XCD_BAR_WORDS 3456
#define XB_SPIN_CAP (1u << 22)

__device__ __forceinline__ unsigned xb_ld(unsigned* p)              { return __hip_atomic_load(p, __ATOMIC_RELAXED, __HIP_MEMORY_SCOPE_AGENT); }
__device__ __forceinline__ unsigned xb_add(unsigned* p, unsigned v) { return __hip_atomic_fetch_add(p, v, __ATOMIC_RELAXED, __HIP_MEMORY_SCOPE_AGENT); }
__device__ __forceinline__ unsigned xb_xcc_id() { return (unsigned)__builtin_amdgcn_s_getreg((3 << 11) | 20) & 0xFu; }
#define XB_SPIN(cond, bar) do { unsigned _sp = 0; while (cond) { __builtin_amdgcn_s_sleep(1); \
    if ((++_sp & 255u) == 0u) { if (xb_ld(&(bar)[XB_TMO])) break; if (_sp > XB_SPIN_CAP) { atomicAdd(&(bar)[XB_TMO], 1u); break; } } } } while (0)

struct XcdBarrier {
    unsigned* bar; unsigned x;
    volatile LAS unsigned* st;
};

__device__ __forceinline__ bool xb_first_thread(int wave) { unsigned z = 0u; asm volatile("" : "+v"(z)); return wave == 0 && __builtin_amdgcn_mbcnt_hi(~0u, __builtin_amdgcn_mbcnt_lo(~0u, z)) == 0u; }
__device__ __forceinline__ XcdBarrier xcd_barrier_post(unsigned* bar, volatile LAS unsigned* st, int wave) {
    XcdBarrier b; b.bar = bar; b.x = xb_xcc_id(); b.st = st;
    if (xb_first_thread(wave)) (void)xb_add(&bar[XB_XCNT(b.x)], 1u);
    return b;
}
__device__ __forceinline__ void xcd_barrier_complete(unsigned* bar, unsigned x, unsigned& nloc, unsigned& nx) {
    const unsigned G = gridDim.x * gridDim.y * gridDim.z;
    unsigned sum, cnt, mine, sp = 0u;
    for (;;) {
        sum = 0u; cnt = 0u; mine = 0u;
#pragma unroll
        for (unsigned j = 0; j < 16; ++j) { const unsigned c = xb_ld(&bar[XB_XCNT(j)]); sum += c; cnt += (c > 0u) ? 1u : 0u; mine = (j == x) ? c : mine; }
        if (sum == G) break;
        __builtin_amdgcn_s_sleep(1);
        if ((++sp & 255u) == 0u) { if (xb_ld(&bar[XB_TMO])) break; if (sp > XB_SPIN_CAP) { atomicAdd(&bar[XB_TMO], 1u); break; } }
    }
    nloc = mine > 0u ? mine : 1u; nx = cnt > 0u ? cnt : 1u;
}

__device__ __forceinline__ void xcd_barrier(const XcdBarrier& b, int wave) {
    asm volatile("s_waitcnt vmcnt(0)" ::: "memory");
    __syncthreads();
    if (xb_first_thread(wave)) {
        unsigned* bar = b.bar; const unsigned x = xb_xcc_id();
        __builtin_amdgcn_s_waitcnt(0);
        unsigned nloc = b.st[0], nx = b.st[1];
        if (nloc == 0u) { xcd_barrier_complete(bar, x, nloc, nx); b.st[0] = nloc; b.st[1] = nx; }
        const unsigned old = xb_add(&bar[XB_XSUB(x)], 1u);
        const unsigned gen = old / nloc;
        if (old + 1u == (gen + 1u) * nloc) {
            __builtin_amdgcn_fence(__ATOMIC_RELEASE, "agent");
            asm volatile("s_waitcnt vmcnt(0)" ::: "memory");
            const unsigned og = xb_add(&bar[XB_TOP], 1u);
            const unsigned tg = og / nx;
            if (og + 1u == (tg + 1u) * nx) xb_add(&bar[XB_TOPGEN], 1u);
            else XB_SPIN(xb_ld(&bar[XB_TOPGEN]) == tg, bar);
            __builtin_amdgcn_fence(__ATOMIC_ACQUIRE, "agent");
            xb_add(&bar[XB_XGEN(x)], 1u);
            asm volatile("s_waitcnt vmcnt(0)" ::: "memory");
        } else {
            XB_SPIN(xb_ld(&bar[XB_XGEN(x)]) == gen, bar);
            __builtin_amdgcn_fence(__ATOMIC_ACQUIRE, "agent");
            asm volatile("s_waitcnt vmcnt(0)" ::: "memory");
        }
    }
    __syncthreads();
}

__device__ __forceinline__ void seam_wait(unsigned* c0, unsigned* c1, unsigned need, unsigned* bar, int wave) {
    if (xb_first_thread(wave)) {
        XB_SPIN(xb_ld(c0) < need, bar);
        XB_SPIN(xb_ld(c1) < need, bar);
        __builtin_amdgcn_fence(__ATOMIC_ACQUIRE, "agent");
        asm volatile("s_waitcnt vmcnt(0)" ::: "memory");
    }
    __syncthreads();
}

struct PanelOrder {
    int pm, j, ks, wave; unsigned* scnt; unsigned* bar;
    __device__ __forceinline__ void init(int G, int c, unsigned* scnt_, unsigned* bar_, int wave_) {
        pg8::StaticOrder S; S.init(MP, 1024, G, c); pg8::Unit u; u.pm = 0; u.pn = 0; (void)S.next(0, u); pm = u.pm; j = u.pn;
        const int k = 2 * pm + (j - 2); ks = (j >= 2 && k < 44) ? k : -1; scnt = scnt_; bar = bar_; wave = wave_; }
    __device__ __forceinline__ bool next(int i, pg8::Unit& u) const {
#ifdef SAMPLE_SECOND
        if (ks >= 0) {
            if (i == 1) { u.pm = 64 + (ks & 1); u.pn = ks >> 1; return true; }
            if (i < 6) { u.pm = pm; u.pn = 4 * (i == 0 ? 0 : i - 1) + j; return true; }
            return false; }
#endif
        if (i < 5) { u.pm = pm; u.pn = 4 * i + j; return true; }
        if (i == 5) { if (j < 2) { u.pm = pm; u.pn = 20 + j; return true; } if (ks >= 0) { u.pm = 64 + (ks & 1); u.pn = ks >> 1; return true; } }
        return false; }
    __device__ __forceinline__ void a_ready(const pg8::Unit& u) const {
        if (u.pm >= 64) {
            if (xb_first_thread(wave)) { XB_SPIN(xb_ld(scnt) < 256u, bar); __builtin_amdgcn_fence(__ATOMIC_ACQUIRE, "agent"); asm volatile("s_waitcnt vmcnt(0)" ::: "memory"); }
            asm volatile("" ::: "memory"); __builtin_amdgcn_s_barrier(); asm volatile("" ::: "memory");
        }
    }
    __device__ __forceinline__ void done(const pg8::Unit&) const {}
};

struct OwnerOrder6 {
    int pm, j, ks; unsigned* cnt;
    __device__ __forceinline__ void init(int G, int c, unsigned* cnt_) { pg8::StaticOrder S; S.init(MP, 1024, G, c); pg8::Unit u; u.pm = 0; u.pn = 0; (void)S.next(0, u); pm = u.pm; j = u.pn;
        const int k = 2 * pm + (j - 2); ks = (j >= 2 && k < 12) ? k : -1; cnt = cnt_; }
    __device__ __forceinline__ bool idle() const { return j >= 2 && ks < 0; }
    __device__ __forceinline__ int idle_index() const { return 2 * (pm - 6) + (j - 2); }
    __device__ __forceinline__ bool next(int i, pg8::Unit& u) const {
        if (i == 0) { u.pm = pm; u.pn = j; return true; }
        if (i == 1) { if (j < 2) { u.pm = pm; u.pn = 4 + j; return true; } if (ks >= 0) { u.pm = 64 + (ks & 1); u.pn = ks >> 1; return true; } }
        return false; }
    __device__ __forceinline__ void a_ready(const pg8::Unit&) const {}
    __device__ __forceinline__ void done(const pg8::Unit& u) const {
        if (cnt != nullptr && u.pn < 2) { asm volatile("s_waitcnt vmcnt(0)" ::: "memory");
            unsigned z = 0u; asm volatile("" : "+v"(z)); if (__builtin_amdgcn_mbcnt_hi(~0u, __builtin_amdgcn_mbcnt_lo(~0u, z)) == 0u) (void)xb_add(cnt + 16 * u.pm, 1u); } }
};
struct ListOrder {
    int n, c0, c1, c2;
    __device__ __forceinline__ bool next(int i, pg8::Unit& u) const { if (i >= n) return false; const int c = i == 0 ? c0 : (i == 1 ? c1 : c2); u.pm = c >> 8; u.pn = c & 255; return true; }
    __device__ __forceinline__ void a_ready(const pg8::Unit&) const {}
    __device__ __forceinline__ void done(const pg8::Unit&) const {}
};

__device__ __forceinline__ int cmap_in(int n)  {
    if (n < 416) return n; if (n < 512) return -1; if (n < 1024) return n - 96;
    const int t = (n - 1024) >> 8, p = n & 255, bj = p >> 7, wc = (p >> 5) & 3, q = p & 31; return 928 + 64 * (4 * t + wc) + 32 * bj + q; }
__device__ __forceinline__ int cmap_qup(int n) { const int t = n >> 8, p = n & 255, bj = p >> 7, wc = (p >> 5) & 3, q = p & 31;
    if (t < 2) return (4 * t + wc) * 96 + 32 * bj + q;
    return (2 * wc + bj) * 96 + 64 + 16 * ((q >> 2) & 1) + 4 * (q >> 3) + (q & 3); }
__device__ __forceinline__ int cmap_kv(int n)  { const int t = n >> 8, p = n & 255, bj = p >> 7, wc = (p >> 5) & 3, q = p & 31;
    return (t < 2) ? (4 * t + wc) * 128 + 32 * bj + q : (4 * (t - 2) + wc) * 128 + 64 + 32 * bj + q; }

template <int WHICH  , bool GAIN>
__device__ __forceinline__ void transpose_item(const float* W, const float* W2, int K, int Nsrc, const float* gain, bf16* WT, LAS float* scr, int item, int nblk, int lane) {
    (void)scr;
    const int kb = item / nblk, nb = item % nblk, k0 = 64 * kb + 8 * (lane >> 3), n0 = 32 * nb, n = n0 + 4 * (lane & 7);
    int colq; const float* srcq = W;
    if (WHICH == 0) colq = cmap_in(n); else if (WHICH == 1) colq = cmap_qup(n); else if (WHICH == 2) colq = cmap_kv(n); else if (WHICH == 3 || WHICH == 5) colq = n;
    else { const int t = n >> 8, p = n & 255; if (p < 128) colq = 128 * t + p; else { colq = 128 * t + p - 128; srcq = W2; } }
    f32x4 v[8];
#pragma unroll
    for (int j = 0; j < 8; ++j) v[j] = (f32x4){0.f, 0.f, 0.f, 0.f};
    if (colq >= 0) {
#pragma unroll
        for (int j = 0; j < 8; ++j) v[j] = *(const f32x4*)(srcq + (size_t)(k0 + j) * Nsrc + colq);
        if (GAIN) { const float* gq = (WHICH == 5 && k0 >= 512) ? W2 + (k0 - 512) : gain + k0;
            const f32x4 g0 = *(const f32x4*)gq, g1 = *(const f32x4*)(gq + 4);
#pragma unroll
            for (int j = 0; j < 4; ++j) { v[j] = v[j] * g0[j]; v[4 + j] = v[4 + j] * g1[j]; } }
    }
#pragma unroll
    for (int e = 0; e < 4; ++e) { u32x4 o; o.x = pk2(v[0][e], v[1][e]); o.y = pk2(v[2][e], v[3][e]); o.z = pk2(v[4][e], v[5][e]); o.w = pk2(v[6][e], v[7][e]);
        *(u32x4*)(WT + (size_t)(n + e) * K + k0) = o; }
}

template <int KTOT>
__device__ __forceinline__ void sample_res_gemm(const bf16* A, int lda, const bf16* Bt, float* out, bf16* XB, float* ssq, int final_f32, int wt, int task, LAS char* lds, int lane, int wave) {
    const int fr = lane & 15, fq = lane >> 4, xcd_ = task >> 5, j_ = task & 31, t0 = 64 * (4 * (xcd_ & 1) + (j_ & 3)), n0 = 32 * (8 * (xcd_ >> 1) + (j_ >> 2));
    constexpr int KW = KTOT / 8, NS = KW / 32, CH = 4;
    static_assert(KW % 32 == 0, "k split");
    const bf16* wp = Bt + (size_t)(n0 + fr) * KTOT + wave * KW + 8 * fq;
    const bf16* xq = A + (size_t)(MP + t0 + fr) * lda + wave * KW + 8 * fq;
    f32x4 acc[2][4];
#pragma unroll
    for (int nf = 0; nf < 2; ++nf)
#pragma unroll
        for (int mf = 0; mf < 4; ++mf) acc[nf][mf] = (f32x4){0.f, 0.f, 0.f, 0.f};
#pragma unroll
    for (int c0 = 0; c0 < NS; c0 += CH) {
        bf16x8 wv[2][CH], xv[4][CH];
#pragma unroll
        for (int nf = 0; nf < 2; ++nf)
#pragma unroll
            for (int s = 0; s < CH; ++s) if (c0 + s < NS) wv[nf][s] = *(const bf16x8*)(wp + (size_t)16 * nf * KTOT + 32 * (c0 + s));
#pragma unroll
        for (int mf = 0; mf < 4; ++mf)
#pragma unroll
            for (int s = 0; s < CH; ++s) if (c0 + s < NS) xv[mf][s] = *(const bf16x8*)(xq + (size_t)16 * mf * lda + 32 * (c0 + s));
        __builtin_amdgcn_sched_barrier(0);
#pragma unroll
        for (int s = 0; s < CH; ++s) if (c0 + s < NS) {
#pragma unroll
            for (int nf = 0; nf < 2; ++nf)
#pragma unroll
                for (int mf = 0; mf < 4; ++mf) acc[nf][mf] = __builtin_amdgcn_mfma_f32_16x16x32_bf16(wv[nf][s], xv[mf][s], acc[nf][mf], 0, 0, 0);
        }
        __builtin_amdgcn_sched_barrier(0);
    }
    LAS f32x4* ps = (LAS f32x4*)lds + wave * 512 + lane;
#pragma unroll
    for (int nf = 0; nf < 2; ++nf)
#pragma unroll
        for (int mf = 0; mf < 4; ++mf) ps[(nf * 4 + mf) * 64] = acc[nf][mf];
    __syncthreads();
    { const int nf = wave >> 2, mf = wave & 3; f32x4 sum = {0.f, 0.f, 0.f, 0.f};
      const LAS f32x4* rp = (const LAS f32x4*)lds + wave * 64 + lane;
#pragma unroll
      for (int p = 0; p < 8; ++p) sum += rp[p * 512];
      const size_t rs = (size_t)t0 + 16 * mf + fr;
      const int col = n0 + 16 * nf + 4 * fq;
      bf16* xp = XB + ((size_t)MP + rs) * 1024 + col; const u32x2 xw = *(const u32x2*)xp;
      const f32x4 o = (f32x4){bflo(xw.x), bfhi(xw.x), bflo(xw.y), bfhi(xw.y)} + sum;
      if (final_f32) *(f32x4*)(out + ((size_t)MP + rs) * 1024 + col) = o;
      else { u32x2 w; w.x = pk2(o[0], o[1]); w.y = pk2(o[2], o[3]); if (wt) st8wtu(XB, xp, w); else *(u32x2*)xp = w; const float ss = sum32(sum16(dot4v(o))); if (fq == 0) atomicAdd(ssq + MP + rs, ss); } }
    asm volatile("s_waitcnt vmcnt(0)" ::: "memory");
    __syncthreads();
}

struct Args { const float* in[25]; float* out; unsigned char* ws; };
enum { I_XP = 0, I_XS, I_CCKV, I_CKR, I_GMIX, I_WIN, I_GQL, I_WQUP, I_GQN, I_GQR, I_GKVL, I_GKR, I_WKV, I_GKN, I_LNG, I_LNB, I_WS, I_BS, I_GOA, I_GOG, I_WO, I_GFFN, I_WG, I_WU, I_WD };

constexpr int I_IN = 16 * 48, I_QU = 4 * 24, I_KV = 2 * 32, I_KVG = 2 * 32, I_O = 16 * 32, I_GU = 16 * 176, I_D = 44 * 32, I_LAYER = I_IN + I_QU + I_KV + I_KVG + I_O + I_GU + I_D, I_EARLY = I_IN + I_QU + I_KV + I_KVG;
__device__ __forceinline__ void convert_items(const Args& A, unsigned char* ws, LAS float* scr, int first, int last, int widx, int nw, int lane) {
    for (int it = first + widx; it < last; it += nw) {
        const int l = it / I_LAYER; int r = it % I_LAYER; unsigned char* wb = ws + WS_W + (size_t)l * LW;
        if (r < I_IN) { transpose_item<0, true>(A.in[I_WIN] + (size_t)l * 1024 * 1440, nullptr, 1024, 1440, A.in[I_GMIX] + l * 1024, (bf16*)(wb + W_IN), scr, r, 48, lane); continue; } r -= I_IN;
        if (r < I_QU) { transpose_item<1, true>(A.in[I_WQUP] + (size_t)l * 256 * 768, nullptr, 256, 768, A.in[I_GQL] + l * 256, (bf16*)(wb + W_QUP), scr, r, 24, lane); continue; } r -= I_QU;
        if (r < I_KV) { transpose_item<2, false>(A.in[I_WKV] + (size_t)l * 128 * 1024, nullptr, 128, 1024, nullptr, (bf16*)(wb + W_KV), scr, r, 32, lane); continue; } r -= I_KV;
        if (r < I_KVG) { transpose_item<2, true>(A.in[I_WKV] + (size_t)l * 128 * 1024, nullptr, 128, 1024, A.in[I_GKVL] + l * 128, (bf16*)(ws + WS_WKVG + (size_t)l * 262144), scr, r, 32, lane); continue; } r -= I_KVG;
        if (r < I_O) { transpose_item<5, true>(A.in[I_WO] + (size_t)l * 1024 * 1024, A.in[I_GOG] + l * 512, 1024, 1024, A.in[I_GOA] + l * 512, (bf16*)(wb + W_O), scr, r, 32, lane); continue; } r -= I_O;
        if (r < I_GU) { transpose_item<4, true>(A.in[I_WG] + (size_t)l * 1024 * DFF, A.in[I_WU] + (size_t)l * 1024 * DFF, 1024, DFF, A.in[I_GFFN] + l * 1024, (bf16*)(wb + W_GU), scr, r, 176, lane); continue; } r -= I_GU;
        transpose_item<3, false>(A.in[I_WD] + (size_t)l * DFF * 1024, nullptr, DFF, 1024, nullptr, (bf16*)(wb + W_D), scr, r, 32, lane);
    }
}
__device__ __forceinline__ void convert_cache(const Args& A, unsigned char* ws, int l, int tix, int ntx) {
    for (int i0 = tix; i0 < MC * 16; i0 += 4 * ntx) { f32x4 a[4], b[4];
#pragma unroll
        for (int u = 0; u < 4; ++u) { const int i = i0 + u * ntx; if (i < MC * 16) { const float* s = A.in[I_CCKV] + ((size_t)l * MC + (i >> 4)) * 128 + (i & 15) * 8; a[u] = *(const f32x4*)s; b[u] = *(const f32x4*)(s + 4); } }
#pragma unroll
        for (int u = 0; u < 4; ++u) { const int i = i0 + u * ntx; if (i < MC * 16) { u32x4 o; o.x = pk2(a[u][0], a[u][1]); o.y = pk2(a[u][2], a[u][3]); o.z = pk2(b[u][0], b[u][1]); o.w = pk2(b[u][2], b[u][3]);
            *(u32x4*)(ws + WS_CKVA + (size_t)l * L_CKVA + ((size_t)(MT + (i >> 4)) * 128 + (i & 15) * 8) * 2) = o; } } }
    for (int i = tix; i < MC * 4; i += ntx) { const int r = i >> 2, c0 = (i & 3) * 8;
        const float* s = A.in[I_CKR] + ((size_t)l * MC + r) * 32 + c0; const f32x4 a = *(const f32x4*)s, b = *(const f32x4*)(s + 4);
        u32x4 o; o.x = pk2(a[0], a[1]); o.y = pk2(a[2], a[3]); o.z = pk2(b[0], b[1]); o.w = pk2(b[2], b[3]);
        *(u32x4*)(ws + WS_KR + (size_t)l * L_KR + ((size_t)(MT + r) * 32 + c0) * 2) = o; }
}
__device__ __forceinline__ void p0_prologue(const Args& A, unsigned char* ws, LAS unsigned char* lds, int vcu, int G, int wave, int lane, int tid) {
    LAS float* scr = (LAS float*)(lds + wave * 16384);
    const int gw = vcu * 8 + wave, NGW = G * 8;
#ifdef NO_DEFER
    convert_items(A, ws, scr, 0, 2 * I_LAYER, gw, NGW, lane);
#else
    convert_items(A, ws, scr, 0, I_EARLY, gw, NGW, lane);
#endif
    const int gt = vcu * 512 + tid, NGT = G * 512;
    for (int i = gt; i < 2 * 8 * 128 * 16; i += NGT) { const int l = i >> 14, rem = i & 16383, gi = rem >> 4, j0 = (rem & 15) * 8, ii = gi & 127;
        const float* s = A.in[I_WS] + (size_t)l * 131072 + (size_t)gi * 128 + j0; const bool vis = (ii >> 6) >= (j0 >> 6);
        const f32x4 a = *(const f32x4*)s, b = *(const f32x4*)(s + 4);
        u32x4 o; o.x = pk2(a[0], a[1]); o.y = pk2(a[2], a[3]); o.z = pk2(b[0], b[1]); o.w = pk2(b[2], b[3]); if (!vis) o = (u32x4){0u, 0u, 0u, 0u};
        *(u32x4*)(ws + WS_W + (size_t)l * LW + W_S + ((size_t)gi * 128 + j0) * 2) = o; }
#ifdef NO_DEFER
    convert_cache(A, ws, 0, gt, NGT); convert_cache(A, ws, 1, gt, NGT);
#endif
    for (int i = gt; i < 2112 * 16; i += NGT) { const int pi = i >> 4, j = i & 15; const int pos = pi < 2048 ? pi : 4096 + (pi - 2048);
        const float inv = __builtin_amdgcn_exp2f(-(float)j * (13.287712379549449f / 16.0f)); const float ang = (float)pos * inv;
        const double t = (double)ang * 0.15915494309189535; const float fr = (float)(t - __builtin_rint(t));
        f32x2 cs; cs.x = __builtin_amdgcn_cosf(fr); cs.y = __builtin_amdgcn_sinf(fr);
        *(f32x2*)(ws + WS_ROPE + (size_t)i * 8) = cs; }
    bf16* XB = (bf16*)(ws + B_XB); float* ssq0 = (float*)(ws + WS_CTL + CTL_SSQ);
    for (int mp = gw; mp < MT / 2; mp += NGW) {
        f32x4 v[2][4];
#pragma unroll
        for (int u = 0; u < 2; ++u) { const int m = 2 * mp + u; const float* xr = (m < MP) ? A.in[I_XP] + (size_t)m * 1024 : A.in[I_XS] + (size_t)(m - MP) * 1024;
#pragma unroll
            for (int j = 0; j < 4; ++j) v[u][j] = *(const f32x4*)(xr + 256 * j + 4 * lane); }
#pragma unroll
        for (int u = 0; u < 2; ++u) { const int m = 2 * mp + u; float s = 0.f;
#pragma unroll
            for (int j = 0; j < 4; ++j) { s += dot4v(v[u][j]); u32x2 w; w.x = pk2(v[u][j][0], v[u][j][1]); w.y = pk2(v[u][j][2], v[u][j][3]); *(u32x2*)(XB + (size_t)m * 1024 + 256 * j + 4 * lane) = w; }
            s = wave_sum(s); if (lane == 0) ssq0[m] = s; } }
}

struct P2Ptrs { const bf16* Z; bf16* MRG; bf16* CKVA; bf16* KR; bf16* VN; const float* rope; float* out;
                const float* gql; const float* gkvl; const float* gkr; const float* lng; const float* lnb; };
__device__ __forceinline__ void p2_rows8(const P2Ptrs& P, int l, int m0, int lane) {
    const int j = lane & 7, m = m0 + (lane >> 3);
    const bf16* z = P.Z + (size_t)m * NZ;
    const u32x4 c0 = *(const u32x4*)(z + 256 + 16 * j), c1 = *(const u32x4*)(z + 256 + 16 * j + 8);
    const u32x2 kw = *(const u32x2*)(z + 384 + 4 * j);
    const bool smp = m >= MP; const int ms = m - MP; const int posidx = smp ? 2048 + (ms & 63) : (m & 2047);
    { f32x4 c[4] = {(f32x4){bflo(c0.x), bfhi(c0.x), bflo(c0.y), bfhi(c0.y)}, (f32x4){bflo(c0.z), bfhi(c0.z), bflo(c0.w), bfhi(c0.w)},
                    (f32x4){bflo(c1.x), bfhi(c1.x), bflo(c1.y), bfhi(c1.y)}, (f32x4){bflo(c1.z), bfhi(c1.z), bflo(c1.w), bfhi(c1.w)}};
      const float ss = sum8((dot4v(c[0]) + dot4v(c[1])) + (dot4v(c[2]) + dot4v(c[3]))); const float rn = rsq(ss * (1.0f / 128.0f) + EPS);
      float* o = (smp ? P.out + O_CKVS + ((size_t)l * MS + ms) * 128 : P.out + O_CKVP + ((size_t)l * MP + m) * 128) + 16 * j;
#pragma unroll
      for (int q = 0; q < 4; ++q) { c[q] = c[q] * rn * *(const f32x4*)(P.gkvl + 16 * j + 4 * q); *(f32x4*)(o + 4 * q) = c[q]; }
      if (smp) { u32x4 w0, w1;
          w0.x = pk2(c[0][0], c[0][1]); w0.y = pk2(c[0][2], c[0][3]); w0.z = pk2(c[1][0], c[1][1]); w0.w = pk2(c[1][2], c[1][3]);
          w1.x = pk2(c[2][0], c[2][1]); w1.y = pk2(c[2][2], c[2][3]); w1.z = pk2(c[3][0], c[3][1]); w1.w = pk2(c[3][2], c[3][3]);
          bf16* cp = P.CKVA + (size_t)m * 128 + 16 * j; *(u32x4*)cp = w0; *(u32x4*)(cp + 8) = w1; } }
    { const f32x4 k = {bflo(kw.x), bfhi(kw.x), bflo(kw.y), bfhi(kw.y)};
      const float ss = sum8(dot4v(k)); const float rn = rsq(ss * (1.0f / 32.0f) + EPS);
      const f32x4 own = k * rn * *(const f32x4*)(P.gkr + 4 * j);
      f32x4 oth; oth[0] = SWZ_XOR(own[0], 4); oth[1] = SWZ_XOR(own[1], 4); oth[2] = SWZ_XOR(own[2], 4); oth[3] = SWZ_XOR(own[3], 4);
      const float* rp = P.rope + (size_t)(posidx * 16 + 4 * (j & 3)) * 2;
      const f32x4 cs0 = *(const f32x4*)rp, cs1 = *(const f32x4*)(rp + 4);
      const f32x4 cc = {cs0[0], cs0[2], cs1[0], cs1[2]}, sn = {cs0[1], cs0[3], cs1[1], cs1[3]};
      const f32x4 o = (j < 4) ? own * cc - oth * sn : oth * sn + own * cc;
      float* ok = (smp ? P.out + O_KRS + ((size_t)l * MS + ms) * 32 : P.out + O_KRP + ((size_t)l * MP + m) * 32) + 4 * j;
      *(f32x4*)ok = o;
      u32x2 w; w.x = pk2(o[0], o[1]); w.y = pk2(o[2], o[3]); *(u32x2*)(P.KR + (size_t)m * 32 + 4 * j) = w; }
}

#ifndef REP_P0
#define REP_P0 1
#endif
#ifndef REP_P1
#define REP_P1 1
#endif
#ifndef REP_P2
#define REP_P2 1
#endif
#ifndef REP_P3
#define REP_P3 1
#endif
#ifndef REP_P4A
#define REP_P4A 1
#endif
#ifndef REP_P4B
#define REP_P4B 1
#endif
#ifndef REP_P6
#define REP_P6 1
#endif
#ifndef REP_BAR
#define REP_BAR 1
#endif
template <class T> __device__ __forceinline__ T* as_global(T* p) {
#if defined(__HIP_DEVICE_COMPILE__)
    __builtin_assume(!__builtin_amdgcn_is_shared((const __attribute__((address_space(0))) void*)p));
    __builtin_assume(!__builtin_amdgcn_is_private((const __attribute__((address_space(0))) void*)p));
#endif
    return p;
}
#define FRESH_TID() unsigned z_p = 0u; asm volatile("" : "+v"(z_p)); const int lane_p = (int)__builtin_amdgcn_mbcnt_hi(~0u, __builtin_amdgcn_mbcnt_lo(~0u, z_p)); const int tid_p = wave * 64 + lane_p
#define FRESH_PTRS() size_t zo_p = 0; asm volatile("" : "+s"(zo_p)); \
    unsigned char* ws = args.ws + zo_p; float* out = args.out + zo_p;     \
    int G = gridDim.x, bx = blockIdx.x; asm volatile("" : "+s"(G), "+s"(bx)); const int vcu = (G % 8 == 0) ? (bx % 8) * (G / 8) + bx / 8 : bx; (void)vcu; (void)out
#define GRID_BAR() for (int repb_ = 0; repb_ < REP_BAR; ++repb_) do { size_t zo_b = 0; asm volatile("" : "+s"(zo_b)); unsigned char* wsb = args.ws + zo_b; XcdBarrier bar_; bar_.bar = (unsigned*)(wsb + WS_CTL) + CW_BAR; bar_.x = 0; bar_.st = (volatile LAS unsigned*)(lds + MISC_OFF) + 8; xcd_barrier(bar_, wave); } while (0)
#ifdef PROBE_STAMPS
#define STAMP(k) do { if (blockIdx.x == 0 && wave == 0) { const unsigned long long t_ = __builtin_amdgcn_s_memrealtime(); volatile LAS unsigned* m_ = (volatile LAS unsigned*)(lds + MISC_OFF) + 16 + 2 * (k); \
        if (xb_first_thread(wave)) { m_[0] = (unsigned)t_; m_[1] = (unsigned)(t_ >> 32); } } } while (0)
#define STAMPG(k, blk) do { if ((int)blockIdx.x == (blk) && wave == 0) { const unsigned long long t_ = __builtin_amdgcn_s_memrealtime(); \
        if (xb_first_thread(wave)) __hip_atomic_store((unsigned long long*)(args.ws + WS_CTL + 983040) + (k), t_, __ATOMIC_RELAXED, __HIP_MEMORY_SCOPE_AGENT); } } while (0)
#define STAMPW(q) do { if (wave == 0) { const unsigned long long t_ = __builtin_amdgcn_s_memrealtime(); \
        if (xb_first_thread(wave)) __hip_atomic_store((unsigned long long*)(args.ws + WS_CTL + 983040 + 1024) + (q) * 256 + blockIdx.x, t_, __ATOMIC_RELAXED, __HIP_MEMORY_SCOPE_AGENT); } } while (0)
#else
#define STAMP(k) do {} while (0)
#define STAMPG(k, blk) do {} while (0)
#define STAMPW(q) do {} while (0)
#endif
__global__ void __launch_bounds__(512, 2) hybrid_fwd(Args args) {
    extern __shared__ __attribute__((aligned(16))) unsigned char lds_raw[];
    LAS unsigned char* lds = (LAS unsigned char*)lds_raw;
    const int wave = __builtin_amdgcn_readfirstlane(threadIdx.x >> 6);
    { FRESH_TID(); for (int u = tid_p; u < (LDS_BYTES - RING_BYTES) / 4; u += 512) ((LAS unsigned*)(lds + RING_BYTES))[u] = 0u; }
    __syncthreads();
    { FRESH_PTRS(); (void)xcd_barrier_post((unsigned*)(ws + WS_CTL) + CW_BAR, (volatile LAS unsigned*)(lds + MISC_OFF) + 8, wave); }

    STAMP(0);
#ifndef NO_P0
    asm volatile("; MARK_P0");
    for (int rep_ = 0; rep_ < REP_P0; ++rep_) { FRESH_TID(); FRESH_PTRS(); p0_prologue(args, ws, lds, vcu, G, wave, lane_p, tid_p); }
#endif
    STAMPW(0); GRID_BAR();
        STAMP(1);

    for (int l = 0; l < NLAYER; ++l) {
#ifndef NO_P1
        asm volatile("; MARK_P1");
        for (int rep_ = 0; rep_ < REP_P1; ++rep_) { FRESH_PTRS(); unsigned char* wb = ws + WS_W + (size_t)l * LW;
          pg8::Gemm g{(const bf16*)(ws + B_XB), (const bf16*)(wb + W_IN), MT, NZ, 1024, 1024};
          OwnerOrder6 S; S.init(G, bx, l == NLAYER - 1 ? (unsigned*)(ws + WS_CTL + CTL_CNT1) : nullptr);
          pg8::EpiZ E{(bf16*)(ws + B_Z), (const float*)(ws + WS_CTL + CTL_SSQ) + (size_t)(2 * l) * MT, (bf16*)(ws + B_MRG), (bf16*)(ws + B_VN), out + O_GVS + (size_t)l * MS * 512, args.in[I_LNG] + l * 512, args.in[I_LNB] + l * 512,
                      (float*)(ws + WS_CTL + CTL_SSQQ) + (size_t)l * MT, (float*)(ws + WS_CTL + CTL_SSQC) + (size_t)l * MT, ws, l == NLAYER - 1 ? 1 : 0};
          pg8::gemm_phase<pg8::EpiZ, OwnerOrder6, true, true>(lds, g, S, E, wave); STAMPG(16 + l, 0); STAMPG(18 + l, 200);
          if (l == 1 && S.idle()) {
              const int T = S.idle_index();
              pg8::Gemm g3{(const bf16*)(ws + WS_CKVA + (size_t)l * L_CKVA) + (size_t)MT * 128, (const bf16*)(wb + W_KV), MC, 512, 128, 128}; ListOrder S3{1, ((T >> 1) << 8) | (T & 1), 0, 0};
              pg8::EpiKV E3{(bf16*)(ws + B_KN) + (size_t)MT * 512, (bf16*)(ws + B_VV) + (size_t)MT * 512, args.in[I_GKN] + l * 64, nullptr, ws};
              pg8::gemm_phase<pg8::EpiKV, ListOrder, true, true>(lds, g3, S3, E3, wave); }
#ifndef NO_DEFER
          if (l == 0 && S.idle()) { FRESH_TID(); const int idl = S.idle_index();
                                     convert_items(args, ws, (LAS float*)(lds + wave * 16384), I_EARLY, I_LAYER, idl * 8 + wave, 116 * 8, lane_p);
                                     convert_cache(args, ws, 0, idl * 512 + tid_p, 116 * 512); convert_cache(args, ws, 1, idl * 512 + tid_p, 116 * 512); }
#endif
          STAMPG(20 + l, 200);
          }
#endif
        STAMPW(1 + 6 * l); if (l != NLAYER - 1) GRID_BAR();
        STAMP(2 + 6 * l);
#ifndef NO_P3
        asm volatile("; MARK_P3");
        if (l != NLAYER - 1) {
        { FRESH_TID(); FRESH_PTRS();
          P2Ptrs P{(const bf16*)(ws + B_Z), (bf16*)(ws + B_MRG), (bf16*)(ws + WS_CKVA + (size_t)l * L_CKVA), (bf16*)(ws + WS_KR + (size_t)l * L_KR), (bf16*)(ws + B_VN), (const float*)(ws + WS_ROPE), out,
                   args.in[I_GQL] + l * 256, args.in[I_GKVL] + l * 128, args.in[I_GKR] + l * 32, args.in[I_LNG] + l * 512, args.in[I_LNB] + l * 512};
          if (G != 256) { const int gw = vcu * 8 + wave, NGW = G * 8; for (int mg = gw; mg < MT / 8; mg += NGW) p2_rows8(P, l, 8 * mg, lane_p); }
          else if (bx >= 198 && bx < 248) { const int gw = (bx - 198) * 8 + wave, NGW = 50 * 8; for (int mg = gw; mg < MT / 8; mg += NGW) p2_rows8(P, l, 8 * mg, lane_p); } }
        STAMPG(36 + l, 0);
        { FRESH_PTRS(); unsigned char* wb = ws + WS_W + (size_t)l * LW;
          pg8::Gemm g{(const bf16*)(ws + B_Z), (const bf16*)(wb + W_QUP), MT, 768, 256, NZ}; pg8::StaticOrder S; S.init(MT, 768, G, bx);
          pg8::EpiQ E{(bf16*)(ws + B_QNP), (bf16*)(ws + B_QRP), args.in[I_GQN] + l * 64, args.in[I_GQR] + l * 32, (const float*)(ws + WS_ROPE), (const float*)(ws + WS_CTL + CTL_SSQQ) + (size_t)l * MT, ws};
          pg8::gemm_phase<pg8::EpiQ, pg8::StaticOrder, true, true>(lds, g, S, E, wave); }
        STAMPG(38 + l, 0);
        asm volatile("; MARK_P3B");
        { FRESH_PTRS();
          pg8::Gemm g{(const bf16*)(ws + B_Z) + 256, (const bf16*)(ws + WS_WKVG + (size_t)l * 262144), MT, 1024, 128, NZ}; pg8::StaticOrder S; S.init(MT, 1024, G, (bx + 8) % G);
          pg8::EpiKV E{(bf16*)(ws + B_KN), (bf16*)(ws + B_VV), args.in[I_GKN] + l * 64, (const float*)(ws + WS_CTL + CTL_SSQC) + (size_t)l * MT, ws};
          pg8::gemm_phase<pg8::EpiKV, pg8::StaticOrder, true, true>(lds, g, S, E, wave); }
        STAMPG(40 + l, 0);
        if (l == 0) { FRESH_PTRS(); unsigned char* wb = ws + WS_W + (size_t)l * LW;
          pg8::Gemm g{(const bf16*)(ws + WS_CKVA + (size_t)l * L_CKVA) + (size_t)MT * 128, (const bf16*)(wb + W_KV), MC, 512, 128, 128}; pg8::StaticOrder S; S.init(MC, 512, G, bx);
          pg8::EpiKV E{(bf16*)(ws + B_KN) + (size_t)MT * 512, (bf16*)(ws + B_VV) + (size_t)MT * 512, args.in[I_GKN] + l * 64, nullptr, ws};
          pg8::gemm_phase<pg8::EpiKV, pg8::StaticOrder, true, true>(lds, g, S, E, wave); }
        } else {
        int rowp = -1, nq = 0, q0 = 0, q1 = 0, nk = 0, k0 = 0, k1 = 0, k2 = 0, ownw = 0, smpw = 0, nc = 0, cc0 = 0, cc1 = 0;
        { FRESH_PTRS(); OwnerOrder6 O; O.init(G, bx, nullptr); const int pm = O.pm, j = O.j;
          if (pm >= 6) {
              if (j == 2) { rowp = pm; nq = 2; q0 = pm << 8; q1 = (pm << 8) | 1; nk = 1; k0 = pm << 8; ownw = 1; }
              else if (j == 3) { nq = 1; q0 = (pm << 8) | 2; nk = 3; k0 = (pm << 8) | 1; k1 = (pm << 8) | 2; k2 = (pm << 8) | 3; ownw = 1; }
              else { const int idx = 2 * (pm - 6) + j;
                  if (idx < 6) { nq = 1; q0 = ((64 + idx / 3) << 8) | (idx % 3); smpw = 1; }
                  else if (idx < 14) { nk = 1; k0 = ((64 + (idx - 6) / 4) << 8) | ((idx - 6) % 4); smpw = 1; }
                  else if (idx < 16) { rowp = 64 + (idx - 14); smpw = 1; }
                  else { const int e = idx - 16; int T = 116 + e; nc = 1; cc0 = ((T >> 1) << 8) | (T & 1); if (e < 40) { T = 216 + e; nc = 2; cc1 = ((T >> 1) << 8) | (T & 1); } } }
          } else {
              ownw = 1;
              if (j == 0) { rowp = pm; nq = 1; q0 = pm << 8; }
              else if (j == 1) { nq = 1; q0 = (pm << 8) | 1; nk = 1; k0 = pm << 8; }
              else if (j == 2) { nq = 1; q0 = (pm << 8) | 2; nk = 1; k0 = (pm << 8) | 1; }
              else { nk = 2; k0 = (pm << 8) | 2; k1 = (pm << 8) | 3; } }
          unsigned* cnt1 = (unsigned*)(ws + WS_CTL + CTL_CNT1); unsigned* barw = (unsigned*)(ws + WS_CTL) + CW_BAR;
          if (ownw) seam_wait(cnt1 + 16 * pm, cnt1 + 16 * pm, 16u, barw, wave);
          if (smpw) seam_wait(cnt1 + 16 * 64, cnt1 + 16 * 65, 16u, barw, wave); }
        if (rowp >= 0) { FRESH_TID(); FRESH_PTRS();
          P2Ptrs P{(const bf16*)(ws + B_Z), (bf16*)(ws + B_MRG), (bf16*)(ws + WS_CKVA + (size_t)l * L_CKVA), (bf16*)(ws + WS_KR + (size_t)l * L_KR), (bf16*)(ws + B_VN), (const float*)(ws + WS_ROPE), out,
                   args.in[I_GQL] + l * 256, args.in[I_GKVL] + l * 128, args.in[I_GKR] + l * 32, args.in[I_LNG] + l * 512, args.in[I_LNB] + l * 512};
          for (int mg = 32 * rowp + wave; mg < 32 * rowp + 32; mg += 8) p2_rows8(P, l, 8 * mg, lane_p); }
        if (nq > 0) { FRESH_PTRS(); unsigned char* wb = ws + WS_W + (size_t)l * LW;
          pg8::Gemm g{(const bf16*)(ws + B_Z), (const bf16*)(wb + W_QUP), MT, 768, 256, NZ}; ListOrder S{nq, q0, q1, 0};
          pg8::EpiQ E{(bf16*)(ws + B_QNP), (bf16*)(ws + B_QRP), args.in[I_GQN] + l * 64, args.in[I_GQR] + l * 32, (const float*)(ws + WS_ROPE), (const float*)(ws + WS_CTL + CTL_SSQQ) + (size_t)l * MT, ws};
          pg8::gemm_phase<pg8::EpiQ, ListOrder, true, true>(lds, g, S, E, wave); }
        if (nk > 0) { FRESH_PTRS();
          pg8::Gemm g{(const bf16*)(ws + B_Z) + 256, (const bf16*)(ws + WS_WKVG + (size_t)l * 262144), MT, 1024, 128, NZ}; ListOrder S{nk, k0, k1, k2};
          pg8::EpiKV E{(bf16*)(ws + B_KN), (bf16*)(ws + B_VV), args.in[I_GKN] + l * 64, (const float*)(ws + WS_CTL + CTL_SSQC) + (size_t)l * MT, ws};
          pg8::gemm_phase<pg8::EpiKV, ListOrder, true, true>(lds, g, S, E, wave); }
        if (nc > 0) { FRESH_PTRS(); unsigned char* wb = ws + WS_W + (size_t)l * LW;
          pg8::Gemm g{(const bf16*)(ws + WS_CKVA + (size_t)l * L_CKVA) + (size_t)MT * 128, (const bf16*)(wb + W_KV), MC, 512, 128, 128}; ListOrder S{nc, cc0, cc1, 0};
          pg8::EpiKV E{(bf16*)(ws + B_KN) + (size_t)MT * 512, (bf16*)(ws + B_VV) + (size_t)MT * 512, args.in[I_GKN] + l * 64, nullptr, ws};
          pg8::gemm_phase<pg8::EpiKV, ListOrder, true, true>(lds, g, S, E, wave); }
        }
#endif
        STAMPW(2 + 6 * l); GRID_BAR();
        STAMP(3 + 6 * l);
#ifndef NO_P4
        asm volatile("; MARK_P4");
        { FRESH_TID(); FRESH_PTRS();
          att::Ptrs P{(const bf16*)(ws + B_QNP), (const bf16*)(ws + B_QRP), (const bf16*)(ws + B_KN), (const bf16*)(ws + B_VV), (const bf16*)(ws + WS_KR + (size_t)l * L_KR), (bf16*)(ws + B_MRG), args.in[I_GOA] + l * 512};
          const int bh = vcu >> 2, s = vcu & 3;
          const int par = bh & 1;
          if (par) att::sample_unit(P, (const bf16*)(ws + WS_CKVA + (size_t)l * L_CKVA), (const bf16*)(ws + WS_W + (size_t)l * LW + W_KV), vcu >> 5, (vcu >> 2) & 7, vcu & 3, (float*)(ws + WS_PART), (unsigned*)(ws + WS_CTL + CTL_SCNT) + l * 64, (LAS char*)lds, tid_p, lane_p, wave);
          att::prompt_unit(P, bh >> 3, bh & 7, 7 - s, (LAS char*)lds, tid_p, lane_p, wave);
          att::prompt_unit(P, bh >> 3, bh & 7, s, (LAS char*)lds, tid_p, lane_p, wave);
          STAMPG(22 + l, 0);
          if (!par) att::sample_unit(P, (const bf16*)(ws + WS_CKVA + (size_t)l * L_CKVA), (const bf16*)(ws + WS_W + (size_t)l * LW + W_KV), vcu >> 5, (vcu >> 2) & 7, vcu & 3, (float*)(ws + WS_PART), (unsigned*)(ws + WS_CTL + CTL_SCNT) + l * 64, (LAS char*)lds, tid_p, lane_p, wave);
#ifndef NO_P4C
          STAMPG(24 + l, 0);
          asm volatile("; MARK_P4C");
          { att::GmPtrs Gm{(const bf16*)(ws + B_VN), (bf16*)(ws + B_MRG), (const bf16*)(ws + WS_W + (size_t)l * LW + W_S), args.in[I_BS] + l * 1024, args.in[I_GOG] + l * 512};
                 att::gmlp_wg(Gm, vcu, (LAS char*)lds, tid_p, lane_p, wave); } STAMPG(34 + l, 0);
#endif
        }
#endif
        STAMPW(3 + 6 * l); GRID_BAR();
        STAMP(4 + 6 * l);
#ifndef NO_P5
        asm volatile("; MARK_P5");
        { FRESH_PTRS(); unsigned char* wb = ws + WS_W + (size_t)l * LW;
          pg8::Gemm g{(const bf16*)(ws + B_MRG), (const bf16*)(wb + W_O), MP, 1024, 1024, 1024}; pg8::StaticOrder S; S.init(MP, 1024, G, bx);
          pg8::EpiRes E{out, (bf16*)(ws + B_XB), (float*)(ws + WS_CTL + CTL_SSQ) + (size_t)(2 * l + 1) * MT, 0, ws, 1};
          pg8::gemm_phase<pg8::EpiRes, pg8::StaticOrder, true, true>(lds, g, S, E, wave); STAMPG(26 + l, 0);
          if (wave == 0) { pg8::Unit u; u.pm = 0; u.pn = 0; if (S.next(0, u) && xb_first_thread(wave)) (void)xb_add((unsigned*)(ws + WS_CTL + CTL_CNT5) + l * (66 * 16) + 16 * u.pm, 1u); }
          { FRESH_TID(); if (vcu < 256) sample_res_gemm<1024>((const bf16*)(ws + B_MRG), 1024, (const bf16*)(wb + W_O), out, E.XB, E.ssq, 0, 1, vcu, (LAS char*)lds, lane_p, wave); } STAMPG(30 + l, 0);
          if (xb_first_thread(wave)) (void)xb_add((unsigned*)(ws + WS_CTL + CTL_CNT5) + l * (66 * 16) + 16 * 64, 1u); }
#endif
        STAMPW(4 + 6 * l);
        STAMP(5 + 6 * l);
#ifndef NO_P6
        asm volatile("; MARK_P6");
        for (int rep_ = 0; rep_ < REP_P6; ++rep_) { FRESH_PTRS(); unsigned char* wb = ws + WS_W + (size_t)l * LW;
          pg8::Gemm g{(const bf16*)(ws + B_XB), (const bf16*)(wb + W_GU), MT, NGU, 1024, 1024};
          unsigned* cnt5 = (unsigned*)(ws + WS_CTL + CTL_CNT5) + l * (66 * 16); PanelOrder S; S.init(G, bx, cnt5 + 16 * 64, (unsigned*)(ws + WS_CTL) + CW_BAR, wave);
          seam_wait(cnt5 + 16 * S.pm, cnt5 + 16 * S.pm, 4u, (unsigned*)(ws + WS_CTL) + CW_BAR, wave);
          pg8::EpiGU E{(bf16*)(ws + B_H), (const float*)(ws + WS_CTL + CTL_SSQ) + (size_t)(2 * l + 1) * MT, ws};
          pg8::gemm_phase<pg8::EpiGU, PanelOrder, true, true>(lds, g, S, E, wave);
          }
        { FRESH_PTRS(); PanelOrder S2; S2.init(G, bx, nullptr, nullptr, wave);
          if (wave == 0) { unsigned* cnt6 = (unsigned*)(ws + WS_CTL + CTL_CNT6) + l * (66 * 16); pg8::Unit u; u.pm = 0; u.pn = 0; const bool t0_ = xb_first_thread(wave);
            for (int i = 0; S2.next(i, u); ++i) { if (t0_) (void)xb_add(cnt6 + 16 * u.pm, 1u); } }
#ifndef NO_DEFER
          if (l == 0 && S2.j >= 2 && S2.ks < 0) { FRESH_TID(); const int idle_ = 2 * (S2.pm - 22) + (S2.j - 2);
                                     convert_items(args, ws, (LAS float*)(lds + wave * 16384), I_LAYER, 2 * I_LAYER, idle_ * 8 + wave, 84 * 8, lane_p);
                                     }
#endif
          }
#endif
        STAMPW(5 + 6 * l);
        STAMP(6 + 6 * l);
#ifndef NO_P7
        asm volatile("; MARK_P7");
        { FRESH_PTRS(); unsigned* cnt6 = (unsigned*)(ws + WS_CTL + CTL_CNT6) + l * (66 * 16); pg8::StaticOrder S; S.init(MP, 1024, G, bx); pg8::Unit u0;
          if (G == 256 && S.next(0, u0)) seam_wait(cnt6 + 16 * u0.pm, cnt6 + 16 * u0.pm, 22u, (unsigned*)(ws + WS_CTL) + CW_BAR, wave);
          else { for (int p = 0; p < 66; p += 2) seam_wait(cnt6 + 16 * p, cnt6 + 16 * (p + 1), 22u, (unsigned*)(ws + WS_CTL) + CW_BAR, wave); } }
        { FRESH_PTRS(); unsigned char* wb = ws + WS_W + (size_t)l * LW;
          pg8::Gemm g{(const bf16*)(ws + B_H), (const bf16*)(wb + W_D), MP, 1024, DFF, DFF}; pg8::StaticOrder S; S.init(MP, 1024, G, bx);
          pg8::EpiRes E{out, (bf16*)(ws + B_XB), (float*)(ws + WS_CTL + CTL_SSQ) + (size_t)(2 * l + 2) * MT, l == NLAYER - 1 ? 1 : 0, ws, 0};
          pg8::gemm_phase<pg8::EpiRes, pg8::StaticOrder, true, true>(lds, g, S, E, wave); STAMPG(28 + l, 0); }
        { FRESH_PTRS(); unsigned* cnt6 = (unsigned*)(ws + WS_CTL + CTL_CNT6) + l * (66 * 16);
          seam_wait(cnt6 + 16 * 64, cnt6 + 16 * 65, 22u, (unsigned*)(ws + WS_CTL) + CW_BAR, wave); }
        { FRESH_PTRS(); unsigned char* wb = ws + WS_W + (size_t)l * LW; pg8::EpiRes E{out, (bf16*)(ws + B_XB), (float*)(ws + WS_CTL + CTL_SSQ) + (size_t)(2 * l + 2) * MT, l == NLAYER - 1 ? 1 : 0, ws, 0};
          { FRESH_TID(); if (vcu < 256) sample_res_gemm<DFF>((const bf16*)(ws + B_H), DFF, (const bf16*)(wb + W_D), out, E.XB, E.ssq, E.final_f32, 0, vcu, (LAS char*)lds, lane_p, wave); } STAMPG(32 + l, 0); }
#endif
        STAMPW(6 + 6 * l); if (l + 1 < NLAYER) GRID_BAR();
        STAMP(7 + 6 * l);
    }
#ifdef PROBE_STAMPS
#ifdef PROBE_MODE
    GRID_BAR();
    if (blockIdx.x == 0 && wave == 0) { volatile LAS unsigned* m_ = (volatile LAS unsigned*)(lds + MISC_OFF) + 16;
        auto rdl = [&](int k) { return (((unsigned long long)m_[2 * k + 1] << 32) | m_[2 * k]); };
        unsigned z_q = 0u; asm volatile("" : "+v"(z_q)); const int lane = (int)__builtin_amdgcn_mbcnt_hi(~0u, __builtin_amdgcn_mbcnt_lo(~0u, z_q)); int total = 0;
        volatile LAS int* sc = (volatile LAS int*)lds;
        _Pragma("unroll 1") for (int q = 0; q < 13; ++q) { if (!((PROBE_QMASK >> q) & 1)) continue;
            const unsigned long long st = rdl(q), en = (q == 12) ? rdl(13) : rdl(q + 1);
            int mx = -(1 << 30), mn = 1 << 30, sm = 0;
            for (int j = 0; j < 4; ++j) { const unsigned long long t = __hip_atomic_load((unsigned long long*)(args.ws + WS_CTL + 983040 + 1024) + q * 256 + lane * 4 + j, __ATOMIC_RELAXED, __HIP_MEMORY_SCOPE_AGENT);
                const int d = (int)(long long)(t - st); mx = d > mx ? d : mx; mn = d < mn ? d : mn; sm += d; }
            sc[lane] = mx; sc[64 + lane] = mn; sc[128 + lane] = sm;
            __builtin_amdgcn_s_waitcnt(0); __builtin_amdgcn_wave_barrier();
            int MX = -(1 << 30), MN = 1 << 30; int SM = 0;
            for (int j = 0; j < 64; ++j) { const int a_ = sc[j], b_ = sc[64 + j]; MX = a_ > MX ? a_ : MX; MN = b_ < MN ? b_ : MN; SM += sc[128 + j]; }
            __builtin_amdgcn_wave_barrier();
            const int mean = SM >> 8, len = (int)(long long)(en - st);
            int v = 0;
            if (PROBE_MODE == 1) v = MX - mean; else if (PROBE_MODE == 2) v = len - MX; else if (PROBE_MODE == 3) v = MX - MN; else if (PROBE_MODE == 4) v = mean; else if (PROBE_MODE == 5) v = MN; else if (PROBE_MODE == 6) v = len;
            total += v > 0 ? v : 0; }
        const unsigned long long now = __builtin_amdgcn_s_memrealtime();
        const unsigned long long until = now + (unsigned long long)PROBE_MULT * (unsigned long long)total;
        while (__builtin_amdgcn_s_memrealtime() < until) __builtin_amdgcn_s_sleep(8); }
#else
    if (blockIdx.x == 0 && wave == 0) { volatile LAS unsigned* m_ = (volatile LAS unsigned*)(lds + MISC_OFF) + 16;
        auto rd = [&](int k) { return k >= 16 ? __hip_atomic_load((unsigned long long*)(args.ws + WS_CTL + 983040) + k, __ATOMIC_RELAXED, __HIP_MEMORY_SCOPE_AGENT) : (((unsigned long long)m_[2 * k + 1] << 32) | m_[2 * k]); };
        const unsigned long long now = __builtin_amdgcn_s_memrealtime();
        const unsigned long long e1 = (PROBE_B1 == 14) ? now : rd(PROBE_B1), e2 = (PROBE_B2 == 14) ? now : rd(PROBE_B2);
        const unsigned long long span = (e1 - rd(PROBE_A1)) + (e2 - rd(PROBE_A2));
        const unsigned long long until = now + (unsigned long long)PROBE_MULT * span;
        while (__builtin_amdgcn_s_memrealtime() < until) __builtin_amdgcn_s_sleep(8); }
#endif
#endif
}

extern "C" void kernel_launch(void* const* d_in, const int* in_sizes, int n_in, void* d_out, int out_size, void* d_ws, size_t ws_size, hipStream_t stream) {
    static int grid = 0;
    if (grid == 0) {
        #ifdef PROBE_WSMIN
        if (ws_size < (size_t)PROBE_WSMIN * MiB) { grid = -1; return; }
#endif
        if (n_in != 25 || (size_t)out_size != O_END || ws_size < WS_END) { fprintf(stderr, "kernel_launch: unexpected shapes (n_in %d, out %d, ws %zu); nothing launched\n", n_in, out_size, ws_size); grid = -1; return; }
        int dev = 0, cus = 0, per_cu = 0;
        if (hipGetDevice(&dev) != hipSuccess || hipDeviceGetAttribute(&cus, hipDeviceAttributeMultiprocessorCount, dev) != hipSuccess) { grid = -1; return; }
        if (hipFuncSetAttribute((const void*)hybrid_fwd, hipFuncAttributeMaxDynamicSharedMemorySize, LDS_BYTES) != hipSuccess) { fprintf(stderr, "kernel_launch: hipFuncSetAttribute failed\n"); grid = -1; return; }
        if (hipOccupancyMaxActiveBlocksPerMultiprocessor(&per_cu, (const void*)hybrid_fwd, 512, LDS_BYTES) != hipSuccess || per_cu < 1) { fprintf(stderr, "kernel_launch: occupancy query reports %d blocks per CU\n", per_cu); (void)hipGetLastError(); grid = -1; return; }
        if (cus < 256) { fprintf(stderr, "kernel_launch: built for a 256-CU device (found %d CUs); nothing launched\n", cus); grid = -1; return; }
        grid = 256;
    }
    if (grid < 0) return;
    if (hipMemsetAsync((char*)d_ws + WS_CTL, 0, CTL_ZERO_BYTES, stream) != hipSuccess) return;
    Args a{};
    for (int i = 0; i < 25; ++i) a.in[i] = (const float*)d_in[i];
    a.out = (float*)d_out; a.ws = (unsigned char*)d_ws;
    hipLaunchKernelGGL(hybrid_fwd, dim3(grid), dim3(512), LDS_BYTES, stream, a);
}
```
